# Optimizing an MI355X kernel written in HIP

```python
import jax
import jax.numpy as jnp
from jax import lax
import numpy as np


D_MODEL = 1024
BATCH = 2
SEQ = 8192
DEPTH = 2

HEAD_DIM = 64
N_BRANCH = 4
ROPE_THETA = 500000.0
PARTIAL_ROT = HEAD_DIM // 4
Q_BLOCK = 128
NORM_EPS = 1e-6

DSA_HEADS = 4
IDX_HEADS = 8
IDX_DIM = 32
IDX_ROT = IDX_DIM // 4
DSA_TOPK_MAX = 256

SB_HEADS = 4

MOBA_HEADS = 4
MOBA_BLOCK = 256
MOBA_TOPK = 3
MOBA_Q_BLOCK = 64

MLA_HEADS = 4
MLA_Q_RANK = 256
MLA_KV_RANK = 128
MLA_NOPE = 64
MLA_ROPE = 32
MLA_V = 64

BRANCH_WIDTH = 4 * HEAD_DIM
D_FF = 4 * D_MODEL

IN_WIDTHS = (
    DSA_HEADS * HEAD_DIM, DSA_HEADS * HEAD_DIM, DSA_HEADS * HEAD_DIM,
    IDX_HEADS * IDX_DIM, IDX_DIM, IDX_HEADS,
    SB_HEADS * HEAD_DIM, SB_HEADS * HEAD_DIM, SB_HEADS * HEAD_DIM,
    MOBA_HEADS * HEAD_DIM, MOBA_HEADS * HEAD_DIM, MOBA_HEADS * HEAD_DIM,
    MLA_Q_RANK, MLA_KV_RANK, MLA_ROPE,
    N_BRANCH * D_MODEL,
)
N_IN = sum(IN_WIDTHS)

kernel_name = 'hybrid_gated_sparse_sb_moba_mla'


def rmsnorm(x, g):
    xf = x.astype(jnp.float32)
    y = xf * lax.rsqrt(jnp.mean(xf * xf, axis=-1, keepdims=True) + NORM_EPS)
    return (y * g.astype(jnp.float32)).astype(x.dtype)


def rope_tables(n_rot, seq):
    inv_freq = 1.0 / (ROPE_THETA ** (jnp.arange(0, n_rot, 2, dtype=jnp.float32) / n_rot))
    ang = jnp.arange(seq, dtype=jnp.float32)[:, None] * inv_freq[None, :]
    return jnp.cos(ang), jnp.sin(ang)


def apply_rope(x, cos, sin):
    n_half = cos.shape[-1]
    n_rot = 2 * n_half
    x1 = x[..., :n_half]
    x2 = x[..., n_half:n_rot]
    c = cos[:, None, :].astype(x.dtype)
    s = sin[:, None, :].astype(x.dtype)
    return jnp.concatenate([x1 * c - x2 * s, x2 * c + x1 * s, x[..., n_rot:]], axis=-1)


def to_heads(a, n):
    return a.reshape(a.shape[0], a.shape[1], n, a.shape[2] // n)


def split_columns(z):
    offsets = []
    acc = 0
    for w in IN_WIDTHS[:-1]:
        acc += w
        offsets.append(acc)
    return jnp.split(z, offsets, axis=-1)


def sweep_query_blocks(block_fn, n_blocks):
    out = lax.map(block_fn, jnp.arange(n_blocks))
    nb, b, qb, h, d = out.shape
    return out.transpose(1, 0, 2, 3, 4).reshape(b, nb * qb, h, d)


def dsa_attention(q, k, v, qi, ki, wi):
    S = q.shape[1]
    top = min(DSA_TOPK_MAX, S // 4)
    scale = HEAD_DIM ** -0.5
    key_pos = jnp.arange(S)
    gather = jax.vmap(lambda kk, ii: kk[ii])

    def block(i):
        start = i * Q_BLOCK
        t = start + jnp.arange(Q_BLOCK)
        qb = lax.dynamic_slice_in_dim(q, start, Q_BLOCK, axis=1)
        qib = lax.dynamic_slice_in_dim(qi, start, Q_BLOCK, axis=1)
        wib = lax.dynamic_slice_in_dim(wi, start, Q_BLOCK, axis=1).astype(jnp.float32)
        rel = jax.nn.relu(jnp.einsum('bqhd,bsd->bqhs', qib, ki).astype(jnp.float32) * (IDX_DIM ** -0.5))
        score = jnp.einsum('bqhs,bqh->bqs', rel, wib * (IDX_HEADS ** -0.5))
        causal = key_pos[None, :] <= t[:, None]
        score = jnp.where(causal[None], score, -jnp.inf)
        _, sel = lax.top_k(score, top)
        valid = sel <= t[None, :, None]
        kg = gather(k, sel)
        vg = gather(v, sel)
        logits = jnp.einsum('bqhd,bqkhd->bhqk', qb, kg).astype(jnp.float32) * scale
        logits = jnp.where(valid[:, None], logits, -jnp.inf)
        p = jax.nn.softmax(logits, axis=-1).astype(v.dtype)
        return jnp.einsum('bhqk,bqkhd->bqhd', p, vg)

    return sweep_query_blocks(block, S // Q_BLOCK)


def stick_breaking_attention(q, k, v):
    S = q.shape[1]
    scale = HEAD_DIM ** -0.5
    key_pos = jnp.arange(S)

    def block(i):
        start = i * Q_BLOCK
        t = start + jnp.arange(Q_BLOCK)
        qb = lax.dynamic_slice_in_dim(q, start, Q_BLOCK, axis=1)
        z = jnp.einsum('bqhd,bshd->bhqs', qb, k).astype(jnp.float32) * scale
        past = key_pos[None, :] < t[:, None]
        log_fail = jnp.where(past, jax.nn.log_sigmoid(-z), 0.0)
        later = lax.cumsum(log_fail, axis=3, reverse=True) - log_fail
        a = jnp.where(past, jnp.exp(jax.nn.log_sigmoid(z) + later), 0.0)
        return jnp.einsum('bhqs,bshd->bqhd', a.astype(v.dtype), v)

    return sweep_query_blocks(block, S // Q_BLOCK)


def moba_attention(q, k, v):
    B, S, H, dh = q.shape
    nb = -(-S // MOBA_BLOCK)
    s_pad = nb * MOBA_BLOCK
    n_sel = min(MOBA_TOPK, nb)
    scale = dh ** -0.5
    pad = ((0, 0), (0, s_pad - S), (0, 0), (0, 0))
    kp = jnp.pad(k, pad)
    vp = jnp.pad(v, pad)
    kblk = kp.reshape(B, nb, MOBA_BLOCK, H, dh).transpose(0, 3, 1, 2, 4)
    vblk = vp.reshape(B, nb, MOBA_BLOCK, H, dh).transpose(0, 3, 1, 2, 4)
    kmean = jnp.mean(kblk.astype(jnp.float32), axis=3).astype(k.dtype)
    gather = jax.vmap(jax.vmap(lambda kk, ii: kk[ii]))
    blk_ids = jnp.arange(nb)

    def block(i):
        start = i * MOBA_Q_BLOCK
        t = start + jnp.arange(MOBA_Q_BLOCK)
        own = start // MOBA_BLOCK
        qb = lax.dynamic_slice_in_dim(q, start, MOBA_Q_BLOCK, axis=1)
        gate = jnp.einsum('bqhd,bhnd->bhqn', qb, kmean).astype(jnp.float32)
        gate = jnp.where(blk_ids < own, gate, -jnp.inf)
        _, sel = lax.top_k(gate, n_sel)
        valid = sel < own
        kg = gather(kblk, sel)
        vg = gather(vblk, sel)
        l_sel = jnp.einsum('bqhd,bhqnld->bhqnl', qb, kg).astype(jnp.float32) * scale
        l_sel = jnp.where(valid[..., None], l_sel, -jnp.inf).reshape(B, H, MOBA_Q_BLOCK, n_sel * MOBA_BLOCK)
        k_own = lax.dynamic_slice_in_dim(kp, own * MOBA_BLOCK, MOBA_BLOCK, axis=1)
        v_own = lax.dynamic_slice_in_dim(vp, own * MOBA_BLOCK, MOBA_BLOCK, axis=1)
        l_own = jnp.einsum('bqhd,bshd->bhqs', qb, k_own).astype(jnp.float32) * scale
        own_pos = own * MOBA_BLOCK + jnp.arange(MOBA_BLOCK)
        l_own = jnp.where(own_pos[None, :] <= t[:, None], l_own, -jnp.inf)
        p = jax.nn.softmax(jnp.concatenate([l_sel, l_own], axis=-1), axis=-1).astype(v.dtype)
        p_sel = p[..., :n_sel * MOBA_BLOCK].reshape(B, H, MOBA_Q_BLOCK, n_sel, MOBA_BLOCK)
        p_own = p[..., n_sel * MOBA_BLOCK:]
        return (jnp.einsum('bhqnl,bhqnld->bqhd', p_sel, vg)
                + jnp.einsum('bhqs,bshd->bqhd', p_own, v_own))

    return sweep_query_blocks(block, S // MOBA_Q_BLOCK)


def mla_attention(q_nope, q_rope, k_nope, k_rope, v):
    S = q_nope.shape[1]
    scale = (MLA_NOPE + MLA_ROPE) ** -0.5
    key_pos = jnp.arange(S)

    def block(i):
        start = i * Q_BLOCK
        t = start + jnp.arange(Q_BLOCK)
        qn = lax.dynamic_slice_in_dim(q_nope, start, Q_BLOCK, axis=1)
        qr = lax.dynamic_slice_in_dim(q_rope, start, Q_BLOCK, axis=1)
        logits = (jnp.einsum('bqhd,bshd->bhqs', qn, k_nope)
                  + jnp.einsum('bqhr,bsr->bhqs', qr, k_rope)).astype(jnp.float32) * scale
        logits = jnp.where(key_pos[None, :] <= t[:, None], logits, -jnp.inf)
        p = jax.nn.softmax(logits, axis=-1).astype(v.dtype)
        return jnp.einsum('bhqs,bshd->bqhd', p, v)

    return sweep_query_blocks(block, S // Q_BLOCK)


def setup_inputs(seed: int = 0) -> dict:
    key = jax.random.key(seed)
    ks = jax.random.split(key, 14)
    f32 = jnp.float32

    def nrm(k, shape, scale):
        return jax.random.normal(k, shape, f32) * scale

    return {
        'x': nrm(ks[0], (BATCH, SEQ, D_MODEL), 1.0),
        'norm_mix': 1.0 + nrm(ks[1], (DEPTH, D_MODEL), 0.05),
        'w_in': nrm(ks[2], (DEPTH, D_MODEL, N_IN), D_MODEL ** -0.5),
        'b_gate': nrm(ks[3], (DEPTH, N_BRANCH, D_MODEL), 0.1),
        'mla_q_norm': 1.0 + nrm(ks[4], (DEPTH, MLA_Q_RANK), 0.05),
        'mla_kv_norm': 1.0 + nrm(ks[5], (DEPTH, MLA_KV_RANK), 0.05),
        'w_uq': nrm(ks[6], (DEPTH, MLA_Q_RANK, MLA_HEADS * (MLA_NOPE + MLA_ROPE)), MLA_Q_RANK ** -0.5),
        'w_ukv': nrm(ks[7], (DEPTH, MLA_KV_RANK, MLA_HEADS * (MLA_NOPE + MLA_V)), MLA_KV_RANK ** -0.5),
        'w_branch': nrm(ks[8], (DEPTH, N_BRANCH, BRANCH_WIDTH, D_MODEL), BRANCH_WIDTH ** -0.5),
        'w_out': nrm(ks[9], (DEPTH, D_MODEL, D_MODEL), D_MODEL ** -0.5),
        'norm_mlp': 1.0 + nrm(ks[10], (DEPTH, D_MODEL), 0.05),
        'w_up': nrm(ks[11], (DEPTH, D_MODEL, D_FF), D_MODEL ** -0.5),
        'w_down': nrm(ks[12], (DEPTH, D_FF, D_MODEL), D_FF ** -0.5),
        'norm_final': 1.0 + nrm(ks[13], (D_MODEL,), 0.05),
    }


def reference(x, norm_mix, w_in, b_gate, mla_q_norm, mla_kv_norm, w_uq, w_ukv,
              w_branch, w_out, norm_mlp, w_up, w_down, norm_final):
    B, S, _ = x.shape
    cos_p, sin_p = rope_tables(PARTIAL_ROT, S)
    cos_i, sin_i = rope_tables(IDX_ROT, S)
    cos_m, sin_m = rope_tables(MLA_ROPE, S)

    for l in range(DEPTH):
        h = rmsnorm(x, norm_mix[l])
        z = h @ w_in[l]
        (dq, dk, dv, iq, ik, iw, sq, sk, sv, mq, mk, mv,
         cq, ckv, kr, gate_logits) = split_columns(z)

        o_a = dsa_attention(
            apply_rope(to_heads(dq, DSA_HEADS), cos_p, sin_p),
            apply_rope(to_heads(dk, DSA_HEADS), cos_p, sin_p),
            to_heads(dv, DSA_HEADS),
            apply_rope(to_heads(iq, IDX_HEADS), cos_i, sin_i),
            apply_rope(ik[:, :, None, :], cos_i, sin_i)[:, :, 0],
            iw)

        o_b = stick_breaking_attention(to_heads(sq, SB_HEADS), to_heads(sk, SB_HEADS),
                                       to_heads(sv, SB_HEADS))

        o_c = moba_attention(apply_rope(to_heads(mq, MOBA_HEADS), cos_p, sin_p),
                             apply_rope(to_heads(mk, MOBA_HEADS), cos_p, sin_p),
                             to_heads(mv, MOBA_HEADS))

        qu = to_heads(rmsnorm(cq, mla_q_norm[l]) @ w_uq[l], MLA_HEADS)
        kvu = to_heads(rmsnorm(ckv, mla_kv_norm[l]) @ w_ukv[l], MLA_HEADS)
        o_d = mla_attention(qu[..., :MLA_NOPE],
                            apply_rope(qu[..., MLA_NOPE:], cos_m, sin_m),
                            kvu[..., :MLA_NOPE],
                            apply_rope(kr[:, :, None, :], cos_m, sin_m)[:, :, 0],
                            kvu[..., MLA_NOPE:])

        branches = jnp.stack([o_a.reshape(B, S, -1), o_b.reshape(B, S, -1),
                              o_c.reshape(B, S, -1), o_d.reshape(B, S, -1)], axis=2)
        gates = jax.nn.sigmoid(gate_logits.reshape(B, S, N_BRANCH, D_MODEL) + b_gate[l])
        proj = jnp.einsum('bsnc,ncd->bsnd', branches, w_branch[l])
        merged = jnp.sum(gates * proj, axis=2)
        x = x + merged @ w_out[l]

        h2 = rmsnorm(x, norm_mlp[l])
        x = x + jnp.square(jax.nn.relu(h2 @ w_up[l])) @ w_down[l]

    return rmsnorm(x, norm_final)
```

```cpp
#include <hip/hip_runtime.h>
#include <hip/hip_bf16.h>
#include <cstdio>
#include <cstdint>
#include <cmath>

namespace xl {
template <int K> __device__ __forceinline__ float sxor(float v) { return __int_as_float(__builtin_amdgcn_ds_swizzle(__float_as_int(v), (K << 10) | 0x1F)); }
template <int K> __device__ __forceinline__ unsigned bcast16(unsigned v) { return (unsigned)__builtin_amdgcn_ds_swizzle((int)v, (K << 5) | 0x10); }
__device__ __forceinline__ void halves(float v, float& lo, float& hi) { auto rr = __builtin_amdgcn_permlane32_swap(__float_as_uint(v), __float_as_uint(v), false, false); lo = __uint_as_float(rr[0]); hi = __uint_as_float(rr[1]); }
__device__ __forceinline__ float hsum(float v) { float lo, hi; halves(v, lo, hi); return lo + hi; }
__device__ __forceinline__ float hmax(float v) { float lo, hi; halves(v, lo, hi); return fmaxf(lo, hi); }
__device__ __forceinline__ unsigned hor(unsigned v) { auto rr = __builtin_amdgcn_permlane32_swap(v, v, false, false); return rr[0] | rr[1]; }
__device__ __forceinline__ int fresh_lane() { int z = 0; asm volatile("" : "+v"(z)); return (int)__builtin_amdgcn_mbcnt_hi(~0u, __builtin_amdgcn_mbcnt_lo(~0u, (unsigned)z)); }
}
namespace pg8 {
#define PG8_LAS __attribute__((address_space(3)))
typedef unsigned short bf16_t;
typedef short bf16x8 __attribute__((ext_vector_type(8)));
typedef float f32x4 __attribute__((ext_vector_type(4)));
typedef unsigned u32x4 __attribute__((ext_vector_type(4)));
constexpr int BM = 256, BK = 64, HALF = 128, HTB = HALF * BK * 2  , STAGE_BYTES = 8 * HTB, NXCD = 8, WGM = 8;

__host__ __device__ __forceinline__ int lds_byte(int r, int c) { const int st = (r >> 4) * 2 + (c >> 5), rr = r & 15, cc = c & 31, ob = rr * 64 + cc * 2; return st * 1024 + (ob ^ (((ob >> 9) & 1) << 5)); }
__host__ __device__ __forceinline__ void stage_rc(int b, int& R, int& C) { const int st = b / 1024, sb = b % 1024, swz = sb ^ (((sb >> 9) & 1) << 5); R = (st >> 1) * 16 + swz / 64; C = (st & 1) * 32 + (swz % 64) / 2; }
__host__ __device__ __forceinline__ int perm32(int rho) { const int n = rho >> 4, i = rho & 15; return 8 * (i >> 2) + 4 * n + (i & 3); }

struct Unit { int pm, pn; };
struct Gemm { const bf16_t* A; const bf16_t* Bt; int M, N, K; };

struct StaticOrder {
    int nM, nN, nwg, G, c;
    __host__ __device__ void init(int M, int N, int G_, int c_) { nM = M / BM; nN = N / BM; nwg = nM * nN; G = G_; c = c_; }
    __host__ __device__ bool next(int i, Unit& u) const {
        const long L = (long)i * G + c; if (L >= nwg) return false;
        int wgid = (int)L; { const int q = nwg / NXCD, r = nwg % NXCD, xcd = wgid % NXCD, off = wgid / NXCD; wgid = (xcd < r ? xcd * (q + 1) : r * (q + 1) + (xcd - r) * q) + off; }
        const int nig = WGM * nN, gid = wgid / nig, fm = gid * WGM, gsz = (nM - fm) < WGM ? (nM - fm) : WGM;
        u.pm = fm + ((wgid % nig) % gsz); u.pn = (wgid % nig) / gsz; return true;
    }
    __device__ __forceinline__ void a_ready(const Unit&) const {}
    __device__ __forceinline__ void done(const Unit&) const {}
};

__device__ __forceinline__ unsigned cvt_pk_bf16(float lo, float hi) { unsigned r; asm volatile("v_cvt_pk_bf16_f32 %0, %1, %2" : "=v"(r) : "v"(lo), "v"(hi)); return r; }
template <class Epi, class Sched, bool ALIGN_EPI = false, bool SP2 = false>
__device__ __forceinline__ void gemm_phase(PG8_LAS unsigned char* lds, const Gemm g, const Sched& S, const Epi& E, const int wave0) {
    int tid_ = (wave0 << 6) | xl::fresh_lane(); asm volatile("" : "+v"(tid_));
    const int tid = tid_, wid = __builtin_amdgcn_readfirstlane(tid >> 6), lane = tid & 63, wr = wid >> 2, wc = wid & 3, fr = lane & 15, fq = lane >> 4;
    int K_ = g.K; asm volatile("" : "+s"(K_));
    const int K = K_, nt = K / BK;
    unsigned voffA[2], voffB[2];
#pragma unroll
    for (int i = 0; i < 2; ++i) { int R, C; stage_rc(tid * 16 + i * 8192, R, C); const int Rb = Epi::PERM ? ((R & ~31) + perm32(R & 31)) : R;
        voffA[i] = (unsigned)(R * K + C) * 2u; voffB[i] = (unsigned)(Rb * K + C) * 2u; }
    const size_t kstep = (size_t)(BK * 2);
    const size_t hstep = (size_t)HALF * K * 2;
    const size_t tstep = 2 * hstep;
    const unsigned ldsw = (unsigned)wid * 1024u;
    const int aoff = lds_byte(wr * 64 + fr, fq * 8), boff = lds_byte(wc * 32 + fr, fq * 8);
#define PG8_SA(b, h) (((b) * 2 + (h)) * HTB)
#define PG8_SB(b, h) ((4 + (b) * 2 + (h)) * HTB)
#define PG8_STAGE(bufoff, gbase, voff) do { _Pragma("unroll") for (int _i = 0; _i < 2; ++_i) \
        __builtin_amdgcn_global_load_lds((const unsigned*)((const char*)(gbase) + (voff)[_i]), (PG8_LAS unsigned*)(lds + (bufoff) + ldsw + _i * 8192), 16, 0, 0); } while (0)
#define PG8_LDA(dst, b, h) do { _Pragma("unroll") for (int m = 0; m < 4; ++m) _Pragma("unroll") for (int k = 0; k < 2; ++k) dst[m][k] = *(const PG8_LAS bf16x8*)(lds + PG8_SA(b, h) + aoff + m * 2048 + k * 1024); } while (0)
#define PG8_LDB(dst, b, h) do { _Pragma("unroll") for (int n = 0; n < 2; ++n) _Pragma("unroll") for (int k = 0; k < 2; ++k) dst[n][k] = *(const PG8_LAS bf16x8*)(lds + PG8_SB(b, h) + boff + n * 2048 + k * 1024); } while (0)
#define PG8_MMA(ai, bj, At, Bt) do { __builtin_amdgcn_s_setprio(1); _Pragma("unroll") for (int m = 0; m < 4; ++m) _Pragma("unroll") for (int n = 0; n < 2; ++n) _Pragma("unroll") for (int k = 0; k < 2; ++k) \
        acc[ai][bj][m][n] = __builtin_amdgcn_mfma_f32_16x16x32_bf16(Bt[n][k], At[m][k], acc[ai][bj][m][n], 0, 0, 0); __builtin_amdgcn_s_setprio(0); } while (0)
#define PG8_WAIT_V(n) asm volatile("s_waitcnt vmcnt(" #n ")" ::: "memory")
#define PG8_WAIT_L(n) asm volatile("s_waitcnt lgkmcnt(" #n ")" ::: "memory")
#define PG8_BAR __builtin_amdgcn_s_barrier()
#define PG8_SCHED __builtin_amdgcn_sched_barrier(0)
    Unit cur, nxt; int ui = 0;
    if (!S.next(0, cur)) return;
    f32x4 acc[2][2][4][2];
#pragma unroll
    for (int a = 0; a < 2; ++a)
#pragma unroll
        for (int b = 0; b < 2; ++b)
#pragma unroll
            for (int m = 0; m < 4; ++m)
#pragma unroll
                for (int n = 0; n < 2; ++n) acc[a][b][m][n] = (f32x4){0.f, 0.f, 0.f, 0.f};
    bf16x8 At[4][2], B0[2][2], B1[2][2];
    const char* cA = (const char*)g.A + (size_t)cur.pm * tstep; const char* cB = (const char*)g.Bt + (size_t)cur.pn * tstep;
    S.a_ready(cur);
    if constexpr (SP2) {
        PG8_STAGE(PG8_SB(0, 0), cB, voffB); PG8_STAGE(PG8_SB(0, 1), cB + hstep, voffB); PG8_STAGE(PG8_SA(0, 0), cA, voffA); PG8_STAGE(PG8_SA(0, 1), cA + hstep, voffA);
        if (wr == 1) PG8_BAR;
        PG8_WAIT_V(2); PG8_BAR;
        PG8_STAGE(PG8_SB(1, 0), cB + kstep, voffB); PG8_STAGE(PG8_SA(1, 0), cA + kstep, voffA); PG8_STAGE(PG8_SB(1, 1), cB + hstep + kstep, voffB);
        PG8_WAIT_V(6); PG8_BAR;
    } else {
        PG8_STAGE(PG8_SB(0, 0), cB, voffB); PG8_STAGE(PG8_SA(0, 0), cA, voffA); PG8_STAGE(PG8_SB(0, 1), cB + hstep, voffB); PG8_STAGE(PG8_SA(0, 1), cA + hstep, voffA);
        if (wr == 1) PG8_BAR;
        PG8_WAIT_V(4); PG8_BAR;
        PG8_STAGE(PG8_SB(1, 0), cB + kstep, voffB); PG8_STAGE(PG8_SA(1, 0), cA + kstep, voffA); PG8_STAGE(PG8_SB(1, 1), cB + hstep + kstep, voffB);
        PG8_WAIT_V(6); PG8_BAR;
    }
    for (;;) {
        const bool has_next = S.next(ui + 1, nxt);
        const char* nA = has_next ? (const char*)g.A + (size_t)nxt.pm * tstep : cA; const char* nB = has_next ? (const char*)g.Bt + (size_t)nxt.pn * tstep : cB;
        for (int t = 0; t < nt; t += 2) {
            const bool last = (t == nt - 2);
            const char* a1 = cA + (size_t)(t + 1) * kstep;
            const char* a2 = last ? nA : cA + (size_t)(t + 2) * kstep; const char* b2 = last ? nB : cB + (size_t)(t + 2) * kstep;
            const char* a3 = a2 + kstep; const char* b3 = b2 + kstep;
            if (last && has_next) S.a_ready(nxt);
            if constexpr (SP2) {
            PG8_LDB(B0, 0, 0); PG8_LDB(B1, 0, 1); PG8_SCHED; PG8_LDA(At, 0, 0); PG8_STAGE(PG8_SA(1, 1), a1 + hstep, voffA);
            PG8_WAIT_V(8); PG8_WAIT_L(0); PG8_BAR; PG8_MMA(0, 0, At, B0); PG8_MMA(0, 1, At, B1); PG8_BAR; PG8_SCHED;
            PG8_LDA(At, 0, 1); PG8_STAGE(PG8_SB(0, 0), b2, voffB); PG8_STAGE(PG8_SB(0, 1), b2 + hstep, voffB); PG8_STAGE(PG8_SA(0, 0), a2, voffA);
            PG8_WAIT_V(8); PG8_WAIT_L(0); PG8_BAR; PG8_MMA(1, 0, At, B0); PG8_MMA(1, 1, At, B1); PG8_BAR; PG8_SCHED;
            PG8_LDB(B0, 1, 0); PG8_LDB(B1, 1, 1); PG8_SCHED; PG8_LDA(At, 1, 0); PG8_STAGE(PG8_SA(0, 1), a2 + hstep, voffA);
            PG8_WAIT_V(8); PG8_WAIT_L(0); PG8_BAR; PG8_MMA(0, 0, At, B0); PG8_MMA(0, 1, At, B1); PG8_BAR; PG8_SCHED;
            PG8_LDA(At, 1, 1); PG8_STAGE(PG8_SB(1, 0), b3, voffB); PG8_STAGE(PG8_SB(1, 1), b3 + hstep, voffB); PG8_STAGE(PG8_SA(1, 0), a3, voffA);
            PG8_WAIT_V(8); PG8_WAIT_L(0); PG8_BAR; PG8_MMA(1, 0, At, B0); PG8_MMA(1, 1, At, B1); PG8_BAR; PG8_SCHED;
            } else {
            PG8_LDB(B0, 0, 0); PG8_SCHED; PG8_LDA(At, 0, 0); PG8_STAGE(PG8_SA(1, 1), a1 + hstep, voffA);
            PG8_WAIT_L(8); PG8_BAR; PG8_WAIT_L(0); PG8_MMA(0, 0, At, B0); PG8_BAR; PG8_SCHED;
            PG8_LDB(B1, 0, 1); PG8_STAGE(PG8_SB(0, 0), b2, voffB);
            PG8_BAR; PG8_WAIT_L(0); PG8_MMA(0, 1, At, B1); PG8_BAR;
            PG8_LDA(At, 0, 1); PG8_STAGE(PG8_SA(0, 0), a2, voffA);
            PG8_BAR; PG8_WAIT_L(0); PG8_MMA(1, 0, At, B0); PG8_BAR; PG8_SCHED;
            PG8_STAGE(PG8_SB(0, 1), b2 + hstep, voffB);
            PG8_WAIT_V(6); PG8_BAR; PG8_MMA(1, 1, At, B1); PG8_BAR;
            PG8_LDB(B0, 1, 0); PG8_SCHED; PG8_LDA(At, 1, 0); PG8_STAGE(PG8_SA(0, 1), a2 + hstep, voffA);
            PG8_WAIT_L(8); PG8_BAR; PG8_WAIT_L(0); PG8_MMA(0, 0, At, B0); PG8_BAR; PG8_SCHED;
            PG8_LDB(B1, 1, 1); PG8_STAGE(PG8_SB(1, 0), b3, voffB);
            PG8_BAR; PG8_WAIT_L(0); PG8_MMA(0, 1, At, B1); PG8_BAR;
            PG8_LDA(At, 1, 1); PG8_STAGE(PG8_SA(1, 0), a3, voffA);
            PG8_BAR; PG8_WAIT_L(0); PG8_MMA(1, 0, At, B0); PG8_BAR; PG8_SCHED;
            PG8_STAGE(PG8_SB(1, 1), b3 + hstep, voffB);
            PG8_WAIT_V(6); PG8_BAR; PG8_MMA(1, 1, At, B1); PG8_BAR;
            }
        }
        if constexpr (ALIGN_EPI) { if (wr == 0) PG8_BAR; }
        if constexpr (!Epi::AFTER_DRAIN) { E(acc, cur, wr, wc, fr, fq); S.done(cur); }
        if (!has_next) break;
#pragma unroll
        for (int a = 0; a < 2; ++a)
#pragma unroll
            for (int b = 0; b < 2; ++b)
#pragma unroll
                for (int m = 0; m < 4; ++m)
#pragma unroll
                    for (int n = 0; n < 2; ++n) acc[a][b][m][n] = (f32x4){0.f, 0.f, 0.f, 0.f};
        cur = nxt; cA = nA; cB = nB; ++ui;
        if constexpr (ALIGN_EPI) { if (wr == 1) PG8_BAR; }
    }
    PG8_WAIT_V(0);
    if constexpr (!ALIGN_EPI) { if (wr == 0) PG8_BAR; }
    PG8_BAR;
    if constexpr (Epi::AFTER_DRAIN) { E.fused(acc, cur, wr, wc, fr, fq, lds, wid, lane); S.done(cur); }
#undef PG8_SA
#undef PG8_SB
#undef PG8_STAGE
#undef PG8_LDA
#undef PG8_LDB
#undef PG8_MMA
#undef PG8_WAIT_V
#undef PG8_WAIT_L
#undef PG8_BAR
#undef PG8_SCHED
}

constexpr float NORM_EPS = 1e-6f;
constexpr float LOG2E = 1.4426950408889634f;
__device__ __forceinline__ u32x4 pack8(const f32x4 a, const f32x4 b) { u32x4 w; w.x = cvt_pk_bf16(a[0], a[1]); w.y = cvt_pk_bf16(a[2], a[3]); w.z = cvt_pk_bf16(b[0], b[1]); w.w = cvt_pk_bf16(b[2], b[3]); return w; }
__device__ __forceinline__ float bf_lo(unsigned w) { return __uint_as_float(w << 16); }
__device__ __forceinline__ float bf_hi(unsigned w) { return __uint_as_float(w & 0xffff0000u); }
__device__ __forceinline__ float row_total16(const float* ss, int row, int fq) {
    const f32x4 p = *(const f32x4*)(ss + (size_t)row * 16 + 4 * fq);
    float s = (p[0] + p[1]) + (p[2] + p[3]);
    s += xl::sxor<16>(s); s = xl::hsum(s);
    return s;
}
__device__ __forceinline__ void rot4(f32x4& v0, f32x4& v1, const f32x4 c4, const f32x4 s4) {
    const float a0 = v0[0] * c4[0] - v0[1] * s4[0], b0 = v0[1] * c4[0] + v0[0] * s4[0];
    const float a1 = v0[2] * c4[1] - v0[3] * s4[1], b1 = v0[3] * c4[1] + v0[2] * s4[1];
    const float a2 = v1[0] * c4[2] - v1[1] * s4[2], b2 = v1[1] * c4[2] + v1[0] * s4[2];
    const float a3 = v1[2] * c4[3] - v1[3] * s4[3], b3 = v1[3] * c4[3] + v1[2] * s4[3];
    v0 = (f32x4){a0, b0, a1, b1}; v1 = (f32x4){a2, b2, a3, b3};
}

struct EpiInProj {
    static constexpr bool PERM = true, AFTER_DRAIN = false;
    bf16_t* zt; size_t zt_stride; bf16_t* mla_a; bf16_t* misc; const float* ss; float* ssq; float* sskv; float* kmp; const float* tp; const float* ti; const float* tm;
    __device__ __forceinline__ void operator()(const f32x4 (&acc)[2][2][4][2], const Unit& u, int wr, int wc, int fr, int fq) const {
        const int tile = u.pn;
        const int row0 = u.pm * BM + wr * 64 + fr;
        const bool rot64 = (tile == 0) | (tile == 1) | (tile == 7) | (tile == 8);
        const float scl = (tile == 0 || tile == 7) ? 0.125f * LOG2E : (tile == 4 ? 0.125f : 1.0f);
        float ksum[2][8];
#pragma unroll
        for (int bj = 0; bj < 2; ++bj)
#pragma unroll
            for (int e = 0; e < 8; ++e) ksum[bj][e] = 0.f;
        float rsv[2][4];
#pragma unroll
        for (int ai = 0; ai < 2; ++ai)
#pragma unroll
            for (int m = 0; m < 4; ++m) rsv[ai][m] = rsqrtf(row_total16(ss, row0 + ai * HALF + m * 16, fq) * (1.0f / 1024.0f) + NORM_EPS);
        const int ct0 = wc * 32 + 8 * fq;
        const float* rtab = nullptr; int rstride = 0, coff = 0, soff = 0, rbj = 3;
        if (rot64) { if ((ct0 & 63) < 16) { rtab = tp; rstride = 16; coff = (ct0 & 63) >> 1; soff = coff + 8; } }
        else if (tile == 3) { if ((ct0 & 31) == 0) { rtab = ti; rstride = 8; coff = 0; soff = 4; } }
        else if (tile == 11) { rbj = 2; if (wc == 0) { rtab = tm; rstride = 32; coff = ct0 >> 1; soff = coff + 16; } else if (wc == 1 && fq == 0) { rtab = ti; rstride = 8; coff = 0; soff = 4; } }
#pragma unroll
        for (int am = 0; am < 4; ++am) {
            const int ai = am >> 1;
            f32x4 c4[2], s4[2];
            if (rtab) {
#pragma unroll
                for (int mm = 0; mm < 2; ++mm) { const int t = (row0 + ai * HALF + (2 * (am & 1) + mm) * 16) & 8191; c4[mm] = *(const f32x4*)(rtab + t * rstride + coff); s4[mm] = *(const f32x4*)(rtab + t * rstride + soff); }
            }
#pragma unroll
            for (int mm = 0; mm < 2; ++mm) {
                const int m = 2 * (am & 1) + mm;
                const int row = row0 + ai * HALF + m * 16;
                const float rs = rsv[ai][m];
                float sq0 = 0.f, sq1 = 0.f;
#pragma unroll
                for (int bj = 0; bj < 2; ++bj) {
                    const int ct = bj * HALF + ct0;
                    f32x4 v0 = acc[ai][bj][m][0] * rs, v1 = acc[ai][bj][m][1] * rs;
                    if (rtab && ((rbj >> bj) & 1)) rot4(v0, v1, c4[mm], s4[mm]);
                    if (tile <= 9) {
                        if (tile == 8) {
#pragma unroll
                            for (int e = 0; e < 4; ++e) { ksum[bj][e] += v0[e]; ksum[bj][4 + e] += v1[e]; }
                        }
                        v0 = v0 * scl; v1 = v1 * scl;
                        *(u32x4*)(zt + (size_t)tile * zt_stride + (size_t)row * 256 + ct) = pack8(v0, v1);
                    } else if (tile == 10) {
                        sq0 += (v0[0] * v0[0] + v0[1] * v0[1]) + (v0[2] * v0[2] + v0[3] * v0[3]) + (v1[0] * v1[0] + v1[1] * v1[1]) + (v1[2] * v1[2] + v1[3] * v1[3]);
                        *(u32x4*)(mla_a + (size_t)row * 384 + ct) = pack8(v0, v1);
                    } else {
                        if (bj == 0) {
                            sq1 += (v0[0] * v0[0] + v0[1] * v0[1]) + (v0[2] * v0[2] + v0[3] * v0[3]) + (v1[0] * v1[0] + v1[1] * v1[1]) + (v1[2] * v1[2] + v1[3] * v1[3]);
                            *(u32x4*)(mla_a + (size_t)row * 384 + 256 + ct) = pack8(v0, v1);
                        } else {
                            if (wc == 2) { v0 = v0 * 0.0625f; v1 = v1 * 0.0625f; }
                            *(u32x4*)(misc + (size_t)row * 128 + ct0) = pack8(v0, v1);
                        }
                    }
                }
                if (tile == 10) { sq0 += xl::sxor<16>(sq0); sq0 = xl::hsum(sq0); if (fq == 0) ssq[(size_t)row * 4 + wc] = sq0; }
                if (tile == 11) { sq1 += xl::sxor<16>(sq1); sq1 = xl::hsum(sq1); if (fq == 0) sskv[(size_t)row * 4 + wc] = sq1; }
            }
        }
        if (tile == 8) {
#pragma unroll
            for (int bj = 0; bj < 2; ++bj)
#pragma unroll
                for (int e = 0; e < 8; ++e) { float s = ksum[bj][e]; s += xl::sxor<1>(s); s += xl::sxor<2>(s); s += xl::sxor<4>(s); s += xl::sxor<8>(s); ksum[bj][e] = s; }
            if (fr == 0) {
#pragma unroll
                for (int bj = 0; bj < 2; ++bj) { float* kp = kmp + (size_t)(u.pm * 2 + wr) * 256 + bj * HALF + wc * 32 + 8 * fq;
                    *(f32x4*)kp = (f32x4){ksum[bj][0], ksum[bj][1], ksum[bj][2], ksum[bj][3]}; *(f32x4*)(kp + 4) = (f32x4){ksum[bj][4], ksum[bj][5], ksum[bj][6], ksum[bj][7]}; }
            }
        }
    }
};

struct EpiMla {
    static constexpr bool PERM = true, AFTER_DRAIN = false;
    bf16_t* qm; bf16_t* kn; bf16_t* vm; const float* ssq; const float* sskv; const float* tm;
    __device__ __forceinline__ void operator()(const f32x4 (&acc)[2][2][4][2], const Unit& u, int wr, int wc, int fr, int fq) const {
        const int tile = u.pn;
        const int row0 = u.pm * BM + wr * 64 + fr;
        const float QS = 0.10206207261596575f * LOG2E;
#pragma unroll
        for (int ai = 0; ai < 2; ++ai)
#pragma unroll
            for (int m = 0; m < 4; ++m) {
                const int row = row0 + ai * HALF + m * 16;
                const int t = row & 8191;
                float rs;
                if (tile < 2) { const f32x4 p = *(const f32x4*)(ssq + (size_t)row * 4); rs = rsqrtf(((p[0] + p[1]) + (p[2] + p[3])) * (1.0f / 256.0f) + NORM_EPS) * QS; }
                else { const f32x4 p = *(const f32x4*)(sskv + (size_t)row * 4); rs = rsqrtf(((p[0] + p[1]) + (p[2] + p[3])) * (1.0f / 128.0f) + NORM_EPS); }
#pragma unroll
                for (int bj = 0; bj < 2; ++bj) {
                    const int ct = bj * HALF + wc * 32 + 8 * fq;
                    f32x4 v0 = acc[ai][bj][m][0] * rs, v1 = acc[ai][bj][m][1] * rs;
                    if (tile == 0) { *(u32x4*)(qm + (size_t)row * 384 + (ct >> 6) * 96 + (ct & 63)) = pack8(v0, v1); }
                    else if (tile == 1) {
                        if (bj == 0) { const int j0 = (ct & 31) >> 1; const f32x4 c4 = *(const f32x4*)(tm + t * 32 + j0), s4 = *(const f32x4*)(tm + t * 32 + 16 + j0); rot4(v0, v1, c4, s4);
                            *(u32x4*)(qm + (size_t)row * 384 + (ct >> 5) * 96 + 64 + (ct & 31)) = pack8(v0, v1); }
                    }
                    else if (tile == 2) { *(u32x4*)(kn + (size_t)row * 256 + ct) = pack8(v0, v1); }
                    else { *(u32x4*)(vm + (size_t)row * 256 + ct) = pack8(v0, v1); }
                }
            }
    }
};

struct EpiProj {
    static constexpr bool PERM = true, AFTER_DRAIN = false;
    bf16_t* proj; int nM;
    __device__ __forceinline__ void operator()(const f32x4 (&acc)[2][2][4][2], const Unit& u, int wr, int wc, int fr, int fq) const {
        const int n = u.pn >> 2, pn = u.pn & 3, pm = u.pm - n * nM;
        const int row0 = pm * BM + wr * 64 + fr;
#pragma unroll
        for (int ai = 0; ai < 2; ++ai)
#pragma unroll
            for (int m = 0; m < 4; ++m) {
                const int row = row0 + ai * HALF + m * 16;
#pragma unroll
                for (int bj = 0; bj < 2; ++bj) { const int ct = bj * HALF + wc * 32 + 8 * fq;
                    *(u32x4*)(proj + (size_t)row * 4096 + n * 1024 + pn * 256 + ct) = pack8(acc[ai][bj][m][0], acc[ai][bj][m][1]); }
            }
    }
};

struct EpiGate {
    static constexpr bool PERM = true, AFTER_DRAIN = false;
    const bf16_t* proj; bf16_t* merged; const float* ss; const float* bgate;
    __device__ __forceinline__ void operator()(const f32x4 (&acc)[2][2][4][2], const Unit& u, int wr, int wc, int fr, int fq) const {
        const int n = (u.pn - 12) >> 2, pd = (u.pn - 12) & 3;
        const int row0 = u.pm * BM + wr * 64 + fr;
        const int d0 = pd * 256 + wc * 32 + 8 * fq;
        f32x4 bg[2][2];
#pragma unroll
        for (int bj = 0; bj < 2; ++bj) { bg[bj][0] = *(const f32x4*)(bgate + n * 1024 + d0 + bj * HALF); bg[bj][1] = *(const f32x4*)(bgate + n * 1024 + d0 + bj * HALF + 4); }
#pragma unroll
        for (int ai = 0; ai < 2; ++ai)
#pragma unroll
            for (int mp = 0; mp < 2; ++mp) {
                u32x4 pr[2][2], mo[2][2]; float rs[2];
#pragma unroll
                for (int mm = 0; mm < 2; ++mm) {
                    const int row = row0 + ai * HALF + (2 * mp + mm) * 16;
#pragma unroll
                    for (int bj = 0; bj < 2; ++bj) {
                        pr[mm][bj] = *(const u32x4*)(proj + (size_t)row * 4096 + n * 1024 + d0 + bj * HALF);
                        if (n > 0) mo[mm][bj] = *(const u32x4*)(merged + (size_t)row * 1024 + d0 + bj * HALF); else mo[mm][bj] = (u32x4){0u, 0u, 0u, 0u};
                    }
                    rs[mm] = rsqrtf(row_total16(ss, row, fq) * (1.0f / 1024.0f) + NORM_EPS);
                }
#pragma unroll
                for (int mm = 0; mm < 2; ++mm) {
                    const int m = 2 * mp + mm; const int row = row0 + ai * HALF + m * 16;
#pragma unroll
                    for (int bj = 0; bj < 2; ++bj) {
                        f32x4 g0 = acc[ai][bj][m][0] * rs[mm] + bg[bj][0], g1 = acc[ai][bj][m][1] * rs[mm] + bg[bj][1];
#pragma unroll
                        for (int e = 0; e < 4; ++e) { g0[e] = __builtin_amdgcn_rcpf(1.0f + __builtin_amdgcn_exp2f(-g0[e] * LOG2E)); g1[e] = __builtin_amdgcn_rcpf(1.0f + __builtin_amdgcn_exp2f(-g1[e] * LOG2E)); }
                        const u32x4 p = pr[mm][bj], q = mo[mm][bj];
                        f32x4 v0 = g0 * (f32x4){bf_lo(p.x), bf_hi(p.x), bf_lo(p.y), bf_hi(p.y)}, v1 = g1 * (f32x4){bf_lo(p.z), bf_hi(p.z), bf_lo(p.w), bf_hi(p.w)};
                        v0 = v0 + (f32x4){bf_lo(q.x), bf_hi(q.x), bf_lo(q.y), bf_hi(q.y)}; v1 = v1 + (f32x4){bf_lo(q.z), bf_hi(q.z), bf_lo(q.w), bf_hi(q.w)};
                        *(u32x4*)(merged + (size_t)row * 1024 + d0 + bj * HALF) = pack8(v0, v1);
                    }
                }
            }
    }
};

struct EpiResid {
    static constexpr bool PERM = true, AFTER_DRAIN = false;
    const float* basef; bf16_t* xb; float* ss;
    __device__ __forceinline__ void operator()(const f32x4 (&acc)[2][2][4][2], const Unit& u, int wr, int wc, int fr, int fq) const {
        const int row0 = u.pm * BM + wr * 64 + fr, col0 = u.pn * BM + wc * 32 + 8 * fq;
#pragma unroll
        for (int ai = 0; ai < 2; ++ai) {
            u32x4 wb[4][2];
            if (!basef) {
#pragma unroll
                for (int m = 0; m < 4; ++m)
#pragma unroll
                    for (int bj = 0; bj < 2; ++bj) wb[m][bj] = *(const u32x4*)(xb + (size_t)(row0 + ai * HALF + m * 16) * 1024 + col0 + bj * HALF);
            }
#pragma unroll
            for (int m = 0; m < 4; ++m) {
                const int row = row0 + ai * HALF + m * 16;
                const size_t off = (size_t)row * 1024 + col0;
                float sq = 0.f;
#pragma unroll
                for (int bj = 0; bj < 2; ++bj) {
                    f32x4 b0, b1;
                    if (basef) { b0 = *(const f32x4*)(basef + off + bj * HALF); b1 = *(const f32x4*)(basef + off + bj * HALF + 4); }
                    else { const u32x4 w = wb[m][bj]; b0 = (f32x4){bf_lo(w.x), bf_hi(w.x), bf_lo(w.y), bf_hi(w.y)}; b1 = (f32x4){bf_lo(w.z), bf_hi(w.z), bf_lo(w.w), bf_hi(w.w)}; }
                    const f32x4 v0 = b0 + acc[ai][bj][m][0], v1 = b1 + acc[ai][bj][m][1];
                    sq += ((v0[0] * v0[0] + v0[1] * v0[1]) + (v0[2] * v0[2] + v0[3] * v0[3])) + ((v1[0] * v1[0] + v1[1] * v1[1]) + (v1[2] * v1[2] + v1[3] * v1[3]));
                    *(u32x4*)(xb + off + bj * HALF) = pack8(v0, v1);
                }
                sq += xl::sxor<16>(sq); sq = xl::hsum(sq);
                if (fq == 0) ss[(size_t)row * 16 + u.pn * 4 + wc] = sq;
            }
        }
    }
};

struct EpiUp {
    static constexpr bool PERM = true, AFTER_DRAIN = false;
    bf16_t* hid; const float* ss;
    __device__ __forceinline__ void operator()(const f32x4 (&acc)[2][2][4][2], const Unit& u, int wr, int wc, int fr, int fq) const {
        const int row0 = u.pm * BM + wr * 64 + fr;
        float rsv[2][4];
#pragma unroll
        for (int ai = 0; ai < 2; ++ai)
#pragma unroll
            for (int m = 0; m < 4; ++m) rsv[ai][m] = rsqrtf(row_total16(ss, row0 + ai * HALF + m * 16, fq) * (1.0f / 1024.0f) + NORM_EPS);
#pragma unroll
        for (int ai = 0; ai < 2; ++ai)
#pragma unroll
            for (int m = 0; m < 4; ++m) {
                const int row = row0 + ai * HALF + m * 16;
                const float rs = rsv[ai][m];
#pragma unroll
                for (int bj = 0; bj < 2; ++bj) { const int ct = bj * HALF + wc * 32 + 8 * fq;
                    f32x4 v0 = acc[ai][bj][m][0] * rs, v1 = acc[ai][bj][m][1] * rs;
#pragma unroll
                    for (int e = 0; e < 4; ++e) { const float a = fmaxf(v0[e], 0.f), b = fmaxf(v1[e], 0.f); v0[e] = a * a; v1[e] = b * b; }
                    *(u32x4*)(hid + (size_t)row * 4096 + u.pn * 256 + ct) = pack8(v0, v1); }
            }
    }
};

struct ProjOrder {
    int nM, G, c;
    __device__ bool next(int i, Unit& u) const { const long L = (long)i * G + c; if (L >= 16L * nM) return false; const int n = (int)(L / (4 * nM)), r = (int)(L % (4 * nM)); u.pm = n * nM + (r >> 2); u.pn = n * 4 + (r & 3); return true; }
    __device__ __forceinline__ void a_ready(const Unit&) const {}
    __device__ __forceinline__ void done(const Unit&) const {}
};
struct GateOrder {
    StaticOrder so;
    __device__ bool next(int i, Unit& u) const { Unit p; if (!so.next(i >> 2, p)) return false; u.pm = p.pm; u.pn = 12 + 4 * (i & 3) + p.pn; return true; }
    __device__ __forceinline__ void a_ready(const Unit&) const {}
    __device__ __forceinline__ void done(const Unit&) const {}
};
}

namespace mk {
#define GAS __attribute__((address_space(1)))
#define LAS __attribute__((address_space(3)))
typedef unsigned short bf16;
typedef unsigned v4u __attribute__((ext_vector_type(4)));
typedef unsigned v2u __attribute__((ext_vector_type(2)));
typedef float f32x4 __attribute__((ext_vector_type(4)));
typedef float f32x16 __attribute__((ext_vector_type(16)));
typedef short bf16x8 __attribute__((ext_vector_type(8)));
typedef short s16x4 __attribute__((ext_vector_type(4)));
typedef GAS unsigned gu32;
#define RLX_AGENT __ATOMIC_RELAXED, __HIP_MEMORY_SCOPE_AGENT
#define LDS_WAIT() asm volatile("s_waitcnt lgkmcnt(0)" ::: "memory")
#define VM_WAIT() asm volatile("s_waitcnt vmcnt(0)" ::: "memory")

constexpr int NWAVES = 8, NTHR = 512;
constexpr int S = 8192, D = 1024, FF = 4096, NIN = 7112, DEPTH = 2;
constexpr int C_DQ = 0, C_DK = 256, C_DV = 512, C_IQ = 768, C_IK = 1024, C_IW = 1056, C_SQ = 1064, C_SK = 1320, C_SV = 1576,
              C_MQ = 1832, C_MK = 2088, C_MV = 2344, C_CQ = 2600, C_CKV = 2856, C_KR = 2984, C_GATE = 3016;
constexpr float LOG2E = 1.4426950408889634f, LN2 = 0.6931471805599453f;

constexpr size_t MiB = 1u << 20;
constexpr size_t WS_CTL = 0, CTL_ZERO_BYTES = 256 * 1024;
constexpr size_t WS_TP = 1 * MiB, WS_TI = WS_TP + 512 * 1024, WS_TM = 2 * MiB;
constexpr size_t WS_SSA = 3 * MiB, WS_SSB = 4 * MiB, WS_SSQ = 5 * MiB, WS_SSKV = WS_SSQ + 256 * 1024, WS_KMP = WS_SSKV + 256 * 1024;
constexpr size_t WS_WIN = 6 * MiB, WS_WMLA = 20 * MiB, WS_WB = 21 * MiB, WS_WOUT = 23 * MiB, WS_WUP = 25 * MiB, WS_WDOWN = 33 * MiB;
constexpr size_t WS_XB = 41 * MiB;
constexpr size_t WS_ZT = 73 * MiB;
constexpr size_t WS_MLAA = 153 * MiB, WS_MISC = 165 * MiB, WS_QM = 169 * MiB, WS_KN = 181 * MiB, WS_VM = 189 * MiB;
constexpr size_t WS_BITS = 197 * MiB;
constexpr size_t WS_O4 = 213 * MiB;
constexpr size_t WS_PROJ = 73 * MiB;
constexpr size_t WS_MERGED = 213 * MiB;
constexpr size_t WS_HID = 73 * MiB;
constexpr size_t WS_PART = 153 * MiB, WS_LSE = 250 * MiB;
constexpr size_t WS_MLIST = 245 * MiB;
constexpr size_t WS_DSA2 = 185 * MiB, WS_LSED = 251 * MiB;
constexpr size_t WS_END = 252 * MiB;
constexpr int CW_TMO = 0, CW_BAR = 4096, CW_QUEUE = 8192, CW_MCNT = 13312;

constexpr int RING_OFF = 0, RING_BYTES = 131072;
constexpr int LDSCTL_OFF = RING_BYTES, MISC_OFF = LDSCTL_OFF + 320;
constexpr int AUX_OFF = LDSCTL_OFF + 1024;
constexpr int LDS_BYTES = 147456;

__device__ __forceinline__ unsigned f2bf(float f) { unsigned u = __builtin_bit_cast(unsigned, f); return (u + 0x7fffu + ((u >> 16) & 1u)) >> 16; }
__device__ __forceinline__ unsigned pk2(float lo, float hi) { return f2bf(lo) | (f2bf(hi) << 16); }
__device__ __forceinline__ float bf2f(unsigned short b) { return __uint_as_float((unsigned)b << 16); }

#define XB_TMO      128
#define XB_XCNT(j)  (256  + 64 * (j))
#define XB_XSUB(j)  (1280 + 64 * (j))
#define XB_XGEN(j)  (2304 + 64 * (j))
#define XB_TOP      3328
#define XB_TOPGEN   3392
#define XCD_BAR_WORDS 3456
#define XB_SPIN_CAP (1u << 18)
__device__ __forceinline__ unsigned xb_ld(unsigned* p)              { return __hip_atomic_load(p, __ATOMIC_RELAXED, __HIP_MEMORY_SCOPE_AGENT); }
__device__ __forceinline__ unsigned xb_add(unsigned* p, unsigned v) { return __hip_atomic_fetch_add(p, v, __ATOMIC_RELAXED, __HIP_MEMORY_SCOPE_AGENT); }
__device__ __forceinline__ unsigned xb_xcc_id() { return (unsigned)__builtin_amdgcn_s_getreg((3 << 11) | 20) & 0xFu; }
#define XB_SPIN(cond, bar) do { unsigned _sp = 0; while (cond) { __builtin_amdgcn_s_sleep(1); \
    if ((++_sp & 255u) == 0u) { if (xb_ld(&(bar)[XB_TMO])) break; if (_sp > XB_SPIN_CAP) { atomicAdd(&(bar)[XB_TMO], 1u); break; } } } } while (0)
struct XcdBarrier { unsigned* bar; unsigned x; volatile LAS unsigned* st; };
__device__ __forceinline__ XcdBarrier xcd_barrier_post(unsigned* bar, volatile LAS unsigned* st, bool leader) {
    XcdBarrier b; b.bar = bar; b.x = xb_xcc_id(); b.st = st;
    if (leader) (void)xb_add(&bar[XB_XCNT(b.x)], 1u);
    return b;
}
__device__ __forceinline__ void xcd_barrier_complete(unsigned* bar, unsigned x, unsigned& nloc, unsigned& nx) {
    const unsigned G = gridDim.x * gridDim.y * gridDim.z;
    unsigned sum, cnt, mine, sp = 0u;
    for (;;) {
        sum = 0u; cnt = 0u; mine = 0u;
#pragma unroll
        for (unsigned j = 0; j < 16; ++j) { const unsigned c = xb_ld(&bar[XB_XCNT(j)]); sum += c; cnt += (c > 0u) ? 1u : 0u; mine = (j == x) ? c : mine; }
        if (sum == G) break;
        __builtin_amdgcn_s_sleep(1);
        if ((++sp & 255u) == 0u) { if (xb_ld(&bar[XB_TMO])) break; if (sp > XB_SPIN_CAP) { atomicAdd(&bar[XB_TMO], 1u); break; } }
    }
    nloc = mine > 0u ? mine : 1u; nx = cnt > 0u ? cnt : 1u;
}
__device__ __forceinline__ void xcd_barrier(const XcdBarrier& b, bool leader) {
    asm volatile("s_waitcnt vmcnt(0)" ::: "memory");
    __syncthreads();
    if (leader) {
        unsigned* bar = b.bar;
        __builtin_amdgcn_s_waitcnt(0);
        unsigned nloc = b.st[0], nx = b.st[1];
        if (nloc == 0u) { xcd_barrier_complete(bar, b.x, nloc, nx); b.st[0] = nloc; b.st[1] = nx; }
        const unsigned old = xb_add(&bar[XB_XSUB(b.x)], 1u);
        const unsigned gen = old / nloc;
        if (old + 1u == (gen + 1u) * nloc) {
            __builtin_amdgcn_fence(__ATOMIC_RELEASE, "agent");
            asm volatile("s_waitcnt vmcnt(0)" ::: "memory");
            const unsigned og = xb_add(&bar[XB_TOP], 1u);
            const unsigned tg = og / nx;
            if (og + 1u == (tg + 1u) * nx) xb_add(&bar[XB_TOPGEN], 1u);
            else XB_SPIN(xb_ld(&bar[XB_TOPGEN]) == tg, bar);
            __builtin_amdgcn_fence(__ATOMIC_ACQUIRE, "agent");
            xb_add(&bar[XB_XGEN(b.x)], 1u);
            asm volatile("s_waitcnt vmcnt(0)" ::: "memory");
        } else {
            XB_SPIN(xb_ld(&bar[XB_XGEN(b.x)]) == gen, bar);
            __builtin_amdgcn_fence(__ATOMIC_ACQUIRE, "agent");
            asm volatile("s_waitcnt vmcnt(0)" ::: "memory");
        }
    }
    __syncthreads();
}

struct Ptrs {
    const float* in[14]; float* out; unsigned char* ws;
    int ph_lo, ph_hi, li, mrows;
};

__device__ __forceinline__ int unperm(int p, int R) { return p < R ? ((p & 1) ? (p >> 1) + (R >> 1) : (p >> 1)) : p; }
__device__ __forceinline__ int win_src(int n) {
    if (n >= 3072) return C_GATE + (n - 3072);
    const int tile = n >> 8, p = n & 255;
    switch (tile) {
        case 0: return C_DQ + (p & ~63) + unperm(p & 63, 16);
        case 1: return C_DK + (p & ~63) + unperm(p & 63, 16);
        case 2: return C_DV + p;
        case 3: return C_IQ + (p & ~31) + unperm(p & 31, 8);
        case 4: return C_SQ + p;
        case 5: return C_SK + p;
        case 6: return C_SV + p;
        case 7: return C_MQ + (p & ~63) + unperm(p & 63, 16);
        case 8: return C_MK + (p & ~63) + unperm(p & 63, 16);
        case 9: return C_MV + p;
        case 10: return C_CQ + p;
        default:
            if (p < 128) return C_CKV + p;
            if (p < 160) return C_KR + unperm(p - 128, 32);
            if (p < 192) return C_IK + unperm(p - 160, 8);
            if (p < 200) return C_IW + (p - 192);
            return -1;
    }
}
__device__ __forceinline__ void conv_item(const float* W, int ldw, int srccol, int k0, const float* gsc, bf16* WT, int ldk, int kout0, int n0, LAS float* scr, int lane) {
#pragma unroll 8
    for (int i = 0; i < 32; ++i) { const int kk = 2 * i + (lane >> 5);
        float v = 0.f;
        if (srccol >= 0) { v = W[(size_t)(k0 + kk) * ldw + srccol]; if (gsc) v *= gsc[k0 + kk]; }
        scr[kk * 33 + (lane & 31)] = v; }
    LDS_WAIT(); asm volatile("" ::: "memory");
    const int c = lane & 7;
#pragma unroll
    for (int j = 0; j < 4; ++j) { const int n = (lane >> 3) + 8 * j; const LAS float* s = scr + (8 * c) * 33 + n;
        v4u o; o.x = pk2(s[0 * 33], s[1 * 33]); o.y = pk2(s[2 * 33], s[3 * 33]); o.z = pk2(s[4 * 33], s[5 * 33]); o.w = pk2(s[6 * 33], s[7 * 33]);
        *(GAS v4u*)(WT + (size_t)(n0 + n) * ldk + kout0 + 8 * c) = o; }
    LDS_WAIT(); asm volatile("" ::: "memory");
}
__device__ __forceinline__ void conv_item_wide(const float* W, int ldw, int src0, int k0, const float* gsc, bf16* WT, int ldk, int kout0, int n0, LAS float* scr, int lane) {
    const int rr = lane >> 4, c4 = (lane & 15) * 4;
    f32x4 v[16];
#pragma unroll
    for (int i = 0; i < 16; ++i) v[i] = *(const GAS f32x4*)(W + (size_t)(k0 + 4 * i + rr) * ldw + src0 + c4);
#pragma unroll
    for (int i = 0; i < 16; ++i) { f32x4 t = v[i]; if (gsc) t = t * gsc[k0 + 4 * i + rr]; const int row = 4 * i + rr; *(LAS f32x4*)(scr + row * 64 + (c4 ^ (8 * ((row >> 3) & 7)))) = t; }
    LDS_WAIT(); asm volatile("" ::: "memory");
    const int c = lane & 7;
#pragma unroll
    for (int j = 0; j < 8; ++j) { const int n = (lane >> 3) + 8 * j; const LAS float* s = scr + (8 * c) * 64 + (n ^ (8 * c));
        v4u o; o.x = pk2(s[0 * 64], s[1 * 64]); o.y = pk2(s[2 * 64], s[3 * 64]); o.z = pk2(s[4 * 64], s[5 * 64]); o.w = pk2(s[6 * 64], s[7 * 64]);
        *(GAS v4u*)(WT + (size_t)(n0 + n) * ldk + kout0 + 8 * c) = o; }
    LDS_WAIT(); asm volatile("" ::: "memory");
}
__device__ __forceinline__ float wave_sum(float v) {
    v += xl::sxor<1>(v); v += xl::sxor<2>(v); v += xl::sxor<4>(v); v += xl::sxor<8>(v); v += xl::sxor<16>(v); v = xl::hsum(v);
    return v;
}
__device__ __forceinline__ void p0_convert(const Ptrs& P, LAS unsigned char* lds, int gw, int NGW, int wave, int lane) {
    unsigned char* ws = P.ws;
    const int nlay = (P.li < 0) ? 1 : DEPTH;
    for (int l = 0; l < nlay; ++l) {
    unsigned char* wb = (l == 0) ? ws + WS_WIN : (unsigned char*)P.out;
    LAS float* scr = (LAS float*)(lds + RING_OFF + wave * 16384);
    const float* w_in = P.in[2] + (size_t)l * D * NIN; const float* norm_mix = P.in[1] + l * D;
    const float* qn = P.in[4] + l * 256; const float* kvn = P.in[5] + l * 128;
    const float* w_uq = P.in[6] + (size_t)l * 256 * 384; const float* w_ukv = P.in[7] + (size_t)l * 128 * 512;
    const float* w_br = P.in[8] + (size_t)l * 4 * 256 * D; const float* w_out = P.in[9] + (size_t)l * D * D;
    const float* norm_mlp = P.in[10] + l * D; const float* w_up = P.in[11] + (size_t)l * D * FF; const float* w_down = P.in[12] + (size_t)l * FF * D;
    bf16* Win = (bf16*)wb; bf16* Wmla = (bf16*)(wb + (WS_WMLA - WS_WIN)); bf16* Wb = (bf16*)(wb + (WS_WB - WS_WIN)); bf16* Wout = (bf16*)(wb + (WS_WOUT - WS_WIN)); bf16* Wup = (bf16*)(wb + (WS_WUP - WS_WIN)); bf16* Wdown = (bf16*)(wb + (WS_WDOWN - WS_WIN));
    constexpr int I_IN = (D / 64) * (3072 / 32), I_MLA = (384 / 64) * (1024 / 32);
    constexpr int J_G = (D / 64) * (4096 / 64), J_B = (256 / 64) * (4096 / 64), J_OUT = (D / 64) * (D / 64), J_UP = (D / 64) * (FF / 64), J_DOWN = (FF / 64) * (D / 64);
    constexpr int NITEMS = I_IN + I_MLA + J_G + J_B + J_OUT + J_UP + J_DOWN;
    for (int it = gw; it < NITEMS; it += NGW) {
        int r = it;
        if (r < I_IN) { const int nb_ = 3072 / 32, kb = r / nb_, nblk = r % nb_; conv_item(w_in, NIN, win_src(nblk * 32 + (lane & 31)), kb * 64, norm_mix, Win, D, kb * 64, nblk * 32, scr, lane); continue; } r -= I_IN;
        if (r < I_MLA) { const int nb_ = 1024 / 32, kb = r / nb_, nblk = r % nb_; const int n = nblk * 32 + (lane & 31);
            int sc = -1; const float* W = w_uq; int ldw = 384; const float* g = qn; int ks = kb * 64;
            if (kb < 4) { if (n < 256) sc = (n >> 6) * 96 + (n & 63); else if (n < 384) sc = ((n - 256) >> 5) * 96 + 64 + unperm((n - 256) & 31, 32); }
            else { W = w_ukv; ldw = 512; g = kvn; ks = kb * 64 - 256; if (n >= 512 && n < 768) sc = ((n - 512) >> 6) * 128 + ((n - 512) & 63); else if (n >= 768) sc = ((n - 768) >> 6) * 128 + 64 + ((n - 768) & 63); }
            conv_item(W, ldw, sc, ks, g, Wmla, 384, kb * 64, nblk * 32, scr, lane); continue; } r -= I_MLA;
        if (r < J_G) { const int nb_ = 4096 / 64, kb = r / nb_, nblk = r % nb_; conv_item_wide(w_in, NIN, C_GATE + nblk * 64, kb * 64, norm_mix, Win, D, kb * 64, 3072 + nblk * 64, scr, lane); continue; } r -= J_G;
        if (r < J_B) { const int nb_ = 4096 / 64, kb = r / nb_, nblk = r % nb_; const int n = nblk * 64;
            conv_item_wide(w_br + (size_t)(n >> 10) * 256 * D, D, n & 1023, kb * 64, nullptr, Wb, 256, kb * 64, n, scr, lane); continue; } r -= J_B;
        if (r < J_OUT) { const int nb_ = D / 64, kb = r / nb_, nblk = r % nb_; conv_item_wide(w_out, D, nblk * 64, kb * 64, nullptr, Wout, D, kb * 64, nblk * 64, scr, lane); continue; } r -= J_OUT;
        if (r < J_UP) { const int nb_ = FF / 64, kb = r / nb_, nblk = r % nb_; conv_item_wide(w_up, FF, nblk * 64, kb * 64, norm_mlp, Wup, D, kb * 64, nblk * 64, scr, lane); continue; } r -= J_UP;
        { const int nb_ = D / 64, kb = r / nb_, nblk = r % nb_; conv_item_wide(w_down, D, nblk * 64, kb * 64, nullptr, Wdown, FF, kb * 64, nblk * 64, scr, lane); }
    }
    }
    {
        const int M = P.mrows;
        const float* x = P.in[0]; bf16* xb = (bf16*)(ws + WS_XB); float* ssa = (float*)(ws + WS_SSA);
        for (int m = gw; m < M; m += NGW) {
            const GAS f32x4* xr = (const GAS f32x4*)(x + (size_t)m * D) + lane;
            f32x4 v[4]; float s = 0.f;
#pragma unroll
            for (int j = 0; j < 4; ++j) { v[j] = xr[64 * j]; s += (v[j].x * v[j].x + v[j].y * v[j].y) + (v[j].z * v[j].z + v[j].w * v[j].w); }
            s = wave_sum(s);
            GAS unsigned long long* o8 = (GAS unsigned long long*)(xb + (size_t)m * D) + lane;
#pragma unroll
            for (int j = 0; j < 4; ++j) o8[64 * j] = (unsigned long long)pk2(v[j].x, v[j].y) | ((unsigned long long)pk2(v[j].z, v[j].w) << 32);
            if (lane < 16) ssa[(size_t)m * 16 + lane] = (lane == 0) ? s : 0.f;
        }
        float* tp = (float*)(ws + WS_TP); float* ti = (float*)(ws + WS_TI); float* tm = (float*)(ws + WS_TM);
        const int gt = gw * 64 + lane, NGT = NGW * 64;
        for (int e = gt; e < S * 28; e += NGT) {
            const int t = e / 28, j = e % 28;
            int nrot, jj; float* dst; int nh;
            if (j < 8) { nrot = 16; jj = j; dst = tp + t * 16; nh = 8; } else if (j < 12) { nrot = 8; jj = j - 8; dst = ti + t * 8; nh = 4; } else { nrot = 32; jj = j - 12; dst = tm + t * 32; nh = 16; }
            const float inv_freq = 1.0f / powf(500000.0f, (float)(2 * jj) / (float)nrot);
            const float ang = (float)t * inv_freq;
            dst[jj] = cosf(ang); dst[nh + jj] = sinf(ang);
        }
    }
}

__device__ __forceinline__ int crow(int r, int hh) { return (r & 3) + 8 * (r >> 2) + 4 * hh; }
typedef float f32x2_t __attribute__((ext_vector_type(2))); typedef __bf16 bf16x2_t __attribute__((ext_vector_type(2)));
__device__ __forceinline__ unsigned cvtpk(float lo, float hi) { f32x2_t v = {lo, hi}; bf16x2_t b = __builtin_convertvector(v, bf16x2_t); return __builtin_bit_cast(unsigned, b); }
typedef short v4i16_t __attribute__((ext_vector_type(4)));
__device__ __forceinline__ s16x4 vtr(const LAS unsigned char* p) { return __builtin_bit_cast(s16x4, __builtin_amdgcn_ds_read_tr16_b64_v4i16((LAS v4i16_t*)p)); }
__device__ __forceinline__ float ex2(float x) { return __builtin_amdgcn_exp2f(x); }
__device__ __forceinline__ float lg2(float x) { return __builtin_amdgcn_logf(x); }
#define MFMA32(a, b, c) __builtin_amdgcn_mfma_f32_32x32x16_bf16((a), (b), (c), 0, 0, 0)

constexpr int VSTR = 144;
constexpr int KSTR64 = 144, KSTR96 = 208;
constexpr int AT_KBUF = 0, AT_VBUF = 2 * 64 * KSTR96, AT_END = AT_VBUF + 3 * 64 * VSTR;
constexpr int AT_KM = AT_END;
constexpr int AX_UNIT = 0, AX_FLAG = 1, AX_SBF = 8  , AX_SPRE = 32, AX_SREM = 64, AX_SCNT = 96, AX_THR = 128, AX_TB = 160, AX_TREM = 192;

struct MixCtx {
    const bf16* zt; size_t zts;
    const bf16* misc; const bf16* qm; const bf16* kn; const bf16* vm; const float* kmp;
    unsigned* bits; bf16* o4; size_t o4s;
    unsigned* diag;
    unsigned short* mlist; unsigned* mcnt; bf16* part; float* lse; bf16* dsa2; float* lsed;
};
struct TileRegs { v4u k, kx, v; };
template <bool MLA> __device__ __forceinline__ void tile_load(TileRegs& tr, const bf16* Kg, const bf16* Xg, const bf16* Vg, size_t rowbase, int key0, int hcol, int tid) {
    const int row = tid >> 3, ch = tid & 7;
    tr.k = *(const v4u*)(Kg + (rowbase + key0 + row) * 256 + hcol + ch * 8);
    tr.v = *(const v4u*)(Vg + (rowbase + key0 + row) * 256 + hcol + ch * 8);
    if (MLA) { if (tid < 256) { const int r2 = tid >> 2, c2 = tid & 3; tr.kx = *(const v4u*)(Xg + (rowbase + key0 + r2) * 128 + c2 * 8); } }
}
template <bool MLA, int KSTR> __device__ __forceinline__ void tile_store(const TileRegs& tr, LAS unsigned char* Kb, LAS unsigned char* Vb, int tid) {
    const int row = tid >> 3, ch = tid & 7;
    *(LAS v4u*)(Kb + row * KSTR + ch * 16) = tr.k;
    *(LAS v4u*)(Vb + row * VSTR + ch * 16) = tr.v;
    if (MLA) { if (tid < 256) { const int r2 = tid >> 2, c2 = tid & 3; *(LAS v4u*)(Kb + r2 * KSTR + 128 + c2 * 16) = tr.kx; } }
}
template <int NKS, int KSTR> __device__ __forceinline__ void qk_tile(f32x16& s0, f32x16& s1, const LAS unsigned char* Kb, const bf16x8 (&qf)[NKS], int lane, const f32x16 cinit = (f32x16){}) {
    const LAS unsigned char* kp = Kb + (lane & 31) * KSTR + (lane >> 5) * 16;
    s0 = cinit; s1 = cinit;
#pragma unroll
    for (int ks = 0; ks < NKS; ++ks) {
        const bf16x8 a0 = *(const LAS bf16x8*)(kp + ks * 32), a1 = *(const LAS bf16x8*)(kp + 32 * KSTR + ks * 32);
        s0 = MFMA32(a0, qf[ks], s0); s1 = MFMA32(a1, qf[ks], s1);
    }
}
__device__ __forceinline__ bf16x8 packp(const f32x16& p, int b) {
    v4u w; w.x = cvtpk(p[b], p[b + 1]); w.y = cvtpk(p[b + 2], p[b + 3]); w.z = cvtpk(p[b + 4], p[b + 5]); w.w = cvtpk(p[b + 6], p[b + 7]);
    return __builtin_bit_cast(bf16x8, w);
}
__device__ __forceinline__ void pv_tile(f32x16& o0, f32x16& o1, const LAS unsigned char* Vb, const f32x16& p0, const f32x16& p1, int lane) {
    bf16x8 pb[4]; pb[0] = packp(p0, 0); pb[1] = packp(p0, 8); pb[2] = packp(p1, 0); pb[3] = packp(p1, 8);
    const int i = lane & 15, G = lane >> 4, hh = G >> 1;
    const LAS unsigned char* vp = Vb + (4 * hh + (i >> 2)) * VSTR + (16 * (G & 1) + 4 * (i & 3)) * 2;
#pragma unroll
    for (int kb = 0; kb < 2; ++kb)
#pragma unroll
        for (int s = 0; s < 2; ++s) {
            const LAS unsigned char* vq = vp + (kb * 32 + 16 * s) * VSTR;
            const s16x4 l0 = vtr(vq), h0 = vtr(vq + 8 * VSTR), l1 = vtr(vq + 64), h1 = vtr(vq + 8 * VSTR + 64);
            const bf16x8 f0 = (bf16x8){l0[0], l0[1], l0[2], l0[3], h0[0], h0[1], h0[2], h0[3]};
            const bf16x8 f1 = (bf16x8){l1[0], l1[1], l1[2], l1[3], h1[0], h1[1], h1[2], h1[3]};
            o0 = MFMA32(f0, pb[kb * 2 + s], o0); o1 = MFMA32(f1, pb[kb * 2 + s], o1);
        }
}
typedef float f32x2s __attribute__((ext_vector_type(2)));
constexpr float SM_THR = 6.0f;
__device__ __forceinline__ void softmax_tile(f32x16& s0, f32x16& s1, float& mref, bool& mset, f32x16& negm, float& l, f32x16& o0, f32x16& o1) {
    float mx = fmaxf(fmaxf(s0[0], s0[1]), s1[0]);
#pragma unroll
    for (int r = 1; r < 16; ++r) { mx = fmaxf(mx, s0[r]); if (r > 1) mx = fmaxf(mx, s1[r - 1]); }
    mx = fmaxf(mx, s1[15]); mx = fmaxf(mx, s1[0]);
    mx = xl::hmax(mx);
    float dl; const bool was_set = mset;
    if (!mset) { dl = (mx > -INFINITY) ? mx : 0.f; mset = mx > -INFINITY; } else dl = (mx > SM_THR) ? mx : 0.f;
    if (__any(dl != 0.f)) {
        const float alpha = was_set ? ex2(-dl) : 1.0f;
#pragma unroll
        for (int r = 0; r < 16; ++r) { s0[r] -= dl; s1[r] -= dl; o0[r] *= alpha; o1[r] *= alpha; }
        l *= alpha; mref += dl;
#pragma unroll
        for (int r = 0; r < 16; ++r) negm[r] = -mref;
    }
    f32x2s ps = {0.f, 0.f};
#pragma unroll
    for (int r = 0; r < 16; r += 2) { s0[r] = ex2(s0[r]); s0[r + 1] = ex2(s0[r + 1]); s1[r] = ex2(s1[r]); s1[r + 1] = ex2(s1[r + 1]); ps += (f32x2s){s0[r], s0[r + 1]}; ps += (f32x2s){s1[r], s1[r + 1]}; }
    l += ps.x + ps.y;
}
__device__ __forceinline__ void store_ot(bf16* O, size_t row, int hcol, const f32x16& o0, const f32x16& o1, float inv, int hh) {
#pragma unroll
    for (int g = 0; g < 4; ++g) {
        v2u w0, w1;
        w0.x = cvtpk(o0[4 * g] * inv, o0[4 * g + 1] * inv); w0.y = cvtpk(o0[4 * g + 2] * inv, o0[4 * g + 3] * inv);
        w1.x = cvtpk(o1[4 * g] * inv, o1[4 * g + 1] * inv); w1.y = cvtpk(o1[4 * g + 2] * inv, o1[4 * g + 3] * inv);
        *(v2u*)(O + row * 256 + hcol + 8 * g + 4 * hh) = w0;
        *(v2u*)(O + row * 256 + hcol + 32 + 8 * g + 4 * hh) = w1;
    }
}

#ifndef MK_ATTDRY
#define MK_ATTDRY 0
#endif
template <int KIND> __device__ __forceinline__ void softmax_unit(const MixCtx& C, int b, int h, int qb, LAS unsigned char* lds, const int wave0, const int dry = 0, const int half = -1) {
    const int dm = dry ? MK_ATTDRY : 0;
    constexpr bool MLA = (KIND == 0);
    constexpr int NKS = MLA ? 6 : 4, KSTR = MLA ? KSTR96 : KSTR64;
    int tid_ = (wave0 << 6) | xl::fresh_lane(); asm volatile("" : "+v"(tid_));
    const int tid = tid_, lane = tid & 63, r32 = lane & 31, hh = lane >> 5, wave = __builtin_amdgcn_readfirstlane(tid >> 6);
    const size_t rowbase = (size_t)b * S; const int q0 = qb * 256, qw = q0 + 32 * wave, t = qw + r32; const int hcol = h * 64;
    const bf16* Kg = MLA ? C.kn : (KIND == 1 ? C.zt + 1 * C.zts : C.zt + 8 * C.zts);
    const bf16* Vg = MLA ? C.vm : (KIND == 1 ? C.zt + 2 * C.zts : C.zt + 9 * C.zts);
    LAS unsigned char* Kb0 = lds + RING_OFF + AT_KBUF; LAS unsigned char* Vb0 = lds + RING_OFF + AT_VBUF;
    bf16x8 qf[NKS];
    if (MLA) {
#pragma unroll
        for (int ks = 0; ks < NKS; ++ks) qf[ks] = *(const bf16x8*)(C.qm + (rowbase + t) * 384 + h * 96 + 16 * ks + 8 * hh);
    } else {
        const bf16* Qg = (KIND == 1) ? C.zt : C.zt + 7 * C.zts;
#pragma unroll
        for (int ks = 0; ks < NKS; ++ks) qf[ks] = *(const bf16x8*)(Qg + (rowbase + t) * 256 + hcol + 16 * ks + 8 * hh);
    }
    const int NTall = 4 * qb + 4;
    const int jlo = (half == 1) ? NTall / 2 : 0, NT = (half == 0) ? NTall / 2 : NTall;
    TileRegs tr;
    tile_load<MLA>(tr, Kg, C.misc, Vg, rowbase, 64 * jlo, hcol, tid);
    unsigned selmask = 0u;
    if (KIND == 2) {
        LAS float* km = (LAS float*)(lds + RING_OFF + AT_KM);
        for (int e = tid; e < 32 * 64; e += NTHR) { const int n = e >> 6, d = e & 63; const float* p = C.kmp + (size_t)((b * 32 + n) * 2) * 256 + hcol + d; km[e] = (p[0] + p[256]) * (1.0f / 256.0f); }
        __syncthreads();
        float qv[32];
#pragma unroll
        for (int ks = 0; ks < 4; ++ks)
#pragma unroll
            for (int j = 0; j < 8; ++j) qv[ks * 8 + j] = bf2f((unsigned short)qf[ks][j]);
        float g0 = -INFINITY, g1 = -INFINITY, g2 = -INFINITY; int i0 = -1, i1 = -1, i2 = -1;
        for (int n = 0; n < qb; ++n) {
            const LAS float* kp = km + n * 64 + 8 * hh;
            float dot = 0.f;
#pragma unroll
            for (int ks = 0; ks < 4; ++ks) { const f32x4 a = *(const LAS f32x4*)(kp + 16 * ks), c = *(const LAS f32x4*)(kp + 16 * ks + 4);
                dot += qv[ks * 8 + 0] * a[0] + qv[ks * 8 + 1] * a[1] + qv[ks * 8 + 2] * a[2] + qv[ks * 8 + 3] * a[3] + qv[ks * 8 + 4] * c[0] + qv[ks * 8 + 5] * c[1] + qv[ks * 8 + 6] * c[2] + qv[ks * 8 + 7] * c[3]; }
            dot = xl::hsum(dot);
            if (dot > g0) { g2 = g1; i2 = i1; g1 = g0; i1 = i0; g0 = dot; i0 = n; }
            else if (dot > g1) { g2 = g1; i2 = i1; g1 = dot; i1 = n; }
            else if (dot > g2) { g2 = dot; i2 = n; }
        }
        if (i0 >= 0) selmask |= 1u << i0; if (i1 >= 0) selmask |= 1u << i1; if (i2 >= 0) selmask |= 1u << i2;
    }
    tile_store<MLA, KSTR>(tr, Kb0, Vb0, tid);
    __syncthreads();
    f32x16 o0 = {}, o1 = {}, negm = {}; float mref = 0.f, l = 0.f; bool mset = false;
    v2u wv_next = (v2u){0u, 0u};
    if (KIND == 1) wv_next = *(const v2u*)(C.bits + (rowbase + t) * 256 + 2 * jlo);
    const bool late = false;
    f32x16 c0 = {}, c1 = {}; bool cact = false;
    auto do_qk = [&](int j, const v2u wv, f32x16& s0, f32x16& s1) {
        qk_tile<NKS, KSTR>(s0, s1, Kb0 + ((j - jlo) & 1) * 64 * KSTR, qf, lane, negm);
        if (KIND == 1) {
            const unsigned w0 = wv.x >> (4 * hh), w1 = wv.y >> (4 * hh);
#pragma unroll
            for (int r = 0; r < 16; ++r) { const unsigned pos = (unsigned)((r & 3) + 8 * (r >> 2));
                const unsigned m0 = (unsigned)__builtin_amdgcn_sbfe((int)w0, pos, 1u), m1 = (unsigned)__builtin_amdgcn_sbfe((int)w1, pos, 1u);
                s0[r] = __uint_as_float((m0 & __float_as_uint(s0[r])) | (~m0 & 0xff800000u)); s1[r] = __uint_as_float((m1 & __float_as_uint(s1[r])) | (~m1 & 0xff800000u)); }
        } else {
            const bool past_blk = (KIND == 2) && ((j >> 2) < qb);
            if (past_blk) { if (!((selmask >> (j >> 2)) & 1u)) { s0 = s0 - INFINITY; s1 = s1 - INFINITY; } }
            else if (64 * j + 63 > qw) {
#pragma unroll
                for (int r = 0; r < 16; ++r) { const int kk = 64 * j + crow(r, hh); if (kk > t) s0[r] = -INFINITY; if (kk + 32 > t) s1[r] = -INFINITY; }
            }
        }
    };
    int vprev = 2 * 64 * VSTR, vcur = 0, vnext = 64 * VSTR;
    for (int j = jlo; j < NT; ++j) {
        if (j + 1 < NT && !(dm & 16)) tile_load<MLA>(tr, Kg, C.misc, Vg, rowbase, 64 * (j + 1), hcol, tid);
        v2u wv = wv_next;
        bool act = 64 * j <= qw + 31;
        if (KIND == 1) { if (64 * (j + 1) <= qw + 31) wv_next = *(const v2u*)(C.bits + (rowbase + t) * 256 + 2 * (j + 1));
                         if (act) act = __any((wv.x | wv.y) != 0u); }
        if (KIND == 2) { const int n = j >> 2; if (n < qb) act = __any((selmask >> n) & 1u); }
        if (!late) {
            if (act) { f32x16 s0, s1; if (dm & 8) { s0 = negm; s1 = negm; } else do_qk(j, wv, s0, s1); if (!(dm & 2)) softmax_tile(s0, s1, mref, mset, negm, l, o0, o1); if (!(dm & 4)) pv_tile(o0, o1, Vb0 + vcur, s0, s1, lane); else { o0 += s0; o1 += s1; } }
        } else {
            if (cact) { softmax_tile(c0, c1, mref, mset, negm, l, o0, o1); pv_tile(o0, o1, Vb0 + vprev, c0, c1, lane); }
            cact = act;
            if (act) do_qk(j, wv, c0, c1);
        }
        if (j + 1 < NT && !(dm & 16)) tile_store<MLA, KSTR>(tr, Kb0 + ((j + 1 - jlo) & 1) * 64 * KSTR, Vb0 + vnext, tid);
        __syncthreads();
        { const int tmp = vprev; vprev = vcur; vcur = vnext; vnext = tmp; }
    }
    if (late && cact) { softmax_tile(c0, c1, mref, mset, negm, l, o0, o1); pv_tile(o0, o1, Vb0 + vprev, c0, c1, lane); }
    __syncthreads();
    l = xl::hsum(l);
    const int branch = MLA ? 3 : (KIND == 1 ? 0 : 2);
    if (KIND == 1 && half >= 0) {
        const float inv = (l > 0.f) ? 1.0f / l : 0.f;
        store_ot(half == 0 ? C.o4 : C.dsa2, rowbase + t, hcol, o0, o1, inv, hh);
        if (hh == 0) C.lsed[((rowbase + t) * 4 + h) * 2 + half] = (l > 0.f) ? mref + lg2(l) : -INFINITY;
    } else
    if (!(dm & 1)) store_ot(C.o4 + branch * C.o4s, rowbase + t, hcol, o0, o1, 1.0f / l, hh);
    else { float x = l; for (int r = 0; r < 16; ++r) x += o0[r] + o1[r]; asm volatile("" :: "v"(x)); }
}

__device__ __forceinline__ float sb_block(f32x16& z, int kbase, int t, int hh, float cin) {
    float lf[16];
#pragma unroll
    for (int r = 0; r < 16; ++r) {
        const float zz = z[r]; const float e = ex2(-fabsf(zz) * LOG2E);
        const float sp = fmaxf(zz, 0.f) + lg2(1.0f + e) * LN2;
        lf[r] = (kbase + crow(r, hh) < t) ? -sp : 0.f;
    }
    float gs[4], pg[4];
#pragma unroll
    for (int g = 0; g < 4; ++g) { gs[g] = (lf[4 * g] + lf[4 * g + 1]) + (lf[4 * g + 2] + lf[4 * g + 3]); float lo_, hi_; xl::halves(gs[g], lo_, hi_); pg[g] = hh ? lo_ : hi_; }
    float run = 0.f;
#pragma unroll
    for (int g = 3; g >= 0; --g) {
        const float base = cin + run + (hh == 0 ? pg[g] : 0.f);
        const float l3 = base, l2 = l3 + lf[4 * g + 3], l1 = l2 + lf[4 * g + 2], l0 = l1 + lf[4 * g + 1];
        const float la[4] = {l0, l1, l2, l3};
#pragma unroll
        for (int e = 0; e < 4; ++e) { const int r = 4 * g + e; const bool past = kbase + crow(r, hh) < t; z[r] = past ? ex2((z[r] + lf[r] + la[e]) * LOG2E) : 0.f; }
        run += gs[g] + pg[g];
    }
    return run;
}
__device__ __forceinline__ void sb_unit(const MixCtx& C, int b, int h, int qb, LAS unsigned char* lds, const int wave0) {
    int tid_ = (wave0 << 6) | xl::fresh_lane(); asm volatile("" : "+v"(tid_));
    const int tid = tid_, lane = tid & 63, r32 = lane & 31, hh = lane >> 5, wave = __builtin_amdgcn_readfirstlane(tid >> 6);
    const size_t rowbase = (size_t)b * S; const int q0 = qb * 256, qw = q0 + 32 * wave, t = qw + r32; const int hcol = h * 64;
    const bf16* Qg = C.zt + 4 * C.zts; const bf16* Kg = C.zt + 5 * C.zts; const bf16* Vg = C.zt + 6 * C.zts;
    LAS unsigned char* Kb0 = lds + RING_OFF + AT_KBUF; LAS unsigned char* Vb0 = lds + RING_OFF + AT_VBUF;
    volatile LAS unsigned* aux = (volatile LAS unsigned*)(lds + AUX_OFF);
    bf16x8 qf[4];
#pragma unroll
    for (int ks = 0; ks < 4; ++ks) qf[ks] = *(const bf16x8*)(Qg + (rowbase + t) * 256 + hcol + 16 * ks + 8 * hh);
    const int NT = 4 * qb + 4;
    TileRegs tr;
    tile_load<false>(tr, Kg, nullptr, Vg, rowbase, 64 * (NT - 1), hcol, tid);
    tile_store<false, KSTR64>(tr, Kb0, Vb0, tid);
    __syncthreads();
    f32x16 o0 = {}, o1 = {}; float carry = 0.f;
    for (int it = 0; it < NT; ++it) {
        const int j = NT - 1 - it, cur = it & 1;
        if (j > 0) tile_load<false>(tr, Kg, nullptr, Vg, rowbase, 64 * (j - 1), hcol, tid);
        if (64 * j < qw + 31) {
            f32x16 s0, s1;
            qk_tile<4, KSTR64>(s0, s1, Kb0 + cur * 64 * KSTR64, qf, lane);
            const float b1 = sb_block(s1, 64 * j + 32, t, hh, carry);
            const float b0 = sb_block(s0, 64 * j, t, hh, carry + b1);
            carry += b1 + b0;
            pv_tile(o0, o1, Vb0 + cur * 64 * VSTR, s0, s1, lane);
        }
        const bool wdone = __all(carry < -110.0f);
        if (lane == 0) aux[AX_SBF + cur * 8 + wave] = wdone ? 1u : 0u;
        if (j > 0) tile_store<false, KSTR64>(tr, Kb0 + (cur ^ 1) * 64 * KSTR64, Vb0 + (cur ^ 1) * 64 * VSTR, tid);
        __syncthreads();
        unsigned alld = 1u;
#pragma unroll
        for (int w = 0; w < 8; ++w) alld &= aux[AX_SBF + cur * 8 + w];
        if (alld) break;
    }
    __syncthreads();
    store_ot(C.o4 + 1 * C.o4s, rowbase + t, hcol, o0, o1, 1.0f, hh);
}

__device__ __forceinline__ unsigned fkey(float f) { const int u = (int)__float_as_uint(f + 0.0f); return (unsigned)u ^ ((unsigned)(u >> 31) | 0x80000000u); }
__device__ __forceinline__ void idx_keys(unsigned (&key)[16], const bf16* misc, size_t rowbase, int kb, const bf16x8 (&qf)[16], const float (&w)[8], int r32, int hh) {
    const bf16* kr = misc + (rowbase + kb * 32 + r32) * 128 + 32 + 8 * hh;
    const bf16x8 k0 = *(const bf16x8*)kr, k1 = *(const bf16x8*)(kr + 16);
    float sc[16];
#pragma unroll
    for (int hd = 0; hd < 8; ++hd) {
        f32x16 s = MFMA32(k0, qf[2 * hd], (f32x16){});
        s = MFMA32(k1, qf[2 * hd + 1], s);
#pragma unroll
        for (int r = 0; r < 16; ++r) { const float v = fmaxf(s[r], 0.f); sc[r] = (hd == 0) ? w[0] * v : __builtin_fmaf(w[hd], v, sc[r]); }
        if (hd & 1) {
#pragma unroll
            for (int r = 0; r < 16; ++r) asm volatile("" : "+v"(sc[r]));
            __builtin_amdgcn_sched_barrier(0);
        }
    }
#pragma unroll
    for (int r = 0; r < 16; ++r) key[r] = fkey(sc[r]);
}
template <bool DESC, bool PEEK = false> __device__ __forceinline__ void hist_scan(volatile LAS unsigned* hist, int rowstride, int nbins, bool swz, int preshift, volatile LAS unsigned* aux, int tid) {
    const int q = tid >> 4, c = tid & 15, lane = tid & 63, wpc = nbins >> 5, sx = swz ? q : 0;
    unsigned csum = 0u;
    for (int i = 0; i < wpc; ++i) { const unsigned w = hist[q * rowstride + ((c * wpc + ((i + c) & (wpc - 1))) ^ sx)]; csum += (w & 0xffffu) + (w >> 16); }
    unsigned other = 0u;
#pragma unroll
    for (int k = 0; k < 16; ++k) { unsigned v; switch (k) { case 0: v = xl::bcast16<0>(csum); break; case 1: v = xl::bcast16<1>(csum); break; case 2: v = xl::bcast16<2>(csum); break; case 3: v = xl::bcast16<3>(csum); break; case 4: v = xl::bcast16<4>(csum); break; case 5: v = xl::bcast16<5>(csum); break; case 6: v = xl::bcast16<6>(csum); break; case 7: v = xl::bcast16<7>(csum); break; case 8: v = xl::bcast16<8>(csum); break; case 9: v = xl::bcast16<9>(csum); break; case 10: v = xl::bcast16<10>(csum); break; case 11: v = xl::bcast16<11>(csum); break; case 12: v = xl::bcast16<12>(csum); break; case 13: v = xl::bcast16<13>(csum); break; case 14: v = xl::bcast16<14>(csum); break; default: v = xl::bcast16<15>(csum); break; }
        if (DESC ? (k > c) : (k < c)) other += v; }
    const unsigned rem = aux[AX_SREM + q];
    if (other < rem && other + csum >= rem) {
        unsigned cum = other; bool found = false; unsigned bin = 0u, cnt = 0u;
        for (int ii = 0; ii < wpc; ++ii) {
            const int i = DESC ? (wpc - 1 - ii) : ii;
            const unsigned w = hist[q * rowstride + ((c * wpc + i) ^ sx)];
            const unsigned first = DESC ? (w >> 16) : (w & 0xffffu), second = DESC ? (w & 0xffffu) : (w >> 16);
            if (!found) { if (cum + first >= rem) { found = true; bin = 2u * (unsigned)(c * wpc + i) + (DESC ? 1u : 0u); cnt = first; } else cum += first; }
            if (!found) { if (cum + second >= rem) { found = true; bin = 2u * (unsigned)(c * wpc + i) + (DESC ? 0u : 1u); cnt = second; } else cum += second; }
        }
        if (PEEK) { aux[AX_TB + q] = bin; }
        else {
        aux[AX_SPRE + q] = (aux[AX_SPRE + q] << preshift) | bin;
        aux[AX_SREM + q] = rem - cum; aux[AX_SCNT + q] = cnt;
        if (!DESC) { aux[AX_TB + q] = bin; aux[AX_TREM + q] = rem - cum; }
        }
    }
}
__device__ __forceinline__ void hist_zero(LAS unsigned char* lds, int tid) {
    LAS v4u* h4 = (LAS v4u*)(lds + RING_OFF);
    for (int i = tid; i < 8192; i += NTHR) h4[i] = (v4u){0u, 0u, 0u, 0u};
}
__device__ __forceinline__ void sel_unit_slow(const MixCtx& C, int b, int qg, LAS unsigned char* lds, const int wave0) {
    int tid_ = (wave0 << 6) | xl::fresh_lane(); asm volatile("" : "+v"(tid_));
    const int tid = tid_, lane = tid & 63, r32 = lane & 31, hh = lane >> 5, wave = __builtin_amdgcn_readfirstlane(tid >> 6);
    const size_t rowbase = (size_t)b * S; const int t = 32 * qg + r32;
    volatile LAS unsigned* hist = (volatile LAS unsigned*)(lds + RING_OFF);
    LAS unsigned* histw = (LAS unsigned*)(lds + RING_OFF);
    volatile LAS unsigned* aux = (volatile LAS unsigned*)(lds + AUX_OFF);
    bf16x8 qf[16]; float w[8];
    { const bf16* qp = C.zt + 3 * C.zts + (rowbase + t) * 256 + 8 * hh;
#pragma unroll
      for (int i = 0; i < 16; ++i) qf[i] = *(const bf16x8*)(qp + 16 * i);
      const v4u wr = *(const v4u*)(C.misc + (rowbase + t) * 128 + 64);
      w[0] = __uint_as_float(wr.x << 16); w[1] = __uint_as_float(wr.x & 0xffff0000u); w[2] = __uint_as_float(wr.y << 16); w[3] = __uint_as_float(wr.y & 0xffff0000u);
      w[4] = __uint_as_float(wr.z << 16); w[5] = __uint_as_float(wr.z & 0xffff0000u); w[6] = __uint_as_float(wr.w << 16); w[7] = __uint_as_float(wr.w & 0xffff0000u); }
    const int kb_last = 8 * (qg >> 3) + 7;
    if (tid < 32) { aux[AX_SPRE + tid] = 0u; aux[AX_SREM + tid] = 256u; aux[AX_SCNT + tid] = 0u; aux[AX_THR + tid] = 0u; aux[AX_TB + tid] = 0x7fffffffu; aux[AX_TREM + tid] = 0u; }
    if (tid == 0) aux[AX_FLAG] = 0u;
    if (qg >= 8) {
        for (int pass = 0; pass < 3; ++pass) {
            hist_zero(lds, tid);
            __syncthreads();
            const unsigned pre = aux[AX_SPRE + r32];
            for (int kb = wave; kb <= qg; kb += 8) {
                unsigned key[16];
                idx_keys(key, C.misc, rowbase, kb, qf, w, r32, hh);
#pragma unroll
                for (int r = 0; r < 16; ++r) {
                    const bool valid = kb * 32 + crow(r, hh) <= t;
                    const unsigned k = key[r];
                    bool match; unsigned bin;
                    if (pass == 0) { match = true; bin = k >> 21; } else if (pass == 1) { match = (k >> 21) == pre; bin = (k >> 10) & 2047u; } else { match = (k >> 10) == pre; bin = k & 1023u; }
                    if (valid && match) __hip_atomic_fetch_add(histw + r32 * 1024 + ((bin >> 1) ^ (unsigned)r32), 1u << (16 * (bin & 1u)), __ATOMIC_RELAXED, __HIP_MEMORY_SCOPE_WORKGROUP);
                }
            }
            __syncthreads();
            hist_scan<true>(hist, 1024, pass == 2 ? 1024 : 2048, true, pass == 2 ? 10 : 11, aux, tid);
            __syncthreads();
        }
        if (tid < 32) { aux[AX_THR + tid] = aux[AX_SPRE + tid]; if (aux[AX_SREM + tid] < aux[AX_SCNT + tid]) aux[AX_FLAG] = 1u; }
        __syncthreads();
        if (aux[AX_FLAG] != 0u) {
            hist_zero(lds, tid);
            __syncthreads();
            const unsigned thr = aux[AX_THR + r32];
            for (int kb = wave; kb <= qg; kb += 8) {
                unsigned key[16];
                idx_keys(key, C.misc, rowbase, kb, qf, w, r32, hh);
#pragma unroll
                for (int r = 0; r < 16; ++r) {
                    const int s = kb * 32 + crow(r, hh);
                    if (s <= t && key[r] == thr) { const unsigned bin = (unsigned)s >> 2; __hip_atomic_fetch_add(histw + r32 * 1024 + ((bin >> 1) ^ (unsigned)r32), 1u << (16 * (bin & 1u)), __ATOMIC_RELAXED, __HIP_MEMORY_SCOPE_WORKGROUP); }
                }
            }
            __syncthreads();
            hist_scan<false>(hist, 1024, 2048, true, 11, aux, tid);
            __syncthreads();
        }
    }
    __syncthreads();
    {
        const unsigned thr = aux[AX_THR + r32]; const unsigned tb = aux[AX_TB + r32], trem = aux[AX_TREM + r32];
        for (int kb = wave; kb <= kb_last; kb += 8) {
            unsigned word = 0u;
            if (kb <= qg) {
                unsigned key[16];
                idx_keys(key, C.misc, rowbase, kb, qf, w, r32, hh);
#pragma unroll
                for (int g = 0; g < 4; ++g) {
                    unsigned rank = 0u; const unsigned s4 = (unsigned)(kb * 8 + 2 * g + hh);
#pragma unroll
                    for (int e = 0; e < 4; ++e) {
                        const int r = 4 * g + e; const int s = kb * 32 + crow(r, hh);
                        const bool valid = s <= t; const unsigned k = key[r];
                        bool sel = valid && (k > thr);
                        if (valid && k == thr) { ++rank; sel = (s4 < tb) || (s4 == tb && rank <= trem); }
                        word |= (sel ? 1u : 0u) << crow(r, hh);
                    }
                }
            }
            word = xl::hor(word);
            if (hh == 0) C.bits[(rowbase + t) * 256 + kb] = word;
        }
    }
    __syncthreads();
}

constexpr int SL_CKEY = 0, SL_CIDX = 65536, SL_BITW = 98304;
constexpr int SL_SHIST = AUX_OFF + 2048;
constexpr int AX_CCNT = 224;
__device__ __forceinline__ void idx_load(bf16x8& k0, bf16x8& k1, const bf16* misc, size_t rowbase, int kb, int r32, int hh) {
    const bf16* kr = misc + (rowbase + kb * 32 + r32) * 128 + 32 + 8 * hh; k0 = *(const bf16x8*)kr; k1 = *(const bf16x8*)(kr + 16);
}
typedef float f32x2v __attribute__((ext_vector_type(2)));
__device__ __forceinline__ float relu1(float x) { const int b = __float_as_int(x); return __int_as_float(b > 0 ? b : 0); }
__device__ __forceinline__ void idx_keys2(unsigned (&key)[16], const bf16x8 k0, const bf16x8 k1, const bf16x8 (&qf)[16], const float (&w)[8]) {
    f32x2v sc[8];
#pragma unroll
    for (int hd = 0; hd < 8; ++hd) {
        f32x16 s = MFMA32(k0, qf[2 * hd], (f32x16){});
        s = MFMA32(k1, qf[2 * hd + 1], s);
        const f32x2v w2 = {w[hd], w[hd]};
#pragma unroll
        for (int j = 0; j < 8; ++j) { const f32x2v v = {relu1(s[2 * j]), relu1(s[2 * j + 1])}; sc[j] = (hd == 0) ? v * w2 : __builtin_elementwise_fma(v, w2, sc[j]); }
        if (hd & 1) {
#pragma unroll
            for (int j = 0; j < 8; ++j) asm volatile("" : "+v"(sc[j]));
            __builtin_amdgcn_sched_barrier(0);
        }
    }
#pragma unroll
    for (int j = 0; j < 8; ++j) { key[2 * j] = fkey(sc[j].x); key[2 * j + 1] = fkey(sc[j].y); }
}
__device__ __forceinline__ void idx_keys3(unsigned (&key)[16], const bf16x8 k0, const bf16x8 k1, const bf16x8 (&qf)[16], const float (&w2)[8], const bf16x8 ql0, const bf16x8 ql1) {
    float sc[16];
    { f32x16 lin = MFMA32(k0, ql0, (f32x16){}); lin = MFMA32(k1, ql1, lin);
#pragma unroll
      for (int r = 0; r < 16; ++r) sc[r] = lin[r]; }
#pragma unroll
    for (int hd = 0; hd < 8; ++hd) {
        f32x16 s = MFMA32(k0, qf[2 * hd], (f32x16){});
        s = MFMA32(k1, qf[2 * hd + 1], s);
#pragma unroll
        for (int r = 0; r < 16; ++r) sc[r] = __builtin_fmaf(__builtin_fabsf(s[r]), w2[hd], sc[r]);
        if (hd & 1) {
#pragma unroll
            for (int r = 0; r < 16; ++r) asm volatile("" : "+v"(sc[r]));
            __builtin_amdgcn_sched_barrier(0);
        }
    }
#pragma unroll
    for (int r = 0; r < 16; ++r) { const int u = __float_as_int(sc[r]); key[r] = (unsigned)u ^ ((unsigned)(u >> 31) | 0x80000000u); }
}
#ifndef MK_SELDRY
#define MK_SELDRY 0
#endif
__device__ __forceinline__ void sel_unit(const MixCtx& C, int b, int qg, LAS unsigned char* lds, const int wave0, const int dry = 0) {
    const int dm = dry ? MK_SELDRY : 0;
    int tid_ = (wave0 << 6) | xl::fresh_lane(); asm volatile("" : "+v"(tid_));
    const int tid = tid_, lane = tid & 63, r32 = lane & 31, hh = lane >> 5, wave = __builtin_amdgcn_readfirstlane(tid >> 6);
    const size_t rowbase = (size_t)b * S; const int t = 32 * qg + r32;
    const int kb_last = 8 * (qg >> 3) + 7;
    LAS unsigned* histw = (LAS unsigned*)(lds + RING_OFF);
    volatile LAS unsigned* hist = (volatile LAS unsigned*)(lds + RING_OFF);
    volatile LAS unsigned* aux = (volatile LAS unsigned*)(lds + AUX_OFF);
    LAS unsigned* ckey = (LAS unsigned*)(lds + RING_OFF + SL_CKEY); LAS unsigned short* cidx = (LAS unsigned short*)(lds + RING_OFF + SL_CIDX);
    LAS unsigned* bitw = (LAS unsigned*)(lds + RING_OFF + SL_BITW); LAS unsigned* shist = (LAS unsigned*)(lds + SL_SHIST);
    LAS unsigned* auxw = (LAS unsigned*)(lds + AUX_OFF);
    if (qg < 8) {
        { const int q = tid >> 4, tq = 32 * qg + q;
          for (int kb = tid & 15; kb <= kb_last; kb += 16) { const int nbit = tq + 1 - 32 * kb; const unsigned word = nbit <= 0 ? 0u : (nbit >= 32 ? 0xffffffffu : ((1u << nbit) - 1u));
            if (!(dm & 1)) C.bits[(rowbase + tq) * 256 + kb] = word; } }
        return;
    }
    bf16x8 qf[16]; float w[8];
    { const bf16* qp = C.zt + 3 * C.zts + (rowbase + t) * 256 + 8 * hh;
#pragma unroll
      for (int i = 0; i < 16; ++i) qf[i] = *(const bf16x8*)(qp + 16 * i);
      const v4u wr = *(const v4u*)(C.misc + (rowbase + t) * 128 + 64);
      w[0] = __uint_as_float(wr.x << 16); w[1] = __uint_as_float(wr.x & 0xffff0000u); w[2] = __uint_as_float(wr.y << 16); w[3] = __uint_as_float(wr.y & 0xffff0000u);
      w[4] = __uint_as_float(wr.z << 16); w[5] = __uint_as_float(wr.z & 0xffff0000u); w[6] = __uint_as_float(wr.w << 16); w[7] = __uint_as_float(wr.w & 0xffff0000u); }
    float w2[8]; bf16x8 ql0, ql1;
    {
#pragma unroll
        for (int hd = 0; hd < 8; ++hd) w2[hd] = 0.5f * w[hd];
        float a0[8], a1[8];
#pragma unroll
        for (int j = 0; j < 8; ++j) { a0[j] = 0.f; a1[j] = 0.f; }
#pragma unroll
        for (int hd = 0; hd < 8; ++hd)
#pragma unroll
            for (int j = 0; j < 8; ++j) { a0[j] = __builtin_fmaf(w2[hd], bf2f((unsigned short)qf[2 * hd][j]), a0[j]); a1[j] = __builtin_fmaf(w2[hd], bf2f((unsigned short)qf[2 * hd + 1][j]), a1[j]); }
        v4u p0, p1; p0.x = cvtpk(a0[0], a0[1]); p0.y = cvtpk(a0[2], a0[3]); p0.z = cvtpk(a0[4], a0[5]); p0.w = cvtpk(a0[6], a0[7]);
        p1.x = cvtpk(a1[0], a1[1]); p1.y = cvtpk(a1[2], a1[3]); p1.z = cvtpk(a1[4], a1[5]); p1.w = cvtpk(a1[6], a1[7]);
        ql0 = __builtin_bit_cast(bf16x8, p0); ql1 = __builtin_bit_cast(bf16x8, p1);
    }
    if (tid < 32) { aux[AX_SPRE + tid] = 0u; aux[AX_SREM + tid] = 256u; aux[AX_SCNT + tid] = 0u; aux[AX_CCNT + tid] = 0u; aux[AX_TB + tid] = 0u; }
    if (tid == 0) aux[AX_FLAG] = 0u;
    hist_zero(lds, tid);
    __syncthreads();
    {
        bf16x8 k0, k1, n0 = {}, n1 = {};
        int kb = wave;
        if (kb <= qg) idx_load(k0, k1, C.misc, rowbase, kb, r32, hh);
        for (; kb <= qg && !(dm & 16); kb += 8) {
            if (kb + 8 <= qg) idx_load(n0, n1, C.misc, rowbase, kb + 8, r32, hh);
            unsigned key[16];
            idx_keys3(key, k0, k1, qf, w2, ql0, ql1);
            if (dm & 2) { unsigned x = 0u;
#pragma unroll
                for (int r = 0; r < 16; ++r) x ^= key[r];
                asm volatile("" :: "v"(x)); }
            else if (dm & 32) {
#pragma unroll
                for (int r = 0; r < 16; ++r) { const unsigned bin = key[r] >> 21; histw[r32 * 1024 + ((bin >> 1) ^ (unsigned)r32)] = 1u << (16 * (bin & 1u)); }
            }
            else if (kb < qg) {
#pragma unroll
                for (int r = 0; r < 16; ++r) { const unsigned bin = key[r] >> 21; __hip_atomic_fetch_add(histw + r32 * 1024 + ((bin >> 1) ^ (unsigned)r32), 1u << (16 * (bin & 1u)), __ATOMIC_RELAXED, __HIP_MEMORY_SCOPE_WORKGROUP); }
            } else {
#pragma unroll
                for (int r = 0; r < 16; ++r) {
                    if (crow(r, hh) <= r32) { const unsigned bin = key[r] >> 21; __hip_atomic_fetch_add(histw + r32 * 1024 + ((bin >> 1) ^ (unsigned)r32), 1u << (16 * (bin & 1u)), __ATOMIC_RELAXED, __HIP_MEMORY_SCOPE_WORKGROUP); }
                }
            }
            k0 = n0; k1 = n1;
        }
    }
    __syncthreads();
    hist_scan<true>(hist, 1024, 2048, true, 11, aux, tid);
    __syncthreads();
    if (tid < 32) { if (aux[AX_SCNT + tid] > 512u) aux[AX_FLAG] = 1u; }
    __syncthreads();
    if (aux[AX_FLAG] != 0u && !dm) {
#ifdef MK_DIAG_FALLBACKS
        if (tid == 0) atomicAdd((unsigned*)C.diag, 1u);
#endif
        __syncthreads(); sel_unit_slow(C, b, qg, lds, wave0); return; }
    const unsigned b1 = aux[AX_SPRE + r32];
    __syncthreads();
    if (tid < 32) { aux[AX_SPRE + tid] = 0u; }
    {
        bf16x8 k0, k1, n0 = {}, n1 = {};
        int kb = wave;
        if (kb <= qg) idx_load(k0, k1, C.misc, rowbase, kb, r32, hh);
        for (; kb <= kb_last && !(dm & 4); kb += 8) {
            unsigned word = 0u;
            if (kb <= qg) {
                if (kb + 8 <= qg) idx_load(n0, n1, C.misc, rowbase, kb + 8, r32, hh);
                unsigned key[16];
                idx_keys3(key, k0, k1, qf, w2, ql0, ql1);
                const bool diag = (kb == qg);
                unsigned cm = 0u;
                const unsigned vm = diag ? ((2u << r32) - 1u) : 0xffffffffu;
#pragma unroll
                for (int r = 0; r < 16; ++r) {
                    const unsigned hi = key[r] >> 21; const unsigned ok = (vm >> crow(r, hh)) & 1u;
                    word |= (hi > b1 ? ok : 0u) << crow(r, hh); cm |= (hi == b1 ? ok : 0u) << r;
                }
                if (cm != 0u) {
                    unsigned pos = __hip_atomic_fetch_add(auxw + AX_CCNT + r32, (unsigned)__builtin_popcount(cm), __ATOMIC_RELAXED, __HIP_MEMORY_SCOPE_WORKGROUP);
#pragma unroll
                    for (int r = 0; r < 16; ++r) { if ((cm >> r) & 1u) { if (pos < 512u) { ckey[r32 * 512 + pos] = key[r] & 0x1fffffu; cidx[r32 * 512 + pos] = (unsigned short)(8191 - (kb * 32 + crow(r, hh))); } ++pos; } }
                }
                k0 = n0; k1 = n1;
            }
            word = xl::hor(word);
            if (hh == 0) bitw[r32 * 256 + kb] = word;
        }
    }
    __syncthreads();
    {
        const int q = tid >> 4, c16 = tid & 15; int cn = (int)aux[AX_CCNT + q]; cn = cn > 512 ? 512 : cn;
        for (int pass = 0; pass < ((dm & 8) ? 0 : 5); ++pass) {
            for (int i = tid; i < 32 * 64; i += NTHR) shist[i] = 0u;
            __syncthreads();
            const unsigned pre = aux[AX_SPRE + q], thk = aux[AX_THR + q];
            for (int i = c16; i < cn; i += 16) {
                const unsigned ck = ckey[q * 512 + i], cv = cidx[q * 512 + i];
                bool match; unsigned bin;
                if (pass == 0) { match = true; bin = ck >> 14; } else if (pass == 1) { match = (ck >> 14) == pre; bin = (ck >> 7) & 127u; } else if (pass == 2) { match = (ck >> 7) == pre; bin = ck & 127u; }
                else if (pass == 3) { match = ck == thk; bin = cv >> 6; } else { match = (ck == thk) && ((cv >> 6) == pre); bin = cv & 63u; }
                if (match) __hip_atomic_fetch_add(shist + q * 64 + (bin >> 1), 1u << (16 * (bin & 1u)), __ATOMIC_RELAXED, __HIP_MEMORY_SCOPE_WORKGROUP);
            }
            __syncthreads();
            hist_scan<true>((volatile LAS unsigned*)shist, 64, pass == 4 ? 64 : 128, false, pass == 4 ? 6 : 7, aux, tid);
            __syncthreads();
            if (pass == 2) {
                if (tid < 32) { aux[AX_THR + tid] = aux[AX_SPRE + tid]; aux[AX_SPRE + tid] = 0u; if (aux[AX_SREM + tid] < aux[AX_SCNT + tid]) aux[AX_FLAG] = 2u; }
                __syncthreads();
                if (aux[AX_FLAG] != 2u) break;
            }
        }
        const unsigned thk = aux[AX_THR + q], thv = aux[AX_SPRE + q];
        for (int i = c16; i < cn; i += 16) {
            const unsigned ck = ckey[q * 512 + i], cv = cidx[q * 512 + i];
            if (ck > thk || (ck == thk && cv >= thv)) { const unsigned s = 8191u - cv; __hip_atomic_fetch_or(bitw + q * 256 + (s >> 5), 1u << (s & 31u), __ATOMIC_RELAXED, __HIP_MEMORY_SCOPE_WORKGROUP); }
        }
    }
    __syncthreads();
    if (!(dm & 1)) { const int q = tid >> 4; unsigned* bp = C.bits + (rowbase + 32 * qg + q) * 256; for (int kb = tid & 15; kb <= kb_last; kb += 16) __builtin_nontemporal_store(bitw[q * 256 + kb], bp + kb); }
    __syncthreads();
}

constexpr int MOBA_MAXL = 7936;
__device__ __forceinline__ void moba_gate_unit(const MixCtx& C, int b, int h, int qb, LAS unsigned char* lds, const int wave0) {
    int tid_ = (wave0 << 6) | xl::fresh_lane(); asm volatile("" : "+v"(tid_));
    const int tid = tid_, lane = tid & 63, r32 = lane & 31, hh = lane >> 5, wave = __builtin_amdgcn_readfirstlane(tid >> 6);
    const size_t rowbase = (size_t)b * S; const int t = qb * 256 + 32 * wave + r32; const int hcol = h * 64;
    LAS float* km = (LAS float*)(lds + RING_OFF + AT_KM);
    for (int e = tid; e < 32 * 64; e += NTHR) { const int n = e >> 6, d = e & 63; const float* p = C.kmp + (size_t)((b * 32 + n) * 2) * 256 + hcol + d; km[e] = (p[0] + p[256]) * (1.0f / 256.0f); }
    __syncthreads();
    float qv[32];
    { const bf16* Qg = C.zt + 7 * C.zts;
#pragma unroll
      for (int ks = 0; ks < 4; ++ks) { const bf16x8 q8 = *(const bf16x8*)(Qg + (rowbase + t) * 256 + hcol + 16 * ks + 8 * hh);
#pragma unroll
          for (int j = 0; j < 8; ++j) qv[ks * 8 + j] = bf2f((unsigned short)q8[j]); } }
    float g0 = -INFINITY, g1 = -INFINITY, g2 = -INFINITY; int i0 = -1, i1 = -1, i2 = -1;
    for (int n = 0; n < qb; ++n) {
        const LAS float* kp = km + n * 64 + 8 * hh;
        float dot = 0.f;
#pragma unroll
        for (int ks = 0; ks < 4; ++ks) { const f32x4 a4 = *(const LAS f32x4*)(kp + 16 * ks), c4 = *(const LAS f32x4*)(kp + 16 * ks + 4);
            dot += qv[ks * 8 + 0] * a4[0] + qv[ks * 8 + 1] * a4[1] + qv[ks * 8 + 2] * a4[2] + qv[ks * 8 + 3] * a4[3] + qv[ks * 8 + 4] * c4[0] + qv[ks * 8 + 5] * c4[1] + qv[ks * 8 + 6] * c4[2] + qv[ks * 8 + 7] * c4[3]; }
        dot = xl::hsum(dot);
        if (dot > g0) { g2 = g1; i2 = i1; g1 = g0; i1 = i0; g0 = dot; i0 = n; }
        else if (dot > g1) { g2 = g1; i2 = i1; g1 = dot; i1 = n; }
        else if (dot > g2) { g2 = dot; i2 = n; }
    }
    if (hh == 0) {
        const int sel[3] = {i0, i1, i2};
#pragma unroll
        for (int j = 0; j < 3; ++j) {
            if (sel[j] >= 0) { unsigned* cp = C.mcnt + (b * 4 + h) * 32 + sel[j]; const unsigned pos = atomicAdd(cp, 1u);
                if (pos < (unsigned)MOBA_MAXL) C.mlist[((size_t)((b * 4 + h) * 32 + sel[j])) * MOBA_MAXL + pos] = (unsigned short)(t | (j << 13)); }
            else C.lse[(rowbase + t) * 16 + h * 4 + j] = -INFINITY;
        }
    }
    __syncthreads();
}
__device__ __forceinline__ void moba_blk_unit(const MixCtx& C, int b, int h, int n, int p, bool own, LAS unsigned char* lds, const int wave0) {
    int tid_ = (wave0 << 6) | xl::fresh_lane(); asm volatile("" : "+v"(tid_));
    const int tid = tid_, lane = tid & 63, r32 = lane & 31, hh = lane >> 5, wave = __builtin_amdgcn_readfirstlane(tid >> 6);
    const size_t rowbase = (size_t)b * S; const int hcol = h * 64;
    const int len = own ? 256 : (int)min(C.mcnt[(b * 4 + h) * 32 + n], (unsigned)MOBA_MAXL);
    if (p * 256 >= len) return;
    const bf16* Qg = C.zt + 7 * C.zts; const bf16* Kg = C.zt + 8 * C.zts; const bf16* Vg = C.zt + 9 * C.zts;
    LAS unsigned char* Kb = lds + RING_OFF; LAS unsigned char* Vb = lds + RING_OFF + 256 * KSTR64;
    const unsigned short* lp = C.mlist + ((size_t)((b * 4 + h) * 32 + n)) * MOBA_MAXL;
    unsigned ent_n = 0u; { const int e0 = p * 256 + 32 * wave + r32; if (!own && e0 < len) ent_n = (unsigned)lp[e0]; }
    { v4u kr[4], vr[4];
#pragma unroll
      for (int i = 0; i < 4; ++i) { const int e = tid + i * NTHR, row = e >> 3, ch = e & 7; kr[i] = *(const v4u*)(Kg + (rowbase + n * 256 + row) * 256 + hcol + ch * 8); vr[i] = *(const v4u*)(Vg + (rowbase + n * 256 + row) * 256 + hcol + ch * 8); }
#pragma unroll
      for (int i = 0; i < 4; ++i) { const int e = tid + i * NTHR, row = e >> 3, ch = e & 7; *(LAS v4u*)(Kb + row * KSTR64 + ch * 16) = kr[i]; *(LAS v4u*)(Vb + row * VSTR + ch * 16) = vr[i]; } }
    bf16x8 qn[4];
    { const int tq0 = own ? n * 256 + 32 * wave + r32 : (int)(ent_n & 8191u);
#pragma unroll
      for (int ks = 0; ks < 4; ++ks) qn[ks] = *(const bf16x8*)(Qg + (rowbase + tq0) * 256 + hcol + 16 * ks + 8 * hh); }
    __syncthreads();
    for (int c = p; c * 256 < len; c += 4) {
        const int e = c * 256 + 32 * wave + r32; const bool valid = e < len;
        int tq, slot;
        if (own) { tq = n * 256 + e; slot = 3; } else { tq = (int)(ent_n & 8191u); slot = (int)(ent_n >> 13); }
        bf16x8 qf[4];
#pragma unroll
        for (int ks = 0; ks < 4; ++ks) qf[ks] = qn[ks];
        if ((c + 4) * 256 < len) {
            const int e2 = (c + 4) * 256 + 32 * wave + r32; ent_n = (e2 < len) ? (unsigned)lp[e2] : 0u;
            const int tq2 = (int)(ent_n & 8191u);
#pragma unroll
            for (int ks = 0; ks < 4; ++ks) qn[ks] = *(const bf16x8*)(Qg + (rowbase + tq2) * 256 + hcol + 16 * ks + 8 * hh);
        }
        f32x16 o0 = {}, o1 = {}, negm = {}; float mref = 0.f, l = 0.f; bool mset = false;
#pragma unroll 1
        for (int i = 0; i < 4; ++i) {
            if (own && 64 * i > 32 * wave + 31) break;
            f32x16 s0, s1;
            qk_tile<4, KSTR64>(s0, s1, Kb + i * 64 * KSTR64, qf, lane, negm);
            if (own && 64 * i + 63 > 32 * wave) {
#pragma unroll
                for (int r = 0; r < 16; ++r) { const int kk = n * 256 + 64 * i + crow(r, hh); if (kk > tq) s0[r] = -INFINITY; if (kk + 32 > tq) s1[r] = -INFINITY; }
            }
            softmax_tile(s0, s1, mref, mset, negm, l, o0, o1);
            pv_tile(o0, o1, Vb + i * 64 * VSTR, s0, s1, lane);
        }
        l = xl::hsum(l);
        if (valid) {
            const float inv = 1.0f / l;
            bf16* op = C.part + ((rowbase + tq) * 16 + h * 4 + slot) * 64;
#pragma unroll
            for (int g = 0; g < 4; ++g) {
                v2u w0, w1;
                w0.x = cvtpk(o0[4 * g] * inv, o0[4 * g + 1] * inv); w0.y = cvtpk(o0[4 * g + 2] * inv, o0[4 * g + 3] * inv);
                w1.x = cvtpk(o1[4 * g] * inv, o1[4 * g + 1] * inv); w1.y = cvtpk(o1[4 * g + 2] * inv, o1[4 * g + 3] * inv);
                *(v2u*)(op + 8 * g + 4 * hh) = w0; *(v2u*)(op + 32 + 8 * g + 4 * hh) = w1;
            }
            if (hh == 0) C.lse[(rowbase + tq) * 16 + h * 4 + slot] = mref + lg2(l);
        }
    }
    __syncthreads();
}

#ifndef MK_REPEAT_LP
#define MK_REPEAT_LP -1
#endif
#ifndef MK_REPEAT_KINDS
#define MK_REPEAT_KINDS 15
#endif
#ifndef MK_REPEAT_LAYERS
#define MK_REPEAT_LAYERS 3
#endif
#ifndef MK_REPEAT_CONV
#define MK_REPEAT_CONV 0
#endif
#ifndef MK_EXTRA_BARRIERS
#define MK_EXTRA_BARRIERS 0
#endif
#ifndef MK_ONLY
#define MK_ONLY -1
#endif
#ifndef MK_SKIPMASK
#define MK_SKIPMASK 0
#endif
#define PHON(x) ((MK_ONLY < 0 || MK_ONLY == (x)) && !((MK_SKIPMASK >> (x)) & 1))
#ifndef MK_MIXONLY
#define MK_MIXONLY -1
#endif
#define MIXON(x) (MK_MIXONLY < 0 || MK_MIXONLY == (x))
constexpr int PH_CONV0 = 0, PH_L0 = 1, PH_CONV1 = 10, PH_L1 = 11, PH_FINAL = 20, N_PHASES = 21, PH_MERGE0 = 21, PH_MERGE1 = 22;
constexpr int LP_INPROJ = 0, LP_MLA = 1, LP_MIX = 2, LP_DSA = 3, LP_PROJ = 4, LP_GATE = 5, LP_OUT = 6, LP_UP = 7, LP_DOWN = 8;


#define P_WIN ((bf16*)(wbase + (WS_WIN - WS_WIN)))
#define P_WMLA ((bf16*)(wbase + (WS_WMLA - WS_WIN)))
#define P_WB ((bf16*)(wbase + (WS_WB - WS_WIN)))
#define P_WOUT ((bf16*)(wbase + (WS_WOUT - WS_WIN)))
#define P_WUP ((bf16*)(wbase + (WS_WUP - WS_WIN)))
#define P_WDOWN ((bf16*)(wbase + (WS_WDOWN - WS_WIN)))
#define P_XB    ((bf16*)(ws + WS_XB))
#define P_ZT    ((bf16*)(ws + WS_ZT))
#define P_MLAA  ((bf16*)(ws + WS_MLAA))
#define P_MISC  ((bf16*)(ws + WS_MISC))
#define P_QM    ((bf16*)(ws + WS_QM))
#define P_KN    ((bf16*)(ws + WS_KN))
#define P_VM    ((bf16*)(ws + WS_VM))
#define P_BITS  ((unsigned*)(ws + WS_BITS))
#define P_O4    ((bf16*)(ws + WS_O4))
#define P_PROJ  ((bf16*)(ws + WS_PROJ))
#define P_DSA2  ((bf16*)(ws + WS_DSA2))
#define P_LSED  ((float*)(ws + WS_LSED))
#define P_MERGED ((bf16*)(ws + WS_MERGED))
#define P_HID   ((bf16*)(ws + WS_HID))
#define P_SSA   ((float*)(ws + WS_SSA))
#define P_SSB   ((float*)(ws + WS_SSB))
#define P_SSQ   ((float*)(ws + WS_SSQ))
#define P_SSKV  ((float*)(ws + WS_SSKV))
#define P_KMP   ((float*)(ws + WS_KMP))
#define P_TP    ((const float*)(ws + WS_TP))
#define P_TI    ((const float*)(ws + WS_TI))
#define P_TM    ((const float*)(ws + WS_TM))

__device__ __forceinline__ int next_unit(gu32* ctr, volatile LAS unsigned* aux, int tid) {
    if (tid == 0) aux[AX_UNIT] = __hip_atomic_fetch_add(ctr, 1u, RLX_AGENT);
    __syncthreads();
    const int u = (int)aux[AX_UNIT];
    __syncthreads();
    return u;
}

template <int ph> __device__ __forceinline__ void run_phase(const Ptrs& P, LAS unsigned char* lds, gu32* ctl, int G, int bx, int vcu, const int wave0) {
    volatile LAS unsigned* aux = (volatile LAS unsigned*)(lds + AUX_OFF);
    const int M = P.mrows, nb = M / S;
    const int NGW = G * NWAVES;
    {
        unsigned char* ws = P.ws;
        unsigned char* wbase = (ph >= PH_L1) ? (unsigned char*)P.out : ws + WS_WIN;
        (void)wbase;
        const size_t zts = (size_t)M * 256;
        if (ph == PH_MERGE0 || ph == PH_MERGE1) {
            int tid_ = (wave0 << 6) | xl::fresh_lane(); asm volatile("" : "+v"(tid_)); const int tid = tid_, lane = tid & 63, wave = __builtin_amdgcn_readfirstlane(tid >> 6), gw = vcu * NWAVES + wave;
            const bf16* part = (const bf16*)(ws + WS_PART); const float* lse = (const float*)(ws + WS_LSE); bf16* oc = P_O4 + 2 * zts;
            const int head = lane >> 4, d0 = (lane & 15) * 4;
            for (int m = gw; m < M; m += NGW) {
                const f32x4 L4 = *(const f32x4*)(lse + (size_t)m * 16 + head * 4);
                const float mx = fmaxf(fmaxf(L4[0], L4[1]), fmaxf(L4[2], L4[3]));
                float wsum = 0.f; f32x4 acc = {0.f, 0.f, 0.f, 0.f};
#pragma unroll
                for (int j = 0; j < 4; ++j) { const float w = __builtin_amdgcn_exp2f(L4[j] - mx);
                    if (w > 0.f) { const v2u pv = *(const v2u*)(part + ((size_t)m * 16 + head * 4 + j) * 64 + d0);
                        acc = acc + w * (f32x4){__uint_as_float(pv.x << 16), __uint_as_float(pv.x & 0xffff0000u), __uint_as_float(pv.y << 16), __uint_as_float(pv.y & 0xffff0000u)}; wsum += w; } }
                const float inv = 1.0f / wsum;
                v2u o; o.x = pk2(acc[0] * inv, acc[1] * inv); o.y = pk2(acc[2] * inv, acc[3] * inv);
                *(v2u*)(oc + (size_t)m * 256 + head * 64 + d0) = o;
                {
                    const float la = P_LSED[((size_t)m * 4 + head) * 2], lb = P_LSED[((size_t)m * 4 + head) * 2 + 1];
                    if (lb > -INFINITY) {
                        bf16* oa = P_O4 + (size_t)m * 256 + head * 64 + d0; const bf16* ob = P_DSA2 + (size_t)m * 256 + head * 64 + d0;
                        const float mm = fmaxf(la, lb), wa = __builtin_amdgcn_exp2f(la - mm), wb = __builtin_amdgcn_exp2f(lb - mm), iv = 1.0f / (wa + wb);
                        const v2u pa = *(const v2u*)oa, pb = *(const v2u*)ob;
                        const f32x4 va = {__uint_as_float(pa.x << 16), __uint_as_float(pa.x & 0xffff0000u), __uint_as_float(pa.y << 16), __uint_as_float(pa.y & 0xffff0000u)};
                        const f32x4 vb = {__uint_as_float(pb.x << 16), __uint_as_float(pb.x & 0xffff0000u), __uint_as_float(pb.y << 16), __uint_as_float(pb.y & 0xffff0000u)};
                        const f32x4 r4 = (va * wa + vb * wb) * iv;
                        v2u o2; o2.x = pk2(r4[0], r4[1]); o2.y = pk2(r4[2], r4[3]);
                        *(v2u*)oa = o2;
                    }
                }
            }
        } else if (PHON(9) && ph == PH_CONV0) {
            int tid_ = (wave0 << 6) | xl::fresh_lane(); asm volatile("" : "+v"(tid_)); const int tid = tid_, lane = tid & 63, wave = __builtin_amdgcn_readfirstlane(tid >> 6), gw = vcu * NWAVES + wave; (void)lane; (void)gw;
            p0_convert(P, lds, gw, NGW, wave, lane);
        } else if (ph == PH_CONV1) {
        } else if (PHON(10) && ph == PH_FINAL) {
            int tid_ = (wave0 << 6) | xl::fresh_lane(); asm volatile("" : "+v"(tid_)); const int tid = tid_, lane = tid & 63, wave = __builtin_amdgcn_readfirstlane(tid >> 6), gw = vcu * NWAVES + wave; (void)lane; (void)gw;
            const float* gf = P.in[13];
            for (int m = gw; m < M; m += NGW) {
                const f32x4 pa = *(const f32x4*)(P_SSA + (size_t)m * 16 + 4 * (lane & 3));
                float s = (pa[0] + pa[1]) + (pa[2] + pa[3]); s += xl::sxor<1>(s); s += xl::sxor<2>(s);
                const float rs = rsqrtf(s * (1.0f / 1024.0f) + 1e-6f);
                const bf16* xr = P_XB + (size_t)m * D; float* orow = P.out + (size_t)m * D;
#pragma unroll
                for (int j = 0; j < 2; ++j) { const int c = 512 * j + 8 * lane; const v4u w = *(const v4u*)(xr + c);
                    const f32x4 g0 = *(const f32x4*)(gf + c), g1 = *(const f32x4*)(gf + c + 4);
                    f32x4 o0 = {__uint_as_float(w.x << 16), __uint_as_float(w.x & 0xffff0000u), __uint_as_float(w.y << 16), __uint_as_float(w.y & 0xffff0000u)};
                    f32x4 o1 = {__uint_as_float(w.z << 16), __uint_as_float(w.z & 0xffff0000u), __uint_as_float(w.w << 16), __uint_as_float(w.w & 0xffff0000u)};
                    *(f32x4*)(orow + c) = o0 * rs * g0; *(f32x4*)(orow + c + 4) = o1 * rs * g1; }
            }
#ifdef MK_DIAG_FALLBACKS
            if (gw == 0 && lane == 0) { const unsigned cnt = __hip_atomic_load(ctl + 12288, RLX_AGENT); if (cnt) { asm volatile("s_waitcnt vmcnt(0)" ::: "memory"); P.out[0] = sqrtf((float)cnt * (float)M * 1024.0f * 1.0025f); } }
#endif
        } else {
            const int l = (ph >= PH_L1) ? 1 : 0, lp = ph - (l ? PH_L1 : PH_L0);
            const int nrep = (lp == MK_REPEAT_LP && ((MK_REPEAT_LAYERS >> l) & 1)) ? 2 : 1;
            for (int rep = 0; rep < nrep; ++rep) {
            if (PHON(0) && lp == LP_INPROJ) {
                pg8::Gemm g{P_XB, P_WIN, M, 3072, D}; pg8::StaticOrder so; so.init(M, 3072, G, bx);
                pg8::EpiInProj E{P_ZT, zts, P_MLAA, P_MISC, P_SSA, P_SSQ, P_SSKV, P_KMP, P_TP, P_TI, P_TM};
                pg8::gemm_phase<pg8::EpiInProj, pg8::StaticOrder, true, true>(lds + RING_OFF, g, so, E, wave0);
            } else if (PHON(1) && lp == LP_MLA) {
                pg8::Gemm g{P_MLAA, P_WMLA, M, 1024, 384}; pg8::StaticOrder so; so.init(M, 1024, G, bx);
                pg8::EpiMla E{P_QM, P_KN, P_VM, P_SSQ, P_SSKV, P_TM};
                pg8::gemm_phase<pg8::EpiMla, pg8::StaticOrder, true, true>(lds + RING_OFF, g, so, E, wave0);
            } else if (PHON(2) && lp == LP_MIX) {
                MixCtx MC; MC.zt = P_ZT; MC.zts = zts; MC.misc = P_MISC; MC.qm = P_QM; MC.kn = P_KN; MC.vm = P_VM; MC.kmp = P_KMP; MC.bits = P_BITS; MC.o4 = P_O4; MC.o4s = zts; MC.diag = (unsigned*)(ctl + 12288); MC.mlist = (unsigned short*)(ws + WS_MLIST); MC.mcnt = (unsigned*)(ctl + CW_MCNT + 256 * l); MC.part = (bf16*)(ws + WS_PART); MC.lse = (float*)(ws + WS_LSE); MC.dsa2 = (bf16*)(ws + WS_DSA2); MC.lsed = (float*)(ws + WS_LSED);
                int tid_ = (wave0 << 6) | xl::fresh_lane(); asm volatile("" : "+v"(tid_)); const int tid = tid_, lane = tid & 63, wave = __builtin_amdgcn_readfirstlane(tid >> 6), gw = vcu * NWAVES + wave; (void)lane; (void)gw;
                gu32* ctr = ctl + CW_QUEUE + 64 * (2 * l + 4 * rep);
                const int per = 20 * nb, total = 32 * per;
                for (;;) {
                    const int u = next_unit(ctr, aux, tid);
                    if (u >= total) break;
                    const int L = 31 - u / per, r = u % per;
                    const int kmask = rep ? MK_REPEAT_KINDS : 15;
                    if (r < 12 * nb) { const int kind = r / (4 * nb), rr = r % (4 * nb), b = rr >> 2, h = rr & 3;
                        if (MIXON(0) && kind == 0 && (kmask & 1)) softmax_unit<0>(MC, b, h, L, lds, wave0, rep); else if (MIXON(2) && kind == 1 && (kmask & 4)) sb_unit(MC, b, h, L, lds, wave0);
                        else if (kind == 2 && !rep) moba_gate_unit(MC, b, h, L, lds, wave0); }
                    else if (MIXON(3) && (kmask & 8)) { const int r2 = r - 12 * nb, b = r2 >> 3, qg = 8 * L + 7 - (r2 & 7); sel_unit(MC, b, qg, lds, wave0, rep); }
                }
            } else if (PHON(3) && lp == LP_DSA) {
                MixCtx MC; MC.zt = P_ZT; MC.zts = zts; MC.misc = P_MISC; MC.qm = P_QM; MC.kn = P_KN; MC.vm = P_VM; MC.kmp = P_KMP; MC.bits = P_BITS; MC.o4 = P_O4; MC.o4s = zts; MC.diag = (unsigned*)(ctl + 12288); MC.mlist = (unsigned short*)(ws + WS_MLIST); MC.mcnt = (unsigned*)(ctl + CW_MCNT + 256 * l); MC.part = (bf16*)(ws + WS_PART); MC.lse = (float*)(ws + WS_LSE); MC.dsa2 = (bf16*)(ws + WS_DSA2); MC.lsed = (float*)(ws + WS_LSED);
                int tid_ = (wave0 << 6) | xl::fresh_lane(); asm volatile("" : "+v"(tid_)); const int tid = tid_, lane = tid & 63, wave = __builtin_amdgcn_readfirstlane(tid >> 6), gw = vcu * NWAVES + wave; (void)lane; (void)gw;
                gu32* ctr = ctl + CW_QUEUE + 64 * (2 * l + 1 + 4 * rep);
                const int per = 28 * nb, total = 32 * per;
                for (;;) {
                    const int u = next_unit(ctr, aux, tid);
                    if (u >= total) break;
                    const int L = 31 - u / per, r = u % per;
                    const int kmask = rep ? MK_REPEAT_KINDS : 15;
                    if (r < 8 * nb) { const int hf = r / (4 * nb), rr = r % (4 * nb); softmax_unit<1>(MC, rr >> 2, rr & 3, L, lds, wave0, 0, hf); }
                    else if (r < 12 * nb) { const int rr = r - 8 * nb; if (MIXON(1) && (kmask & 2)) moba_blk_unit(MC, rr >> 2, rr & 3, L, 0, true, lds, wave0); }
                    else { const int rr = r - 12 * nb, bh = rr >> 2, p = rr & 3; if (MIXON(1) && (kmask & 2) && L > 0) moba_blk_unit(MC, bh >> 2, bh & 3, 31 - L, p, false, lds, wave0); }
                }
            } else if (PHON(4) && lp == LP_PROJ) {
                pg8::Gemm g{P_O4, P_WB, 4 * M, 4096, 256}; pg8::ProjOrder so{M / 256, G, bx};
                pg8::EpiProj E{P_PROJ, M / 256};
                pg8::gemm_phase<pg8::EpiProj, pg8::ProjOrder, true, true>(lds + RING_OFF, g, so, E, wave0);
            } else if (PHON(5) && lp == LP_GATE) {
                pg8::Gemm g{P_XB, P_WIN, M, 7168, D}; pg8::GateOrder so; so.so.init(M, 1024, G, bx);
                pg8::EpiGate E{P_PROJ, P_MERGED, P_SSA, P.in[3] + (size_t)l * 4 * D};
                pg8::gemm_phase<pg8::EpiGate, pg8::GateOrder, true, true>(lds + RING_OFF, g, so, E, wave0);
            } else if (PHON(6) && lp == LP_OUT) {
                pg8::Gemm g{P_MERGED, P_WOUT, M, D, D}; pg8::StaticOrder so; so.init(M, D, G, bx);
                pg8::EpiResid E{(l == 0) ? P.in[0] : nullptr, P_XB, P_SSB};
                pg8::gemm_phase<pg8::EpiResid, pg8::StaticOrder, true, true>(lds + RING_OFF, g, so, E, wave0);
            } else if (PHON(7) && lp == LP_UP) {
                pg8::Gemm g{P_XB, P_WUP, M, FF, D}; pg8::StaticOrder so; so.init(M, FF, G, bx);
                pg8::EpiUp E{P_HID, P_SSB};
                pg8::gemm_phase<pg8::EpiUp, pg8::StaticOrder, true, true>(lds + RING_OFF, g, so, E, wave0);
            } else if (PHON(8)) {
                pg8::Gemm g{P_HID, P_WDOWN, M, D, FF}; pg8::StaticOrder so; so.init(M, D, G, bx);
                pg8::EpiResid E{nullptr, P_XB, P_SSA};
                pg8::gemm_phase<pg8::EpiResid, pg8::StaticOrder, true, true>(lds + RING_OFF, g, so, E, wave0);
            }
            }
        }
    }
}

__global__ void __launch_bounds__(NTHR, 2) mk_fwd(Ptrs P) {
    extern __shared__ __attribute__((aligned(16))) unsigned char lds_raw[];
    LAS unsigned char* lds = (LAS unsigned char*)lds_raw;
    const int tid0 = threadIdx.x;
    const int wave0 = __builtin_amdgcn_readfirstlane(tid0 >> 6);
#define LEADER (wave0 == 0 && xl::fresh_lane() == 0)
    const int G = gridDim.x, bx = blockIdx.x;
    const int vcu = (G % 8 == 0) ? (bx % 8) * (G / 8) + bx / 8 : bx;
    gu32* ctl = (gu32*)(P.ws + WS_CTL);
    volatile LAS unsigned* MISCW = (volatile LAS unsigned*)(lds + MISC_OFF);
    for (int u = tid0; u < (LDS_BYTES - LDSCTL_OFF) / 4; u += NTHR) ((LAS unsigned*)(lds + LDSCTL_OFF))[u] = 0u;
    __syncthreads();
    const bool multi = (P.ph_hi - P.ph_lo) > 1;
    XcdBarrier bar; bar.bar = (unsigned*)(ctl + CW_BAR); bar.x = 0; bar.st = nullptr;
    if (multi) bar = xcd_barrier_post((unsigned*)(ctl + CW_BAR), MISCW + 8, tid0 == 0);
#define RUNPH(k) if (P.ph_lo <= (k) && (k) < P.ph_hi) { run_phase<k>(P, lds, ctl, G, bx, vcu, wave0); if ((k) + 1 < P.ph_hi && (k) != PH_CONV1) xcd_barrier(bar, LEADER); }
    RUNPH(0) RUNPH(1) RUNPH(2) RUNPH(3) RUNPH(4)
    if (P.ph_lo <= PH_L0 + LP_DSA && PH_L0 + LP_PROJ < P.ph_hi) { run_phase<PH_MERGE0>(P, lds, ctl, G, bx, vcu, wave0); xcd_barrier(bar, LEADER); }
    RUNPH(5) RUNPH(6) RUNPH(7) RUNPH(8) RUNPH(9) RUNPH(10)
#if MK_REPEAT_CONV
    RUNPH(10)
#endif
    RUNPH(11) RUNPH(12) RUNPH(13) RUNPH(14)
    if (P.ph_lo <= PH_L1 + LP_DSA && PH_L1 + LP_PROJ < P.ph_hi) { run_phase<PH_MERGE1>(P, lds, ctl, G, bx, vcu, wave0); xcd_barrier(bar, LEADER); }
    RUNPH(15) RUNPH(16) RUNPH(17) RUNPH(18) RUNPH(19) RUNPH(20)
#undef RUNPH
    if (multi) { for (int i = 0; i < MK_EXTRA_BARRIERS; ++i) xcd_barrier(bar, LEADER); }
}

static int g_grid = 0;
static int mk_setup(size_t ws_size) {
    if (g_grid != 0) return g_grid;
    if (ws_size < WS_END) { fprintf(stderr, "kernel_launch: workspace too small (%zu < %zu)\n", ws_size, (size_t)WS_END); g_grid = -1; return g_grid; }
    int dev = 0, cus = 0, per_cu = 0;
    if (hipGetDevice(&dev) != hipSuccess || hipDeviceGetAttribute(&cus, hipDeviceAttributeMultiprocessorCount, dev) != hipSuccess) { g_grid = -1; return g_grid; }
    if (hipFuncSetAttribute((const void*)mk_fwd, hipFuncAttributeMaxDynamicSharedMemorySize, LDS_BYTES) != hipSuccess) { fprintf(stderr, "kernel_launch: hipFuncSetAttribute failed\n"); g_grid = -1; return g_grid; }
    if (hipOccupancyMaxActiveBlocksPerMultiprocessor(&per_cu, (const void*)mk_fwd, NTHR, LDS_BYTES) != hipSuccess || per_cu < 1) fprintf(stderr, "kernel_launch: occupancy query reports %d blocks per CU\n", per_cu);
    (void)hipGetLastError();
    g_grid = cus;
    return g_grid;
}
static void mk_launch(Ptrs a, int lo, int hi, int li, hipStream_t stream) {
    a.ph_lo = lo; a.ph_hi = hi; a.li = li;
    hipLaunchKernelGGL(mk_fwd, dim3(g_grid), dim3(NTHR), LDS_BYTES, stream, a);
}
}

extern "C" void kernel_launch(void* const* d_in, const int* in_sizes, int n_in, void* d_out, int out_size, void* d_ws, size_t ws_size, hipStream_t stream) {
    if (n_in != 14 || out_size != 2 * mk::S * mk::D) { fprintf(stderr, "kernel_launch: unexpected shapes\n"); return; }
    if (mk::mk_setup(ws_size) < 0) return;
    if (hipMemsetAsync((char*)d_ws + mk::WS_CTL, 0, mk::CTL_ZERO_BYTES, stream) != hipSuccess) return;
    mk::Ptrs a{};
    for (int i = 0; i < 14; ++i) a.in[i] = (const float*)d_in[i];
    a.out = (float*)d_out; a.ws = (unsigned char*)d_ws; a.mrows = 2 * mk::S;
#ifndef MK_PER_PHASE
    mk::mk_launch(a, 0, mk::N_PHASES, 0, stream);
#else
    for (int ph = 0; ph < mk::N_PHASES; ++ph) mk::mk_launch(a, ph, ph + 1, ph, stream);
#endif
}
```

```cpp
#include <hip/hip_runtime.h>
#include <hip/hip_bf16.h>
#include <cstdio>
#include <cstdint>
#include <cmath>

namespace xl {
template <int K> __device__ __forceinline__ float sxor(float v) { return __int_as_float(__builtin_amdgcn_ds_swizzle(__float_as_int(v), (K << 10) | 0x1F)); }
template <int K> __device__ __forceinline__ unsigned bcast16(unsigned v) { return (unsigned)__builtin_amdgcn_ds_swizzle((int)v, (K << 5) | 0x10); }
__device__ __forceinline__ void halves(float v, float& lo, float& hi) { auto rr = __builtin_amdgcn_permlane32_swap(__float_as_uint(v), __float_as_uint(v), false, false); lo = __uint_as_float(rr[0]); hi = __uint_as_float(rr[1]); }
__device__ __forceinline__ float hsum(float v) { float lo, hi; halves(v, lo, hi); return lo + hi; }
__device__ __forceinline__ float hmax(float v) { float lo, hi; halves(v, lo, hi); return fmaxf(lo, hi); }
__device__ __forceinline__ unsigned hor(unsigned v) { auto rr = __builtin_amdgcn_permlane32_swap(v, v, false, false); return rr[0] | rr[1]; }
__device__ __forceinline__ int fresh_lane() { int z = 0; asm volatile("" : "+v"(z)); return (int)__builtin_amdgcn_mbcnt_hi(~0u, __builtin_amdgcn_mbcnt_lo(~0u, (unsigned)z)); }
}
namespace pg8 {
#define PG8_LAS __attribute__((address_space(3)))
typedef unsigned short bf16_t;
typedef short bf16x8 __attribute__((ext_vector_type(8)));
typedef float f32x4 __attribute__((ext_vector_type(4)));
typedef unsigned u32x4 __attribute__((ext_vector_type(4)));
constexpr int BM = 256, BK = 64, HALF = 128, HTB = HALF * BK * 2  , STAGE_BYTES = 8 * HTB, NXCD = 8, WGM = 8;

__host__ __device__ __forceinline__ int lds_byte(int r, int c) { const int st = (r >> 4) * 2 + (c >> 5), rr = r & 15, cc = c & 31, ob = rr * 64 + cc * 2; return st * 1024 + (ob ^ (((ob >> 9) & 1) << 5)); }
__host__ __device__ __forceinline__ void stage_rc(int b, int& R, int& C) { const int st = b / 1024, sb = b % 1024, swz = sb ^ (((sb >> 9) & 1) << 5); R = (st >> 1) * 16 + swz / 64; C = (st & 1) * 32 + (swz % 64) / 2; }
__host__ __device__ __forceinline__ int perm32(int rho) { const int n = rho >> 4, i = rho & 15; return 8 * (i >> 2) + 4 * n + (i & 3); }

struct Unit { int pm, pn; };
struct Gemm { const bf16_t* A; const bf16_t* Bt; int M, N, K; };

struct StaticOrder {
    int nM, nN, nwg, G, c;
    __host__ __device__ void init(int M, int N, int G_, int c_) { nM = M / BM; nN = N / BM; nwg = nM * nN; G = G_; c = c_; }
    __host__ __device__ bool next(int i, Unit& u) const {
        const long L = (long)i * G + c; if (L >= nwg) return false;
        int wgid = (int)L; { const int q = nwg / NXCD, r = nwg % NXCD, xcd = wgid % NXCD, off = wgid / NXCD; wgid = (xcd < r ? xcd * (q + 1) : r * (q + 1) + (xcd - r) * q) + off; }
        const int nig = WGM * nN, gid = wgid / nig, fm = gid * WGM, gsz = (nM - fm) < WGM ? (nM - fm) : WGM;
        u.pm = fm + ((wgid % nig) % gsz); u.pn = (wgid % nig) / gsz; return true;
    }
    __device__ __forceinline__ void a_ready(const Unit&) const {}
    __device__ __forceinline__ void done(const Unit&) const {}
};

__device__ __forceinline__ unsigned cvt_pk_bf16(float lo, float hi) { unsigned r; asm volatile("v_cvt_pk_bf16_f32 %0, %1, %2" : "=v"(r) : "v"(lo), "v"(hi)); return r; }
template <class Epi, class Sched, bool ALIGN_EPI = false, bool SP2 = false>
__device__ __forceinline__ void gemm_phase(PG8_LAS unsigned char* lds, const Gemm g, const Sched& S, const Epi& E, const int wave0) {
    int tid_ = (wave0 << 6) | xl::fresh_lane(); asm volatile("" : "+v"(tid_));
    const int tid = tid_, wid = __builtin_amdgcn_readfirstlane(tid >> 6), lane = tid & 63, wr = wid >> 2, wc = wid & 3, fr = lane & 15, fq = lane >> 4;
    int K_ = g.K; asm volatile("" : "+s"(K_));
    const int K = K_, nt = K / BK;
    unsigned voffA[2], voffB[2];
#pragma unroll
    for (int i = 0; i < 2; ++i) { int R, C; stage_rc(tid * 16 + i * 8192, R, C); const int Rb = Epi::PERM ? ((R & ~31) + perm32(R & 31)) : R;
        voffA[i] = (unsigned)(R * K + C) * 2u; voffB[i] = (unsigned)(Rb * K + C) * 2u; }
    const size_t kstep = (size_t)(BK * 2);
    const size_t hstep = (size_t)HALF * K * 2;
    const size_t tstep = 2 * hstep;
    const unsigned ldsw = (unsigned)wid * 1024u;
    const int aoff = lds_byte(wr * 64 + fr, fq * 8), boff = lds_byte(wc * 32 + fr, fq * 8);
#define PG8_SA(b, h) (((b) * 2 + (h)) * HTB)
#define PG8_SB(b, h) ((4 + (b) * 2 + (h)) * HTB)
#define PG8_STAGE(bufoff, gbase, voff) do { _Pragma("unroll") for (int _i = 0; _i < 2; ++_i) \
        __builtin_amdgcn_global_load_lds((const unsigned*)((const char*)(gbase) + (voff)[_i]), (PG8_LAS unsigned*)(lds + (bufoff) + ldsw + _i * 8192), 16, 0, 0); } while (0)
#define PG8_LDA(dst, b, h) do { _Pragma("unroll") for (int m = 0; m < 4; ++m) _Pragma("unroll") for (int k = 0; k < 2; ++k) dst[m][k] = *(const PG8_LAS bf16x8*)(lds + PG8_SA(b, h) + aoff + m * 2048 + k * 1024); } while (0)
#define PG8_LDB(dst, b, h) do { _Pragma("unroll") for (int n = 0; n < 2; ++n) _Pragma("unroll") for (int k = 0; k < 2; ++k) dst[n][k] = *(const PG8_LAS bf16x8*)(lds + PG8_SB(b, h) + boff + n * 2048 + k * 1024); } while (0)
#define PG8_MMA(ai, bj, At, Bt) do { __builtin_amdgcn_s_setprio(1); _Pragma("unroll") for (int m = 0; m < 4; ++m) _Pragma("unroll") for (int n = 0; n < 2; ++n) _Pragma("unroll") for (int k = 0; k < 2; ++k) \
        acc[ai][bj][m][n] = __builtin_amdgcn_mfma_f32_16x16x32_bf16(Bt[n][k], At[m][k], acc[ai][bj][m][n], 0, 0, 0); __builtin_amdgcn_s_setprio(0); } while (0)
#define PG8_WAIT_V(n) asm volatile("s_waitcnt vmcnt(" #n ")" ::: "memory")
#define PG8_WAIT_L(n) asm volatile("s_waitcnt lgkmcnt(" #n ")" ::: "memory")
#define PG8_BAR __builtin_amdgcn_s_barrier()
#define PG8_SCHED __builtin_amdgcn_sched_barrier(0)
    Unit cur, nxt; int ui = 0;
    if (!S.next(0, cur)) return;
    f32x4 acc[2][2][4][2];
#pragma unroll
    for (int a = 0; a < 2; ++a)
#pragma unroll
        for (int b = 0; b < 2; ++b)
#pragma unroll
            for (int m = 0; m < 4; ++m)
#pragma unroll
                for (int n = 0; n < 2; ++n) acc[a][b][m][n] = (f32x4){0.f, 0.f, 0.f, 0.f};
    bf16x8 At[4][2], B0[2][2], B1[2][2];
    const char* cA = (const char*)g.A + (size_t)cur.pm * tstep; const char* cB = (const char*)g.Bt + (size_t)cur.pn * tstep;
    S.a_ready(cur);
    if constexpr (SP2) {
        PG8_STAGE(PG8_SB(0, 0), cB, voffB); PG8_STAGE(PG8_SB(0, 1), cB + hstep, voffB); PG8_STAGE(PG8_SA(0, 0), cA, voffA); PG8_STAGE(PG8_SA(0, 1), cA + hstep, voffA);
        if (wr == 1) PG8_BAR;
        PG8_WAIT_V(2); PG8_BAR;
        PG8_STAGE(PG8_SB(1, 0), cB + kstep, voffB); PG8_STAGE(PG8_SA(1, 0), cA + kstep, voffA); PG8_STAGE(PG8_SB(1, 1), cB + hstep + kstep, voffB);
        PG8_WAIT_V(6); PG8_BAR;
    } else {
        PG8_STAGE(PG8_SB(0, 0), cB, voffB); PG8_STAGE(PG8_SA(0, 0), cA, voffA); PG8_STAGE(PG8_SB(0, 1), cB + hstep, voffB); PG8_STAGE(PG8_SA(0, 1), cA + hstep, voffA);
        if (wr == 1) PG8_BAR;
        PG8_WAIT_V(4); PG8_BAR;
        PG8_STAGE(PG8_SB(1, 0), cB + kstep, voffB); PG8_STAGE(PG8_SA(1, 0), cA + kstep, voffA); PG8_STAGE(PG8_SB(1, 1), cB + hstep + kstep, voffB);
        PG8_WAIT_V(6); PG8_BAR;
    }
    for (;;) {
        const bool has_next = S.next(ui + 1, nxt);
        const char* nA = has_next ? (const char*)g.A + (size_t)nxt.pm * tstep : cA; const char* nB = has_next ? (const char*)g.Bt + (size_t)nxt.pn * tstep : cB;
        for (int t = 0; t < nt; t += 2) {
            const bool last = (t == nt - 2);
            const char* a1 = cA + (size_t)(t + 1) * kstep;
            const char* a2 = last ? nA : cA + (size_t)(t + 2) * kstep; const char* b2 = last ? nB : cB + (size_t)(t + 2) * kstep;
            const char* a3 = a2 + kstep; const char* b3 = b2 + kstep;
            if (last && has_next) S.a_ready(nxt);
            if constexpr (SP2) {
            PG8_LDB(B0, 0, 0); PG8_LDB(B1, 0, 1); PG8_SCHED; PG8_LDA(At, 0, 0); PG8_STAGE(PG8_SA(1, 1), a1 + hstep, voffA);
            PG8_WAIT_V(8); PG8_WAIT_L(0); PG8_BAR; PG8_MMA(0, 0, At, B0); PG8_MMA(0, 1, At, B1); PG8_BAR; PG8_SCHED;
            PG8_LDA(At, 0, 1); PG8_STAGE(PG8_SB(0, 0), b2, voffB); PG8_STAGE(PG8_SB(0, 1), b2 + hstep, voffB); PG8_STAGE(PG8_SA(0, 0), a2, voffA);
            PG8_WAIT_V(8); PG8_WAIT_L(0); PG8_BAR; PG8_MMA(1, 0, At, B0); PG8_MMA(1, 1, At, B1); PG8_BAR; PG8_SCHED;
            PG8_LDB(B0, 1, 0); PG8_LDB(B1, 1, 1); PG8_SCHED; PG8_LDA(At, 1, 0); PG8_STAGE(PG8_SA(0, 1), a2 + hstep, voffA);
            PG8_WAIT_V(8); PG8_WAIT_L(0); PG8_BAR; PG8_MMA(0, 0, At, B0); PG8_MMA(0, 1, At, B1); PG8_BAR; PG8_SCHED;
            PG8_LDA(At, 1, 1); PG8_STAGE(PG8_SB(1, 0), b3, voffB); PG8_STAGE(PG8_SB(1, 1), b3 + hstep, voffB); PG8_STAGE(PG8_SA(1, 0), a3, voffA);
            PG8_WAIT_V(8); PG8_WAIT_L(0); PG8_BAR; PG8_MMA(1, 0, At, B0); PG8_MMA(1, 1, At, B1); PG8_BAR; PG8_SCHED;
            } else {
            PG8_LDB(B0, 0, 0); PG8_SCHED; PG8_LDA(At, 0, 0); PG8_STAGE(PG8_SA(1, 1), a1 + hstep, voffA);
            PG8_WAIT_L(8); PG8_BAR; PG8_WAIT_L(0); PG8_MMA(0, 0, At, B0); PG8_BAR; PG8_SCHED;
            PG8_LDB(B1, 0, 1); PG8_STAGE(PG8_SB(0, 0), b2, voffB);
            PG8_BAR; PG8_WAIT_L(0); PG8_MMA(0, 1, At, B1); PG8_BAR;
            PG8_LDA(At, 0, 1); PG8_STAGE(PG8_SA(0, 0), a2, voffA);
            PG8_BAR; PG8_WAIT_L(0); PG8_MMA(1, 0, At, B0); PG8_BAR; PG8_SCHED;
            PG8_STAGE(PG8_SB(0, 1), b2 + hstep, voffB);
            PG8_WAIT_V(6); PG8_BAR; PG8_MMA(1, 1, At, B1); PG8_BAR;
            PG8_LDB(B0, 1, 0); PG8_SCHED; PG8_LDA(At, 1, 0); PG8_STAGE(PG8_SA(0, 1), a2 + hstep, voffA);
            PG8_WAIT_L(8); PG8_BAR; PG8_WAIT_L(0); PG8_MMA(0, 0, At, B0); PG8_BAR; PG8_SCHED;
            PG8_LDB(B1, 1, 1); PG8_STAGE(PG8_SB(1, 0), b3, voffB);
            PG8_BAR; PG8_WAIT_L(0); PG8_MMA(0, 1, At, B1); PG8_BAR;
            PG8_LDA(At, 1, 1); PG8_STAGE(PG8_SA(1, 0), a3, voffA);
            PG8_BAR; PG8_WAIT_L(0); PG8_MMA(1, 0, At, B0); PG8_BAR; PG8_SCHED;
            PG8_STAGE(PG8_SB(1, 1), b3 + hstep, voffB);
            PG8_WAIT_V(6); PG8_BAR; PG8_MMA(1, 1, At, B1); PG8_BAR;
            }
        }
        if constexpr (ALIGN_EPI) { if (wr == 0) PG8_BAR; }
        if constexpr (!Epi::AFTER_DRAIN) { E(acc, cur, wr, wc, fr, fq); S.done(cur); }
        if (!has_next) break;
#pragma unroll
        for (int a = 0; a < 2; ++a)
#pragma unroll
            for (int b = 0; b < 2; ++b)
#pragma unroll
                for (int m = 0; m < 4; ++m)
#pragma unroll
                    for (int n = 0; n < 2; ++n) acc[a][b][m][n] = (f32x4){0.f, 0.f, 0.f, 0.f};
        cur = nxt; cA = nA; cB = nB; ++ui;
        if constexpr (ALIGN_EPI) { if (wr == 1) PG8_BAR; }
    }
    PG8_WAIT_V(0);
    if constexpr (!ALIGN_EPI) { if (wr == 0) PG8_BAR; }
    PG8_BAR;
    if constexpr (Epi::AFTER_DRAIN) { E.fused(acc, cur, wr, wc, fr, fq, lds, wid, lane); S.done(cur); }
#undef PG8_SA
#undef PG8_SB
#undef PG8_STAGE
#undef PG8_LDA
#undef PG8_LDB
#undef PG8_MMA
#undef PG8_WAIT_V
#undef PG8_WAIT_L
#undef PG8_BAR
#undef PG8_SCHED
}

constexpr float NORM_EPS = 1e-6f;
constexpr float LOG2E = 1.4426950408889634f;
__device__ __forceinline__ u32x4 pack8(const f32x4 a, const f32x4 b) { u32x4 w; w.x = cvt_pk_bf16(a[0], a[1]); w.y = cvt_pk_bf16(a[2], a[3]); w.z = cvt_pk_bf16(b[0], b[1]); w.w = cvt_pk_bf16(b[2], b[3]); return w; }
__device__ __forceinline__ float bf_lo(unsigned w) { return __uint_as_float(w << 16); }
__device__ __forceinline__ float bf_hi(unsigned w) { return __uint_as_float(w & 0xffff0000u); }
__device__ __forceinline__ float row_total16(const float* ss, int row, int fq) {
    const f32x4 p = *(const f32x4*)(ss + (size_t)row * 16 + 4 * fq);
    float s = (p[0] + p[1]) + (p[2] + p[3]);
    s += xl::sxor<16>(s); s = xl::hsum(s);
    return s;
}
__device__ __forceinline__ void rot4(f32x4& v0, f32x4& v1, const f32x4 c4, const f32x4 s4) {
    const float a0 = v0[0] * c4[0] - v0[1] * s4[0], b0 = v0[1] * c4[0] + v0[0] * s4[0];
    const float a1 = v0[2] * c4[1] - v0[3] * s4[1], b1 = v0[3] * c4[1] + v0[2] * s4[1];
    const float a2 = v1[0] * c4[2] - v1[1] * s4[2], b2 = v1[1] * c4[2] + v1[0] * s4[2];
    const float a3 = v1[2] * c4[3] - v1[3] * s4[3], b3 = v1[3] * c4[3] + v1[2] * s4[3];
    v0 = (f32x4){a0, b0, a1, b1}; v1 = (f32x4){a2, b2, a3, b3};
}

struct EpiInProj {
    static constexpr bool PERM = true, AFTER_DRAIN = false;
    bf16_t* zt; size_t zt_stride; bf16_t* mla_a; bf16_t* misc; const float* ss; float* ssq; float* sskv; float* kmp; const float* tp; const float* ti; const float* tm;
    __device__ __forceinline__ void operator()(const f32x4 (&acc)[2][2][4][2], const Unit& u, int wr, int wc, int fr, int fq) const {
        const int tile = u.pn;
        const int row0 = u.pm * BM + wr * 64 + fr;
        const bool rot64 = (tile == 0) | (tile == 1) | (tile == 7) | (tile == 8);
        const float scl = (tile == 0 || tile == 7) ? 0.125f * LOG2E : (tile == 4 ? 0.125f : 1.0f);
        float ksum[2][8];
#pragma unroll
        for (int bj = 0; bj < 2; ++bj)
#pragma unroll
            for (int e = 0; e < 8; ++e) ksum[bj][e] = 0.f;
        float rsv[2][4];
#pragma unroll
        for (int ai = 0; ai < 2; ++ai)
#pragma unroll
            for (int m = 0; m < 4; ++m) rsv[ai][m] = rsqrtf(row_total16(ss, row0 + ai * HALF + m * 16, fq) * (1.0f / 1024.0f) + NORM_EPS);
        const int ct0 = wc * 32 + 8 * fq;
        const float* rtab = nullptr; int rstride = 0, coff = 0, soff = 0, rbj = 3;
        if (rot64) { if ((ct0 & 63) < 16) { rtab = tp; rstride = 16; coff = (ct0 & 63) >> 1; soff = coff + 8; } }
        else if (tile == 3) { if ((ct0 & 31) == 0) { rtab = ti; rstride = 8; coff = 0; soff = 4; } }
        else if (tile == 11) { rbj = 2; if (wc == 0) { rtab = tm; rstride = 32; coff = ct0 >> 1; soff = coff + 16; } else if (wc == 1 && fq == 0) { rtab = ti; rstride = 8; coff = 0; soff = 4; } }
#pragma unroll
        for (int am = 0; am < 4; ++am) {
            const int ai = am >> 1;
            f32x4 c4[2], s4[2];
            if (rtab) {
#pragma unroll
                for (int mm = 0; mm < 2; ++mm) { const int t = (row0 + ai * HALF + (2 * (am & 1) + mm) * 16) & 8191; c4[mm] = *(const f32x4*)(rtab + t * rstride + coff); s4[mm] = *(const f32x4*)(rtab + t * rstride + soff); }
            }
#pragma unroll
            for (int mm = 0; mm < 2; ++mm) {
                const int m = 2 * (am & 1) + mm;
                const int row = row0 + ai * HALF + m * 16;
                const float rs = rsv[ai][m];
                float sq0 = 0.f, sq1 = 0.f;
#pragma unroll
                for (int bj = 0; bj < 2; ++bj) {
                    const int ct = bj * HALF + ct0;
                    f32x4 v0 = acc[ai][bj][m][0] * rs, v1 = acc[ai][bj][m][1] * rs;
                    if (rtab && ((rbj >> bj) & 1)) rot4(v0, v1, c4[mm], s4[mm]);
                    if (tile <= 9) {
                        if (tile == 8) {
#pragma unroll
                            for (int e = 0; e < 4; ++e) { ksum[bj][e] += v0[e]; ksum[bj][4 + e] += v1[e]; }
                        }
                        v0 = v0 * scl; v1 = v1 * scl;
                        *(u32x4*)(zt + (size_t)tile * zt_stride + (size_t)row * 256 + ct) = pack8(v0, v1);
                    } else if (tile == 10) {
                        sq0 += (v0[0] * v0[0] + v0[1] * v0[1]) + (v0[2] * v0[2] + v0[3] * v0[3]) + (v1[0] * v1[0] + v1[1] * v1[1]) + (v1[2] * v1[2] + v1[3] * v1[3]);
                        *(u32x4*)(mla_a + (size_t)row * 384 + ct) = pack8(v0, v1);
                    } else {
                        if (bj == 0) {
                            sq1 += (v0[0] * v0[0] + v0[1] * v0[1]) + (v0[2] * v0[2] + v0[3] * v0[3]) + (v1[0] * v1[0] + v1[1] * v1[1]) + (v1[2] * v1[2] + v1[3] * v1[3]);
                            *(u32x4*)(mla_a + (size_t)row * 384 + 256 + ct) = pack8(v0, v1);
                        } else {
                            if (wc == 2) { v0 = v0 * 0.0625f; v1 = v1 * 0.0625f; }
                            *(u32x4*)(misc + (size_t)row * 128 + ct0) = pack8(v0, v1);
                        }
                    }
                }
                if (tile == 10) { sq0 += xl::sxor<16>(sq0); sq0 = xl::hsum(sq0); if (fq == 0) ssq[(size_t)row * 4 + wc] = sq0; }
                if (tile == 11) { sq1 += xl::sxor<16>(sq1); sq1 = xl::hsum(sq1); if (fq == 0) sskv[(size_t)row * 4 + wc] = sq1; }
            }
        }
        if (tile == 8) {
#pragma unroll
            for (int bj = 0; bj < 2; ++bj)
#pragma unroll
                for (int e = 0; e < 8; ++e) { float s = ksum[bj][e]; s += xl::sxor<1>(s); s += xl::sxor<2>(s); s += xl::sxor<4>(s); s += xl::sxor<8>(s); ksum[bj][e] = s; }
            if (fr == 0) {
#pragma unroll
                for (int bj = 0; bj < 2; ++bj) { float* kp = kmp + (size_t)(u.pm * 2 + wr) * 256 + bj * HALF + wc * 32 + 8 * fq;
                    *(f32x4*)kp = (f32x4){ksum[bj][0], ksum[bj][1], ksum[bj][2], ksum[bj][3]}; *(f32x4*)(kp + 4) = (f32x4){ksum[bj][4], ksum[bj][5], ksum[bj][6], ksum[bj][7]}; }
            }
        }
    }
};

struct EpiMla {
    static constexpr bool PERM = true, AFTER_DRAIN = false;
    bf16_t* qm; bf16_t* kn; bf16_t* vm; const float* ssq; const float* sskv; const float* tm;
    __device__ __forceinline__ void operator()(const f32x4 (&acc)[2][2][4][2], const Unit& u, int wr, int wc, int fr, int fq) const {
        const int tile = u.pn;
        const int row0 = u.pm * BM + wr * 64 + fr;
        const float QS = 0.10206207261596575f * LOG2E;
#pragma unroll
        for (int ai = 0; ai < 2; ++ai)
#pragma unroll
            for (int m = 0; m < 4; ++m) {
                const int row = row0 + ai * HALF + m * 16;
                const int t = row & 8191;
                float rs;
                if (tile < 2) { const f32x4 p = *(const f32x4*)(ssq + (size_t)row * 4); rs = rsqrtf(((p[0] + p[1]) + (p[2] + p[3])) * (1.0f / 256.0f) + NORM_EPS) * QS; }
                else { const f32x4 p = *(const f32x4*)(sskv + (size_t)row * 4); rs = rsqrtf(((p[0] + p[1]) + (p[2] + p[3])) * (1.0f / 128.0f) + NORM_EPS); }
#pragma unroll
                for (int bj = 0; bj < 2; ++bj) {
                    const int ct = bj * HALF + wc * 32 + 8 * fq;
                    f32x4 v0 = acc[ai][bj][m][0] * rs, v1 = acc[ai][bj][m][1] * rs;
                    if (tile == 0) { *(u32x4*)(qm + (size_t)row * 384 + (ct >> 6) * 96 + (ct & 63)) = pack8(v0, v1); }
                    else if (tile == 1) {
                        if (bj == 0) { const int j0 = (ct & 31) >> 1; const f32x4 c4 = *(const f32x4*)(tm + t * 32 + j0), s4 = *(const f32x4*)(tm + t * 32 + 16 + j0); rot4(v0, v1, c4, s4);
                            *(u32x4*)(qm + (size_t)row * 384 + (ct >> 5) * 96 + 64 + (ct & 31)) = pack8(v0, v1); }
                    }
                    else if (tile == 2) { *(u32x4*)(kn + (size_t)row * 256 + ct) = pack8(v0, v1); }
                    else { *(u32x4*)(vm + (size_t)row * 256 + ct) = pack8(v0, v1); }
                }
            }
    }
};

struct EpiProj {
    static constexpr bool PERM = true, AFTER_DRAIN = false;
    bf16_t* proj; int nM;
    __device__ __forceinline__ void operator()(const f32x4 (&acc)[2][2][4][2], const Unit& u, int wr, int wc, int fr, int fq) const {
        const int n = u.pn >> 2, pn = u.pn & 3, pm = u.pm - n * nM;
        const int row0 = pm * BM + wr * 64 + fr;
#pragma unroll
        for (int ai = 0; ai < 2; ++ai)
#pragma unroll
            for (int m = 0; m < 4; ++m) {
                const int row = row0 + ai * HALF + m * 16;
#pragma unroll
                for (int bj = 0; bj < 2; ++bj) { const int ct = bj * HALF + wc * 32 + 8 * fq;
                    *(u32x4*)(proj + (size_t)row * 4096 + n * 1024 + pn * 256 + ct) = pack8(acc[ai][bj][m][0], acc[ai][bj][m][1]); }
            }
    }
};

struct EpiGate {
    static constexpr bool PERM = true, AFTER_DRAIN = false;
    const bf16_t* proj; bf16_t* merged; const float* ss; const float* bgate;
    __device__ __forceinline__ void operator()(const f32x4 (&acc)[2][2][4][2], const Unit& u, int wr, int wc, int fr, int fq) const {
        const int n = (u.pn - 12) >> 2, pd = (u.pn - 12) & 3;
        const int row0 = u.pm * BM + wr * 64 + fr;
        const int d0 = pd * 256 + wc * 32 + 8 * fq;
        f32x4 bg[2][2];
#pragma unroll
        for (int bj = 0; bj < 2; ++bj) { bg[bj][0] = *(const f32x4*)(bgate + n * 1024 + d0 + bj * HALF); bg[bj][1] = *(const f32x4*)(bgate + n * 1024 + d0 + bj * HALF + 4); }
#pragma unroll
        for (int ai = 0; ai < 2; ++ai)
#pragma unroll
            for (int mp = 0; mp < 2; ++mp) {
                u32x4 pr[2][2], mo[2][2]; float rs[2];
#pragma unroll
                for (int mm = 0; mm < 2; ++mm) {
                    const int row = row0 + ai * HALF + (2 * mp + mm) * 16;
#pragma unroll
                    for (int bj = 0; bj < 2; ++bj) {
                        pr[mm][bj] = *(const u32x4*)(proj + (size_t)row * 4096 + n * 1024 + d0 + bj * HALF);
                        if (n > 0) mo[mm][bj] = *(const u32x4*)(merged + (size_t)row * 1024 + d0 + bj * HALF); else mo[mm][bj] = (u32x4){0u, 0u, 0u, 0u};
                    }
                    rs[mm] = rsqrtf(row_total16(ss, row, fq) * (1.0f / 1024.0f) + NORM_EPS);
                }
#pragma unroll
                for (int mm = 0; mm < 2; ++mm) {
                    const int m = 2 * mp + mm; const int row = row0 + ai * HALF + m * 16;
#pragma unroll
                    for (int bj = 0; bj < 2; ++bj) {
                        f32x4 g0 = acc[ai][bj][m][0] * rs[mm] + bg[bj][0], g1 = acc[ai][bj][m][1] * rs[mm] + bg[bj][1];
#pragma unroll
                        for (int e = 0; e < 4; ++e) { g0[e] = __builtin_amdgcn_rcpf(1.0f + __builtin_amdgcn_exp2f(-g0[e] * LOG2E)); g1[e] = __builtin_amdgcn_rcpf(1.0f + __builtin_amdgcn_exp2f(-g1[e] * LOG2E)); }
                        const u32x4 p = pr[mm][bj], q = mo[mm][bj];
                        f32x4 v0 = g0 * (f32x4){bf_lo(p.x), bf_hi(p.x), bf_lo(p.y), bf_hi(p.y)}, v1 = g1 * (f32x4){bf_lo(p.z), bf_hi(p.z), bf_lo(p.w), bf_hi(p.w)};
                        v0 = v0 + (f32x4){bf_lo(q.x), bf_hi(q.x), bf_lo(q.y), bf_hi(q.y)}; v1 = v1 + (f32x4){bf_lo(q.z), bf_hi(q.z), bf_lo(q.w), bf_hi(q.w)};
                        *(u32x4*)(merged + (size_t)row * 1024 + d0 + bj * HALF) = pack8(v0, v1);
                    }
                }
            }
    }
};

struct EpiResid {
    static constexpr bool PERM = true, AFTER_DRAIN = false;
    const float* basef; bf16_t* xb; float* ss;
    __device__ __forceinline__ void operator()(const f32x4 (&acc)[2][2][4][2], const Unit& u, int wr, int wc, int fr, int fq) const {
        const int row0 = u.pm * BM + wr * 64 + fr, col0 = u.pn * BM + wc * 32 + 8 * fq;
#pragma unroll
        for (int ai = 0; ai < 2; ++ai) {
            u32x4 wb[4][2];
            if (!basef) {
#pragma unroll
                for (int m = 0; m < 4; ++m)
#pragma unroll
                    for (int bj = 0; bj < 2; ++bj) wb[m][bj] = *(const u32x4*)(xb + (size_t)(row0 + ai * HALF + m * 16) * 1024 + col0 + bj * HALF);
            }
#pragma unroll
            for (int m = 0; m < 4; ++m) {
                const int row = row0 + ai * HALF + m * 16;
                const size_t off = (size_t)row * 1024 + col0;
                float sq = 0.f;
#pragma unroll
                for (int bj = 0; bj < 2; ++bj) {
                    f32x4 b0, b1;
                    if (basef) { b0 = *(const f32x4*)(basef + off + bj * HALF); b1 = *(const f32x4*)(basef + off + bj * HALF + 4); }
                    else { const u32x4 w = wb[m][bj]; b0 = (f32x4){bf_lo(w.x), bf_hi(w.x), bf_lo(w.y), bf_hi(w.y)}; b1 = (f32x4){bf_lo(w.z), bf_hi(w.z), bf_lo(w.w), bf_hi(w.w)}; }
                    const f32x4 v0 = b0 + acc[ai][bj][m][0], v1 = b1 + acc[ai][bj][m][1];
                    sq += ((v0[0] * v0[0] + v0[1] * v0[1]) + (v0[2] * v0[2] + v0[3] * v0[3])) + ((v1[0] * v1[0] + v1[1] * v1[1]) + (v1[2] * v1[2] + v1[3] * v1[3]));
                    *(u32x4*)(xb + off + bj * HALF) = pack8(v0, v1);
                }
                sq += xl::sxor<16>(sq); sq = xl::hsum(sq);
                if (fq == 0) ss[(size_t)row * 16 + u.pn * 4 + wc] = sq;
            }
        }
    }
};

struct EpiUp {
    static constexpr bool PERM = true, AFTER_DRAIN = false;
    bf16_t* hid; const float* ss;
    __device__ __forceinline__ void operator()(const f32x4 (&acc)[2][2][4][2], const Unit& u, int wr, int wc, int fr, int fq) const {
        const int row0 = u.pm * BM + wr * 64 + fr;
        float rsv[2][4];
#pragma unroll
        for (int ai = 0; ai < 2; ++ai)
#pragma unroll
            for (int m = 0; m < 4; ++m) rsv[ai][m] = rsqrtf(row_total16(ss, row0 + ai * HALF + m * 16, fq) * (1.0f / 1024.0f) + NORM_EPS);
#pragma unroll
        for (int ai = 0; ai < 2; ++ai)
#pragma unroll
            for (int m = 0; m < 4; ++m) {
                const int row = row0 + ai * HALF + m * 16;
                const float rs = rsv[ai][m];
#pragma unroll
                for (int bj = 0; bj < 2; ++bj) { const int ct = bj * HALF + wc * 32 + 8 * fq;
                    f32x4 v0 = acc[ai][bj][m][0] * rs, v1 = acc[ai][bj][m][1] * rs;
#pragma unroll
                    for (int e = 0; e < 4; ++e) { const float a = fmaxf(v0[e], 0.f), b = fmaxf(v1[e], 0.f); v0[e] = a * a; v1[e] = b * b; }
                    *(u32x4*)(hid + (size_t)row * 4096 + u.pn * 256 + ct) = pack8(v0, v1); }
            }
    }
};

struct ProjOrder {
    int nM, G, c;
    __device__ bool next(int i, Unit& u) const { const long L = (long)i * G + c; if (L >= 16L * nM) return false; const int n = (int)(L / (4 * nM)), r = (int)(L % (4 * nM)); u.pm = n * nM + (r >> 2); u.pn = n * 4 + (r & 3); return true; }
    __device__ __forceinline__ void a_ready(const Unit&) const {}
    __device__ __forceinline__ void done(const Unit&) const {}
};
struct GateOrder {
    StaticOrder so;
    __device__ bool next(int i, Unit& u) const { Unit p; if (!so.next(i >> 2, p)) return false; u.pm = p.pm; u.pn = 12 + 4 * (i & 3) + p.pn; return true; }
    __device__ __forceinline__ void a_ready(const Unit&) const {}
    __device__ __forceinline__ void done(const Unit&) const {}
};
}

namespace mk {
#define GAS __attribute__((address_space(1)))
#define LAS __attribute__((address_space(3)))
typedef unsigned short bf16;
typedef unsigned v4u __attribute__((ext_vector_type(4)));
typedef unsigned v2u __attribute__((ext_vector_type(2)));
typedef float f32x4 __attribute__((ext_vector_type(4)));
typedef float f32x16 __attribute__((ext_vector_type(16)));
typedef short bf16x8 __attribute__((ext_vector_type(8)));
typedef short s16x4 __attribute__((ext_vector_type(4)));
typedef GAS unsigned gu32;
#define RLX_AGENT __ATOMIC_RELAXED, __HIP_MEMORY_SCOPE_AGENT
#define LDS_WAIT() asm volatile("s_waitcnt lgkmcnt(0)" ::: "memory")
#define VM_WAIT() asm volatile("s_waitcnt vmcnt(0)" ::: "memory")

constexpr int NWAVES = 8, NTHR = 512;
constexpr int S = 8192, D = 1024, FF = 4096, NIN = 7112, DEPTH = 2;
constexpr int C_DQ = 0, C_DK = 256, C_DV = 512, C_IQ = 768, C_IK = 1024, C_IW = 1056, C_SQ = 1064, C_SK = 1320, C_SV = 1576,
              C_MQ = 1832, C_MK = 2088, C_MV = 2344, C_CQ = 2600, C_CKV = 2856, C_KR = 2984, C_GATE = 3016;
constexpr float LOG2E = 1.4426950408889634f, LN2 = 0.6931471805599453f;

constexpr size_t MiB = 1u << 20;
constexpr size_t WS_CTL = 0, CTL_ZERO_BYTES = 256 * 1024;
constexpr size_t WS_TP = 1 * MiB, WS_TI = WS_TP + 512 * 1024, WS_TM = 2 * MiB;
constexpr size_t WS_SSA = 3 * MiB, WS_SSB = 4 * MiB, WS_SSQ = 5 * MiB, WS_SSKV = WS_SSQ + 256 * 1024, WS_KMP = WS_SSKV + 256 * 1024;
constexpr size_t WS_WIN = 6 * MiB, WS_WMLA = 20 * MiB, WS_WB = 21 * MiB, WS_WOUT = 23 * MiB, WS_WUP = 25 * MiB, WS_WDOWN = 33 * MiB;
constexpr size_t WS_XB = 41 * MiB;
constexpr size_t WS_ZT = 73 * MiB;
constexpr size_t WS_MLAA = 153 * MiB, WS_MISC = 165 * MiB, WS_QM = 169 * MiB, WS_KN = 181 * MiB, WS_VM = 189 * MiB;
constexpr size_t WS_BITS = 197 * MiB;
constexpr size_t WS_O4 = 213 * MiB;
constexpr size_t WS_PROJ = 73 * MiB;
constexpr size_t WS_MERGED = 213 * MiB;
constexpr size_t WS_HID = 73 * MiB;
constexpr size_t WS_PART = 153 * MiB, WS_LSE = 250 * MiB;
constexpr size_t WS_MLIST = 245 * MiB;
constexpr size_t WS_DSA2 = 185 * MiB, WS_LSED = 251 * MiB;
constexpr size_t WS_END = 252 * MiB;
constexpr int CW_TMO = 0, CW_BAR = 4096, CW_QUEUE = 8192, CW_MCNT = 13312;

constexpr int RING_OFF = 0, RING_BYTES = 131072;
constexpr int LDSCTL_OFF = RING_BYTES, MISC_OFF = LDSCTL_OFF + 320;
constexpr int AUX_OFF = LDSCTL_OFF + 1024;
constexpr int LDS_BYTES = 147456;

__device__ __forceinline__ unsigned f2bf(float f) { unsigned u = __builtin_bit_cast(unsigned, f); return (u + 0x7fffu + ((u >> 16) & 1u)) >> 16; }
__device__ __forceinline__ unsigned pk2(float lo, float hi) { return f2bf(lo) | (f2bf(hi) << 16); }
__device__ __forceinline__ float bf2f(unsigned short b) { return __uint_as_float((unsigned)b << 16); }

#define XB_TMO      128
#define XB_XCNT(j)  (256  + 64 * (j))
#define XB_XSUB(j)  (1280 + 64 * (j))
#define XB_XGEN(j)  (2304 + 64 * (j))
#define XB_TOP      3328
#define XB_TOPGEN   3392
#define XCD_BAR_WORDS 3456
#define XB_SPIN_CAP (1u << 18)
__device__ __forceinline__ unsigned xb_ld(unsigned* p)              { return __hip_atomic_load(p, __ATOMIC_RELAXED, __HIP_MEMORY_SCOPE_AGENT); }
__device__ __forceinline__ unsigned xb_add(unsigned* p, unsigned v) { return __hip_atomic_fetch_add(p, v, __ATOMIC_RELAXED, __HIP_MEMORY_SCOPE_AGENT); }
__device__ __forceinline__ unsigned xb_xcc_id() { return (unsigned)__builtin_amdgcn_s_getreg((3 << 11) | 20) & 0xFu; }
#define XB_SPIN(cond, bar) do { unsigned _sp = 0; while (cond) { __builtin_amdgcn_s_sleep(1); \
    if ((++_sp & 255u) == 0u) { if (xb_ld(&(bar)[XB_TMO])) break; if (_sp > XB_SPIN_CAP) { atomicAdd(&(bar)[XB_TMO], 1u); break; } } } } while (0)
struct XcdBarrier { unsigned* bar; unsigned x; volatile LAS unsigned* st; };
__device__ __forceinline__ XcdBarrier xcd_barrier_post(unsigned* bar, volatile LAS unsigned* st, bool leader) {
    XcdBarrier b; b.bar = bar; b.x = xb_xcc_id(); b.st = st;
    if (leader) (void)xb_add(&bar[XB_XCNT(b.x)], 1u);
    return b;
}
__device__ __forceinline__ void xcd_barrier_complete(unsigned* bar, unsigned x, unsigned& nloc, unsigned& nx) {
    const unsigned G = gridDim.x * gridDim.y * gridDim.z;
    unsigned sum, cnt, mine, sp = 0u;
    for (;;) {
        sum = 0u; cnt = 0u; mine = 0u;
#pragma unroll
        for (unsigned j = 0; j < 16; ++j) { const unsigned c = xb_ld(&bar[XB_XCNT(j)]); sum += c; cnt += (c > 0u) ? 1u : 0u; mine = (j == x) ? c : mine; }
        if (sum == G) break;
        __builtin_amdgcn_s_sleep(1);
        if ((++sp & 255u) == 0u) { if (xb_ld(&bar[XB_TMO])) break; if (sp > XB_SPIN_CAP) { atomicAdd(&bar[XB_TMO], 1u); break; } }
    }
    nloc = mine > 0u ? mine : 1u; nx = cnt > 0u ? cnt : 1u;
}
__device__ __forceinline__ void xcd_barrier(const XcdBarrier& b, bool leader) {
    asm volatile("s_waitcnt vmcnt(0)" ::: "memory");
    __syncthreads();
    if (leader) {
        unsigned* bar = b.bar;
        __builtin_amdgcn_s_waitcnt(0);
        unsigned nloc = b.st[0], nx = b.st[1];
        if (nloc == 0u) { xcd_barrier_complete(bar, b.x, nloc, nx); b.st[0] = nloc; b.st[1] = nx; }
        const unsigned old = xb_add(&bar[XB_XSUB(b.x)], 1u);
        const unsigned gen = old / nloc;
        if (old + 1u == (gen + 1u) * nloc) {
            __builtin_amdgcn_fence(__ATOMIC_RELEASE, "agent");
            asm volatile("s_waitcnt vmcnt(0)" ::: "memory");
            const unsigned og = xb_add(&bar[XB_TOP], 1u);
            const unsigned tg = og / nx;
            if (og + 1u == (tg + 1u) * nx) xb_add(&bar[XB_TOPGEN], 1u);
            else XB_SPIN(xb_ld(&bar[XB_TOPGEN]) == tg, bar);
            __builtin_amdgcn_fence(__ATOMIC_ACQUIRE, "agent");
            xb_add(&bar[XB_XGEN(b.x)], 1u);
            asm volatile("s_waitcnt vmcnt(0)" ::: "memory");
        } else {
            XB_SPIN(xb_ld(&bar[XB_XGEN(b.x)]) == gen, bar);
            __builtin_amdgcn_fence(__ATOMIC_ACQUIRE, "agent");
            asm volatile("s_waitcnt vmcnt(0)" ::: "memory");
        }
    }
    __syncthreads();
}

struct Ptrs {
    const float* in[14]; float* out; unsigned char* ws;
    int ph_lo, ph_hi, li, mrows;
};

__device__ __forceinline__ int unperm(int p, int R) { return p < R ? ((p & 1) ? (p >> 1) + (R >> 1) : (p >> 1)) : p; }
__device__ __forceinline__ int win_src(int n) {
    if (n >= 3072) return C_GATE + (n - 3072);
    const int tile = n >> 8, p = n & 255;
    switch (tile) {
        case 0: return C_DQ + (p & ~63) + unperm(p & 63, 16);
        case 1: return C_DK + (p & ~63) + unperm(p & 63, 16);
        case 2: return C_DV + p;
        case 3: return C_IQ + (p & ~31) + unperm(p & 31, 8);
        case 4: return C_SQ + p;
        case 5: return C_SK + p;
        case 6: return C_SV + p;
        case 7: return C_MQ + (p & ~63) + unperm(p & 63, 16);
        case 8: return C_MK + (p & ~63) + unperm(p & 63, 16);
        case 9: return C_MV + p;
        case 10: return C_CQ + p;
        default:
            if (p < 128) return C_CKV + p;
            if (p < 160) return C_KR + unperm(p - 128, 32);
            if (p < 192) return C_IK + unperm(p - 160, 8);
            if (p < 200) return C_IW + (p - 192);
            return -1;
    }
}
__device__ __forceinline__ void conv_item(const float* W, int ldw, int srccol, int k0, const float* gsc, bf16* WT, int ldk, int kout0, int n0, LAS float* scr, int lane) {
#pragma unroll 8
    for (int i = 0; i < 32; ++i) { const int kk = 2 * i + (lane >> 5);
        float v = 0.f;
        if (srccol >= 0) { v = W[(size_t)(k0 + kk) * ldw + srccol]; if (gsc) v *= gsc[k0 + kk]; }
        scr[kk * 33 + (lane & 31)] = v; }
    LDS_WAIT(); asm volatile("" ::: "memory");
    const int c = lane & 7;
#pragma unroll
    for (int j = 0; j < 4; ++j) { const int n = (lane >> 3) + 8 * j; const LAS float* s = scr + (8 * c) * 33 + n;
        v4u o; o.x = pk2(s[0 * 33], s[1 * 33]); o.y = pk2(s[2 * 33], s[3 * 33]); o.z = pk2(s[4 * 33], s[5 * 33]); o.w = pk2(s[6 * 33], s[7 * 33]);
        *(GAS v4u*)(WT + (size_t)(n0 + n) * ldk + kout0 + 8 * c) = o; }
    LDS_WAIT(); asm volatile("" ::: "memory");
}
__device__ __forceinline__ void conv_item_wide(const float* W, int ldw, int src0, int k0, const float* gsc, bf16* WT, int ldk, int kout0, int n0, LAS float* scr, int lane) {
    const int rr = lane >> 4, c4 = (lane & 15) * 4;
    f32x4 v[16];
#pragma unroll
    for (int i = 0; i < 16; ++i) v[i] = *(const GAS f32x4*)(W + (size_t)(k0 + 4 * i + rr) * ldw + src0 + c4);
#pragma unroll
    for (int i = 0; i < 16; ++i) { f32x4 t = v[i]; if (gsc) t = t * gsc[k0 + 4 * i + rr]; const int row = 4 * i + rr; *(LAS f32x4*)(scr + row * 64 + (c4 ^ (8 * ((row >> 3) & 7)))) = t; }
    LDS_WAIT(); asm volatile("" ::: "memory");
    const int c = lane & 7;
#pragma unroll
    for (int j = 0; j < 8; ++j) { const int n = (lane >> 3) + 8 * j; const LAS float* s = scr + (8 * c) * 64 + (n ^ (8 * c));
        v4u o; o.x = pk2(s[0 * 64], s[1 * 64]); o.y = pk2(s[2 * 64], s[3 * 64]); o.z = pk2(s[4 * 64], s[5 * 64]); o.w = pk2(s[6 * 64], s[7 * 64]);
        *(GAS v4u*)(WT + (size_t)(n0 + n) * ldk + kout0 + 8 * c) = o; }
    LDS_WAIT(); asm volatile("" ::: "memory");
}
__device__ __forceinline__ float wave_sum(float v) {
    v += xl::sxor<1>(v); v += xl::sxor<2>(v); v += xl::sxor<4>(v); v += xl::sxor<8>(v); v += xl::sxor<16>(v); v = xl::hsum(v);
    return v;
}
__device__ __forceinline__ void p0_convert(const Ptrs& P, LAS unsigned char* lds, int gw, int NGW, int wave, int lane) {
    unsigned char* ws = P.ws;
    const int nlay = (P.li < 0) ? 1 : DEPTH;
    for (int l = 0; l < nlay; ++l) {
    unsigned char* wb = (l == 0) ? ws + WS_WIN : (unsigned char*)P.out;
    LAS float* scr = (LAS float*)(lds + RING_OFF + wave * 16384);
    const float* w_in = P.in[2] + (size_t)l * D * NIN; const float* norm_mix = P.in[1] + l * D;
    const float* qn = P.in[4] + l * 256; const float* kvn = P.in[5] + l * 128;
    const float* w_uq = P.in[6] + (size_t)l * 256 * 384; const float* w_ukv = P.in[7] + (size_t)l * 128 * 512;
    const float* w_br = P.in[8] + (size_t)l * 4 * 256 * D; const float* w_out = P.in[9] + (size_t)l * D * D;
    const float* norm_mlp = P.in[10] + l * D; const float* w_up = P.in[11] + (size_t)l * D * FF; const float* w_down = P.in[12] + (size_t)l * FF * D;
    bf16* Win = (bf16*)wb; bf16* Wmla = (bf16*)(wb + (WS_WMLA - WS_WIN)); bf16* Wb = (bf16*)(wb + (WS_WB - WS_WIN)); bf16* Wout = (bf16*)(wb + (WS_WOUT - WS_WIN)); bf16* Wup = (bf16*)(wb + (WS_WUP - WS_WIN)); bf16* Wdown = (bf16*)(wb + (WS_WDOWN - WS_WIN));
    constexpr int I_IN = (D / 64) * (3072 / 32), I_MLA = (384 / 64) * (1024 / 32);
    constexpr int J_G = (D / 64) * (4096 / 64), J_B = (256 / 64) * (4096 / 64), J_OUT = (D / 64) * (D / 64), J_UP = (D / 64) * (FF / 64), J_DOWN = (FF / 64) * (D / 64);
    constexpr int NITEMS = I_IN + I_MLA + J_G + J_B + J_OUT + J_UP + J_DOWN;
    for (int it = gw; it < NITEMS; it += NGW) {
        int r = it;
        if (r < I_IN) { const int nb_ = 3072 / 32, kb = r / nb_, nblk = r % nb_; conv_item(w_in, NIN, win_src(nblk * 32 + (lane & 31)), kb * 64, norm_mix, Win, D, kb * 64, nblk * 32, scr, lane); continue; } r -= I_IN;
        if (r < I_MLA) { const int nb_ = 1024 / 32, kb = r / nb_, nblk = r % nb_; const int n = nblk * 32 + (lane & 31);
            int sc = -1; const float* W = w_uq; int ldw = 384; const float* g = qn; int ks = kb * 64;
            if (kb < 4) { if (n < 256) sc = (n >> 6) * 96 + (n & 63); else if (n < 384) sc = ((n - 256) >> 5) * 96 + 64 + unperm((n - 256) & 31, 32); }
            else { W = w_ukv; ldw = 512; g = kvn; ks = kb * 64 - 256; if (n >= 512 && n < 768) sc = ((n - 512) >> 6) * 128 + ((n - 512) & 63); else if (n >= 768) sc = ((n - 768) >> 6) * 128 + 64 + ((n - 768) & 63); }
            conv_item(W, ldw, sc, ks, g, Wmla, 384, kb * 64, nblk * 32, scr, lane); continue; } r -= I_MLA;
        if (r < J_G) { const int nb_ = 4096 / 64, kb = r / nb_, nblk = r % nb_; conv_item_wide(w_in, NIN, C_GATE + nblk * 64, kb * 64, norm_mix, Win, D, kb * 64, 3072 + nblk * 64, scr, lane); continue; } r -= J_G;
        if (r < J_B) { const int nb_ = 4096 / 64, kb = r / nb_, nblk = r % nb_; const int n = nblk * 64;
            conv_item_wide(w_br + (size_t)(n >> 10) * 256 * D, D, n & 1023, kb * 64, nullptr, Wb, 256, kb * 64, n, scr, lane); continue; } r -= J_B;
        if (r < J_OUT) { const int nb_ = D / 64, kb = r / nb_, nblk = r % nb_; conv_item_wide(w_out, D, nblk * 64, kb * 64, nullptr, Wout, D, kb * 64, nblk * 64, scr, lane); continue; } r -= J_OUT;
        if (r < J_UP) { const int nb_ = FF / 64, kb = r / nb_, nblk = r % nb_; conv_item_wide(w_up, FF, nblk * 64, kb * 64, norm_mlp, Wup, D, kb * 64, nblk * 64, scr, lane); continue; } r -= J_UP;
        { const int nb_ = D / 64, kb = r / nb_, nblk = r % nb_; conv_item_wide(w_down, D, nblk * 64, kb * 64, nullptr, Wdown, FF, kb * 64, nblk * 64, scr, lane); }
    }
    }
    {
        const int M = P.mrows;
        const float* x = P.in[0]; bf16* xb = (bf16*)(ws + WS_XB); float* ssa = (float*)(ws + WS_SSA);
        for (int m = gw; m < M; m += NGW) {
            const GAS f32x4* xr = (const GAS f32x4*)(x + (size_t)m * D) + lane;
            f32x4 v[4]; float s = 0.f;
#pragma unroll
            for (int j = 0; j < 4; ++j) { v[j] = xr[64 * j]; s += (v[j].x * v[j].x + v[j].y * v[j].y) + (v[j].z * v[j].z + v[j].w * v[j].w); }
            s = wave_sum(s);
            GAS unsigned long long* o8 = (GAS unsigned long long*)(xb + (size_t)m * D) + lane;
#pragma unroll
            for (int j = 0; j < 4; ++j) o8[64 * j] = (unsigned long long)pk2(v[j].x, v[j].y) | ((unsigned long long)pk2(v[j].z, v[j].w) << 32);
            if (lane < 16) ssa[(size_t)m * 16 + lane] = (lane == 0) ? s : 0.f;
        }
        float* tp = (float*)(ws + WS_TP); float* ti = (float*)(ws + WS_TI); float* tm = (float*)(ws + WS_TM);
        const int gt = gw * 64 + lane, NGT = NGW * 64;
        for (int e = gt; e < S * 28; e += NGT) {
            const int t = e / 28, j = e % 28;
            int nrot, jj; float* dst; int nh;
            if (j < 8) { nrot = 16; jj = j; dst = tp + t * 16; nh = 8; } else if (j < 12) { nrot = 8; jj = j - 8; dst = ti + t * 8; nh = 4; } else { nrot = 32; jj = j - 12; dst = tm + t * 32; nh = 16; }
            const float inv_freq = 1.0f / powf(500000.0f, (float)(2 * jj) / (float)nrot);
            const float ang = (float)t * inv_freq;
            dst[jj] = cosf(ang); dst[nh + jj] = sinf(ang);
        }
    }
}

__device__ __forceinline__ int crow(int r, int hh) { return (r & 3) + 8 * (r >> 2) + 4 * hh; }
typedef float f32x2_t __attribute__((ext_vector_type(2))); typedef __bf16 bf16x2_t __attribute__((ext_vector_type(2)));
__device__ __forceinline__ unsigned cvtpk(float lo, float hi) { f32x2_t v = {lo, hi}; bf16x2_t b = __builtin_convertvector(v, bf16x2_t); return __builtin_bit_cast(unsigned, b); }
typedef short v4i16_t __attribute__((ext_vector_type(4)));
__device__ __forceinline__ s16x4 vtr(const LAS unsigned char* p) { return __builtin_bit_cast(s16x4, __builtin_amdgcn_ds_read_tr16_b64_v4i16((LAS v4i16_t*)p)); }
__device__ __forceinline__ float ex2(float x) { return __builtin_amdgcn_exp2f(x); }
__device__ __forceinline__ float lg2(float x) { return __builtin_amdgcn_logf(x); }
#define MFMA32(a, b, c) __builtin_amdgcn_mfma_f32_32x32x16_bf16((a), (b), (c), 0, 0, 0)

constexpr int VSTR = 144;
constexpr int KSTR64 = 144, KSTR96 = 208;
constexpr int AT_KBUF = 0, AT_VBUF = 2 * 64 * KSTR96, AT_END = AT_VBUF + 3 * 64 * VSTR;
constexpr int AT_KM = AT_END;
constexpr int AX_UNIT = 0, AX_FLAG = 1, AX_SBF = 8  , AX_SPRE = 32, AX_SREM = 64, AX_SCNT = 96, AX_THR = 128, AX_TB = 160, AX_TREM = 192;

struct MixCtx {
    const bf16* zt; size_t zts;
    const bf16* misc; const bf16* qm; const bf16* kn; const bf16* vm; const float* kmp;
    unsigned* bits; bf16* o4; size_t o4s;
    unsigned* diag;
    unsigned short* mlist; unsigned* mcnt; bf16* part; float* lse; bf16* dsa2; float* lsed;
};
struct TileRegs { v4u k, kx, v; };
template <bool MLA> __device__ __forceinline__ void tile_load(TileRegs& tr, const bf16* Kg, const bf16* Xg, const bf16* Vg, size_t rowbase, int key0, int hcol, int tid) {
    const int row = tid >> 3, ch = tid & 7;
    tr.k = *(const v4u*)(Kg + (rowbase + key0 + row) * 256 + hcol + ch * 8);
    tr.v = *(const v4u*)(Vg + (rowbase + key0 + row) * 256 + hcol + ch * 8);
    if (MLA) { if (tid < 256) { const int r2 = tid >> 2, c2 = tid & 3; tr.kx = *(const v4u*)(Xg + (rowbase + key0 + r2) * 128 + c2 * 8); } }
}
template <bool MLA, int KSTR> __device__ __forceinline__ void tile_store(const TileRegs& tr, LAS unsigned char* Kb, LAS unsigned char* Vb, int tid) {
    const int row = tid >> 3, ch = tid & 7;
    *(LAS v4u*)(Kb + row * KSTR + ch * 16) = tr.k;
    *(LAS v4u*)(Vb + row * VSTR + ch * 16) = tr.v;
    if (MLA) { if (tid < 256) { const int r2 = tid >> 2, c2 = tid & 3; *(LAS v4u*)(Kb + r2 * KSTR + 128 + c2 * 16) = tr.kx; } }
}
template <int NKS, int KSTR> __device__ __forceinline__ void qk_tile(f32x16& s0, f32x16& s1, const LAS unsigned char* Kb, const bf16x8 (&qf)[NKS], int lane, const f32x16 cinit = (f32x16){}) {
    const LAS unsigned char* kp = Kb + (lane & 31) * KSTR + (lane >> 5) * 16;
    s0 = cinit; s1 = cinit;
#pragma unroll
    for (int ks = 0; ks < NKS; ++ks) {
        const bf16x8 a0 = *(const LAS bf16x8*)(kp + ks * 32), a1 = *(const LAS bf16x8*)(kp + 32 * KSTR + ks * 32);
        s0 = MFMA32(a0, qf[ks], s0); s1 = MFMA32(a1, qf[ks], s1);
    }
}
__device__ __forceinline__ bf16x8 packp(const f32x16& p, int b) {
    v4u w; w.x = cvtpk(p[b], p[b + 1]); w.y = cvtpk(p[b + 2], p[b + 3]); w.z = cvtpk(p[b + 4], p[b + 5]); w.w = cvtpk(p[b + 6], p[b + 7]);
    return __builtin_bit_cast(bf16x8, w);
}
__device__ __forceinline__ void pv_tile(f32x16& o0, f32x16& o1, const LAS unsigned char* Vb, const f32x16& p0, const f32x16& p1, int lane) {
    bf16x8 pb[4]; pb[0] = packp(p0, 0); pb[1] = packp(p0, 8); pb[2] = packp(p1, 0); pb[3] = packp(p1, 8);
    const int i = lane & 15, G = lane >> 4, hh = G >> 1;
    const LAS unsigned char* vp = Vb + (4 * hh + (i >> 2)) * VSTR + (16 * (G & 1) + 4 * (i & 3)) * 2;
#pragma unroll
    for (int kb = 0; kb < 2; ++kb)
#pragma unroll
        for (int s = 0; s < 2; ++s) {
            const LAS unsigned char* vq = vp + (kb * 32 + 16 * s) * VSTR;
            const s16x4 l0 = vtr(vq), h0 = vtr(vq + 8 * VSTR), l1 = vtr(vq + 64), h1 = vtr(vq + 8 * VSTR + 64);
            const bf16x8 f0 = (bf16x8){l0[0], l0[1], l0[2], l0[3], h0[0], h0[1], h0[2], h0[3]};
            const bf16x8 f1 = (bf16x8){l1[0], l1[1], l1[2], l1[3], h1[0], h1[1], h1[2], h1[3]};
            o0 = MFMA32(f0, pb[kb * 2 + s], o0); o1 = MFMA32(f1, pb[kb * 2 + s], o1);
        }
}
typedef float f32x2s __attribute__((ext_vector_type(2)));
constexpr float SM_THR = 6.0f;
__device__ __forceinline__ void softmax_tile(f32x16& s0, f32x16& s1, float& mref, bool& mset, f32x16& negm, float& l, f32x16& o0, f32x16& o1) {
    float mx = fmaxf(fmaxf(s0[0], s0[1]), s1[0]);
#pragma unroll
    for (int r = 1; r < 16; ++r) { mx = fmaxf(mx, s0[r]); if (r > 1) mx = fmaxf(mx, s1[r - 1]); }
    mx = fmaxf(mx, s1[15]); mx = fmaxf(mx, s1[0]);
    mx = xl::hmax(mx);
    float dl; const bool was_set = mset;
    if (!mset) { dl = (mx > -INFINITY) ? mx : 0.f; mset = mx > -INFINITY; } else dl = (mx > SM_THR) ? mx : 0.f;
    if (__any(dl != 0.f)) {
        const float alpha = was_set ? ex2(-dl) : 1.0f;
#pragma unroll
        for (int r = 0; r < 16; ++r) { s0[r] -= dl; s1[r] -= dl; o0[r] *= alpha; o1[r] *= alpha; }
        l *= alpha; mref += dl;
#pragma unroll
        for (int r = 0; r < 16; ++r) negm[r] = -mref;
    }
    f32x2s ps = {0.f, 0.f};
#pragma unroll
    for (int r = 0; r < 16; r += 2) { s0[r] = ex2(s0[r]); s0[r + 1] = ex2(s0[r + 1]); s1[r] = ex2(s1[r]); s1[r + 1] = ex2(s1[r + 1]); ps += (f32x2s){s0[r], s0[r + 1]}; ps += (f32x2s){s1[r], s1[r + 1]}; }
    l += ps.x + ps.y;
}
__device__ __forceinline__ void store_ot(bf16* O, size_t row, int hcol, const f32x16& o0, const f32x16& o1, float inv, int hh) {
#pragma unroll
    for (int g = 0; g < 4; ++g) {
        v2u w0, w1;
        w0.x = cvtpk(o0[4 * g] * inv, o0[4 * g + 1] * inv); w0.y = cvtpk(o0[4 * g + 2] * inv, o0[4 * g + 3] * inv);
        w1.x = cvtpk(o1[4 * g] * inv, o1[4 * g + 1] * inv); w1.y = cvtpk(o1[4 * g + 2] * inv, o1[4 * g + 3] * inv);
        *(v2u*)(O + row * 256 + hcol + 8 * g + 4 * hh) = w0;
        *(v2u*)(O + row * 256 + hcol + 32 + 8 * g + 4 * hh) = w1;
    }
}

#ifndef MK_ATTDRY
#define MK_ATTDRY 0
#endif
template <int KIND> __device__ __forceinline__ void softmax_unit(const MixCtx& C, int b, int h, int qb, LAS unsigned char* lds, const int wave0, const int dry = 0, const int half = -1) {
    const int dm = dry ? MK_ATTDRY : 0;
    constexpr bool MLA = (KIND == 0);
    constexpr int NKS = MLA ? 6 : 4, KSTR = MLA ? KSTR96 : KSTR64;
    int tid_ = (wave0 << 6) | xl::fresh_lane(); asm volatile("" : "+v"(tid_));
    const int tid = tid_, lane = tid & 63, r32 = lane & 31, hh = lane >> 5, wave = __builtin_amdgcn_readfirstlane(tid >> 6);
    const size_t rowbase = (size_t)b * S; const int q0 = qb * 256, qw = q0 + 32 * wave, t = qw + r32; const int hcol = h * 64;
    const bf16* Kg = MLA ? C.kn : (KIND == 1 ? C.zt + 1 * C.zts : C.zt + 8 * C.zts);
    const bf16* Vg = MLA ? C.vm : (KIND == 1 ? C.zt + 2 * C.zts : C.zt + 9 * C.zts);
    LAS unsigned char* Kb0 = lds + RING_OFF + AT_KBUF; LAS unsigned char* Vb0 = lds + RING_OFF + AT_VBUF;
    bf16x8 qf[NKS];
    if (MLA) {
#pragma unroll
        for (int ks = 0; ks < NKS; ++ks) qf[ks] = *(const bf16x8*)(C.qm + (rowbase + t) * 384 + h * 96 + 16 * ks + 8 * hh);
    } else {
        const bf16* Qg = (KIND == 1) ? C.zt : C.zt + 7 * C.zts;
#pragma unroll
        for (int ks = 0; ks < NKS; ++ks) qf[ks] = *(const bf16x8*)(Qg + (rowbase + t) * 256 + hcol + 16 * ks + 8 * hh);
    }
    const int NTall = 4 * qb + 4;
    const int jlo = (half == 1) ? NTall / 2 : 0, NT = (half == 0) ? NTall / 2 : NTall;
    TileRegs tr;
    tile_load<MLA>(tr, Kg, C.misc, Vg, rowbase, 64 * jlo, hcol, tid);
    unsigned selmask = 0u;
    if (KIND == 2) {
        LAS float* km = (LAS float*)(lds + RING_OFF + AT_KM);
        for (int e = tid; e < 32 * 64; e += NTHR) { const int n = e >> 6, d = e & 63; const float* p = C.kmp + (size_t)((b * 32 + n) * 2) * 256 + hcol + d; km[e] = (p[0] + p[256]) * (1.0f / 256.0f); }
        __syncthreads();
        float qv[32];
#pragma unroll
        for (int ks = 0; ks < 4; ++ks)
#pragma unroll
            for (int j = 0; j < 8; ++j) qv[ks * 8 + j] = bf2f((unsigned short)qf[ks][j]);
        float g0 = -INFINITY, g1 = -INFINITY, g2 = -INFINITY; int i0 = -1, i1 = -1, i2 = -1;
        for (int n = 0; n < qb; ++n) {
            const LAS float* kp = km + n * 64 + 8 * hh;
            float dot = 0.f;
#pragma unroll
            for (int ks = 0; ks < 4; ++ks) { const f32x4 a = *(const LAS f32x4*)(kp + 16 * ks), c = *(const LAS f32x4*)(kp + 16 * ks + 4);
                dot += qv[ks * 8 + 0] * a[0] + qv[ks * 8 + 1] * a[1] + qv[ks * 8 + 2] * a[2] + qv[ks * 8 + 3] * a[3] + qv[ks * 8 + 4] * c[0] + qv[ks * 8 + 5] * c[1] + qv[ks * 8 + 6] * c[2] + qv[ks * 8 + 7] * c[3]; }
            dot = xl::hsum(dot);
            if (dot > g0) { g2 = g1; i2 = i1; g1 = g0; i1 = i0; g0 = dot; i0 = n; }
            else if (dot > g1) { g2 = g1; i2 = i1; g1 = dot; i1 = n; }
            else if (dot > g2) { g2 = dot; i2 = n; }
        }
        if (i0 >= 0) selmask |= 1u << i0; if (i1 >= 0) selmask |= 1u << i1; if (i2 >= 0) selmask |= 1u << i2;
    }
    tile_store<MLA, KSTR>(tr, Kb0, Vb0, tid);
    __syncthreads();
    f32x16 o0 = {}, o1 = {}, negm = {}; float mref = 0.f, l = 0.f; bool mset = false;
    v2u wv_next = (v2u){0u, 0u};
    if (KIND == 1) wv_next = *(const v2u*)(C.bits + (rowbase + t) * 256 + 2 * jlo);
    const bool late = false;
    f32x16 c0 = {}, c1 = {}; bool cact = false;
    auto do_qk = [&](int j, const v2u wv, f32x16& s0, f32x16& s1) {
        qk_tile<NKS, KSTR>(s0, s1, Kb0 + ((j - jlo) & 1) * 64 * KSTR, qf, lane, negm);
        if (KIND == 1) {
            const unsigned w0 = wv.x >> (4 * hh), w1 = wv.y >> (4 * hh);
#pragma unroll
            for (int r = 0; r < 16; ++r) { const unsigned pos = (unsigned)((r & 3) + 8 * (r >> 2));
                const unsigned m0 = (unsigned)__builtin_amdgcn_sbfe((int)w0, pos, 1u), m1 = (unsigned)__builtin_amdgcn_sbfe((int)w1, pos, 1u);
                s0[r] = __uint_as_float((m0 & __float_as_uint(s0[r])) | (~m0 & 0xff800000u)); s1[r] = __uint_as_float((m1 & __float_as_uint(s1[r])) | (~m1 & 0xff800000u)); }
        } else {
            const bool past_blk = (KIND == 2) && ((j >> 2) < qb);
            if (past_blk) { if (!((selmask >> (j >> 2)) & 1u)) { s0 = s0 - INFINITY; s1 = s1 - INFINITY; } }
            else if (64 * j + 63 > qw) {
#pragma unroll
                for (int r = 0; r < 16; ++r) { const int kk = 64 * j + crow(r, hh); if (kk > t) s0[r] = -INFINITY; if (kk + 32 > t) s1[r] = -INFINITY; }
            }
        }
    };
    int vprev = 2 * 64 * VSTR, vcur = 0, vnext = 64 * VSTR;
    for (int j = jlo; j < NT; ++j) {
        if (j + 1 < NT && !(dm & 16)) tile_load<MLA>(tr, Kg, C.misc, Vg, rowbase, 64 * (j + 1), hcol, tid);
        v2u wv = wv_next;
        bool act = 64 * j <= qw + 31;
        if (KIND == 1) { if (64 * (j + 1) <= qw + 31) wv_next = *(const v2u*)(C.bits + (rowbase + t) * 256 + 2 * (j + 1));
                         if (act) act = __any((wv.x | wv.y) != 0u); }
        if (KIND == 2) { const int n = j >> 2; if (n < qb) act = __any((selmask >> n) & 1u); }
        if (!late) {
            if (act) { f32x16 s0, s1; if (dm & 8) { s0 = negm; s1 = negm; } else do_qk(j, wv, s0, s1); if (!(dm & 2)) softmax_tile(s0, s1, mref, mset, negm, l, o0, o1); if (!(dm & 4)) pv_tile(o0, o1, Vb0 + vcur, s0, s1, lane); else { o0 += s0; o1 += s1; } }
        } else {
            if (cact) { softmax_tile(c0, c1, mref, mset, negm, l, o0, o1); pv_tile(o0, o1, Vb0 + vprev, c0, c1, lane); }
            cact = act;
            if (act) do_qk(j, wv, c0, c1);
        }
        if (j + 1 < NT && !(dm & 16)) tile_store<MLA, KSTR>(tr, Kb0 + ((j + 1 - jlo) & 1) * 64 * KSTR, Vb0 + vnext, tid);
        __syncthreads();
        { const int tmp = vprev; vprev = vcur; vcur = vnext; vnext = tmp; }
    }
    if (late && cact) { softmax_tile(c0, c1, mref, mset, negm, l, o0, o1); pv_tile(o0, o1, Vb0 + vprev, c0, c1, lane); }
    __syncthreads();
    l = xl::hsum(l);
    const int branch = MLA ? 3 : (KIND == 1 ? 0 : 2);
    if (KIND == 1 && half >= 0) {
        const float inv = (l > 0.f) ? 1.0f / l : 0.f;
        store_ot(half == 0 ? C.o4 : C.dsa2, rowbase + t, hcol, o0, o1, inv, hh);
        if (hh == 0) C.lsed[((rowbase + t) * 4 + h) * 2 + half] = (l > 0.f) ? mref + lg2(l) : -INFINITY;
    } else
    if (!(dm & 1)) store_ot(C.o4 + branch * C.o4s, rowbase + t, hcol, o0, o1, 1.0f / l, hh);
    else { float x = l; for (int r = 0; r < 16; ++r) x += o0[r] + o1[r]; asm volatile("" :: "v"(x)); }
}

__device__ __forceinline__ float sb_block(f32x16& z, int kbase, int t, int hh, float cin) {
    float lf[16];
#pragma unroll
    for (int r = 0; r < 16; ++r) {
        const float zz = z[r]; const float e = ex2(-fabsf(zz) * LOG2E);
        const float sp = fmaxf(zz, 0.f) + lg2(1.0f + e) * LN2;
        lf[r] = (kbase + crow(r, hh) < t) ? -sp : 0.f;
    }
    float gs[4], pg[4];
#pragma unroll
    for (int g = 0; g < 4; ++g) { gs[g] = (lf[4 * g] + lf[4 * g + 1]) + (lf[4 * g + 2] + lf[4 * g + 3]); float lo_, hi_; xl::halves(gs[g], lo_, hi_); pg[g] = hh ? lo_ : hi_; }
    float run = 0.f;
#pragma unroll
    for (int g = 3; g >= 0; --g) {
        const float base = cin + run + (hh == 0 ? pg[g] : 0.f);
        const float l3 = base, l2 = l3 + lf[4 * g + 3], l1 = l2 + lf[4 * g + 2], l0 = l1 + lf[4 * g + 1];
        const float la[4] = {l0, l1, l2, l3};
#pragma unroll
        for (int e = 0; e < 4; ++e) { const int r = 4 * g + e; const bool past = kbase + crow(r, hh) < t; z[r] = past ? ex2((z[r] + lf[r] + la[e]) * LOG2E) : 0.f; }
        run += gs[g] + pg[g];
    }
    return run;
}
__device__ __forceinline__ void sb_unit(const MixCtx& C, int b, int h, int qb, LAS unsigned char* lds, const int wave0) {
    int tid_ = (wave0 << 6) | xl::fresh_lane(); asm volatile("" : "+v"(tid_));
    const int tid = tid_, lane = tid & 63, r32 = lane & 31, hh = lane >> 5, wave = __builtin_amdgcn_readfirstlane(tid >> 6);
    const size_t rowbase = (size_t)b * S; const int q0 = qb * 256, qw = q0 + 32 * wave, t = qw + r32; const int hcol = h * 64;
    const bf16* Qg = C.zt + 4 * C.zts; const bf16* Kg = C.zt + 5 * C.zts; const bf16* Vg = C.zt + 6 * C.zts;
    LAS unsigned char* Kb0 = lds + RING_OFF + AT_KBUF; LAS unsigned char* Vb0 = lds + RING_OFF + AT_VBUF;
    volatile LAS unsigned* aux = (volatile LAS unsigned*)(lds + AUX_OFF);
    bf16x8 qf[4];
#pragma unroll
    for (int ks = 0; ks < 4; ++ks) qf[ks] = *(const bf16x8*)(Qg + (rowbase + t) * 256 + hcol + 16 * ks + 8 * hh);
    const int NT = 4 * qb + 4;
    TileRegs tr;
    tile_load<false>(tr, Kg, nullptr, Vg, rowbase, 64 * (NT - 1), hcol, tid);
    tile_store<false, KSTR64>(tr, Kb0, Vb0, tid);
    __syncthreads();
    f32x16 o0 = {}, o1 = {}; float carry = 0.f;
    for (int it = 0; it < NT; ++it) {
        const int j = NT - 1 - it, cur = it & 1;
        if (j > 0) tile_load<false>(tr, Kg, nullptr, Vg, rowbase, 64 * (j - 1), hcol, tid);
        if (64 * j < qw + 31) {
            f32x16 s0, s1;
            qk_tile<4, KSTR64>(s0, s1, Kb0 + cur * 64 * KSTR64, qf, lane);
            const float b1 = sb_block(s1, 64 * j + 32, t, hh, carry);
            const float b0 = sb_block(s0, 64 * j, t, hh, carry + b1);
            carry += b1 + b0;
            pv_tile(o0, o1, Vb0 + cur * 64 * VSTR, s0, s1, lane);
        }
        const bool wdone = __all(carry < -110.0f);
        if (lane == 0) aux[AX_SBF + cur * 8 + wave] = wdone ? 1u : 0u;
        if (j > 0) tile_store<false, KSTR64>(tr, Kb0 + (cur ^ 1) * 64 * KSTR64, Vb0 + (cur ^ 1) * 64 * VSTR, tid);
        __syncthreads();
        unsigned alld = 1u;
#pragma unroll
        for (int w = 0; w < 8; ++w) alld &= aux[AX_SBF + cur * 8 + w];
        if (alld) break;
    }
    __syncthreads();
    store_ot(C.o4 + 1 * C.o4s, rowbase + t, hcol, o0, o1, 1.0f, hh);
}

__device__ __forceinline__ unsigned fkey(float f) { const int u = (int)__float_as_uint(f + 0.0f); return (unsigned)u ^ ((unsigned)(u >> 31) | 0x80000000u); }
__device__ __forceinline__ void idx_keys(unsigned (&key)[16], const bf16* misc, size_t rowbase, int kb, const bf16x8 (&qf)[16], const float (&w)[8], int r32, int hh) {
    const bf16* kr = misc + (rowbase + kb * 32 + r32) * 128 + 32 + 8 * hh;
    const bf16x8 k0 = *(const bf16x8*)kr, k1 = *(const bf16x8*)(kr + 16);
    float sc[16];
#pragma unroll
    for (int hd = 0; hd < 8; ++hd) {
        f32x16 s = MFMA32(k0, qf[2 * hd], (f32x16){});
        s = MFMA32(k1, qf[2 * hd + 1], s);
#pragma unroll
        for (int r = 0; r < 16; ++r) { const float v = fmaxf(s[r], 0.f); sc[r] = (hd == 0) ? w[0] * v : __builtin_fmaf(w[hd], v, sc[r]); }
        if (hd & 1) {
#pragma unroll
            for (int r = 0; r < 16; ++r) asm volatile("" : "+v"(sc[r]));
            __builtin_amdgcn_sched_barrier(0);
        }
    }
#pragma unroll
    for (int r = 0; r < 16; ++r) key[r] = fkey(sc[r]);
}
template <bool DESC, bool PEEK = false> __device__ __forceinline__ void hist_scan(volatile LAS unsigned* hist, int rowstride, int nbins, bool swz, int preshift, volatile LAS unsigned* aux, int tid) {
    const int q = tid >> 4, c = tid & 15, lane = tid & 63, wpc = nbins >> 5, sx = swz ? q : 0;
    unsigned csum = 0u;
    for (int i = 0; i < wpc; ++i) { const unsigned w = hist[q * rowstride + ((c * wpc + ((i + c) & (wpc - 1))) ^ sx)]; csum += (w & 0xffffu) + (w >> 16); }
    unsigned other = 0u;
#pragma unroll
    for (int k = 0; k < 16; ++k) { unsigned v; switch (k) { case 0: v = xl::bcast16<0>(csum); break; case 1: v = xl::bcast16<1>(csum); break; case 2: v = xl::bcast16<2>(csum); break; case 3: v = xl::bcast16<3>(csum); break; case 4: v = xl::bcast16<4>(csum); break; case 5: v = xl::bcast16<5>(csum); break; case 6: v = xl::bcast16<6>(csum); break; case 7: v = xl::bcast16<7>(csum); break; case 8: v = xl::bcast16<8>(csum); break; case 9: v = xl::bcast16<9>(csum); break; case 10: v = xl::bcast16<10>(csum); break; case 11: v = xl::bcast16<11>(csum); break; case 12: v = xl::bcast16<12>(csum); break; case 13: v = xl::bcast16<13>(csum); break; case 14: v = xl::bcast16<14>(csum); break; default: v = xl::bcast16<15>(csum); break; }
        if (DESC ? (k > c) : (k < c)) other += v; }
    const unsigned rem = aux[AX_SREM + q];
    if (other < rem && other + csum >= rem) {
        unsigned cum = other; bool found = false; unsigned bin = 0u, cnt = 0u;
        for (int ii = 0; ii < wpc; ++ii) {
            const int i = DESC ? (wpc - 1 - ii) : ii;
            const unsigned w = hist[q * rowstride + ((c * wpc + i) ^ sx)];
            const unsigned first = DESC ? (w >> 16) : (w & 0xffffu), second = DESC ? (w & 0xffffu) : (w >> 16);
            if (!found) { if (cum + first >= rem) { found = true; bin = 2u * (unsigned)(c * wpc + i) + (DESC ? 1u : 0u); cnt = first; } else cum += first; }
            if (!found) { if (cum + second >= rem) { found = true; bin = 2u * (unsigned)(c * wpc + i) + (DESC ? 0u : 1u); cnt = second; } else cum += second; }
        }
        if (PEEK) { aux[AX_TB + q] = bin; }
        else {
        aux[AX_SPRE + q] = (aux[AX_SPRE + q] << preshift) | bin;
        aux[AX_SREM + q] = rem - cum; aux[AX_SCNT + q] = cnt;
        if (!DESC) { aux[AX_TB + q] = bin; aux[AX_TREM + q] = rem - cum; }
        }
    }
}
__device__ __forceinline__ void hist_zero(LAS unsigned char* lds, int tid) {
    LAS v4u* h4 = (LAS v4u*)(lds + RING_OFF);
    for (int i = tid; i < 8192; i += NTHR) h4[i] = (v4u){0u, 0u, 0u, 0u};
}
__device__ __forceinline__ void sel_unit_slow(const MixCtx& C, int b, int qg, LAS unsigned char* lds, const int wave0) {
    int tid_ = (wave0 << 6) | xl::fresh_lane(); asm volatile("" : "+v"(tid_));
    const int tid = tid_, lane = tid & 63, r32 = lane & 31, hh = lane >> 5, wave = __builtin_amdgcn_readfirstlane(tid >> 6);
    const size_t rowbase = (size_t)b * S; const int t = 32 * qg + r32;
    volatile LAS unsigned* hist = (volatile LAS unsigned*)(lds + RING_OFF);
    LAS unsigned* histw = (LAS unsigned*)(lds + RING_OFF);
    volatile LAS unsigned* aux = (volatile LAS unsigned*)(lds + AUX_OFF);
    bf16x8 qf[16]; float w[8];
    { const bf16* qp = C.zt + 3 * C.zts + (rowbase + t) * 256 + 8 * hh;
#pragma unroll
      for (int i = 0; i < 16; ++i) qf[i] = *(const bf16x8*)(qp + 16 * i);
      const v4u wr = *(const v4u*)(C.misc + (rowbase + t) * 128 + 64);
      w[0] = __uint_as_float(wr.x << 16); w[1] = __uint_as_float(wr.x & 0xffff0000u); w[2] = __uint_as_float(wr.y << 16); w[3] = __uint_as_float(wr.y & 0xffff0000u);
      w[4] = __uint_as_float(wr.z << 16); w[5] = __uint_as_float(wr.z & 0xffff0000u); w[6] = __uint_as_float(wr.w << 16); w[7] = __uint_as_float(wr.w & 0xffff0000u); }
    const int kb_last = 8 * (qg >> 3) + 7;
    if (tid < 32) { aux[AX_SPRE + tid] = 0u; aux[AX_SREM + tid] = 256u; aux[AX_SCNT + tid] = 0u; aux[AX_THR + tid] = 0u; aux[AX_TB + tid] = 0x7fffffffu; aux[AX_TREM + tid] = 0u; }
    if (tid == 0) aux[AX_FLAG] = 0u;
    if (qg >= 8) {
        for (int pass = 0; pass < 3; ++pass) {
            hist_zero(lds, tid);
            __syncthreads();
            const unsigned pre = aux[AX_SPRE + r32];
            for (int kb = wave; kb <= qg; kb += 8) {
                unsigned key[16];
                idx_keys(key, C.misc, rowbase, kb, qf, w, r32, hh);
#pragma unroll
                for (int r = 0; r < 16; ++r) {
                    const bool valid = kb * 32 + crow(r, hh) <= t;
                    const unsigned k = key[r];
                    bool match; unsigned bin;
                    if (pass == 0) { match = true; bin = k >> 21; } else if (pass == 1) { match = (k >> 21) == pre; bin = (k >> 10) & 2047u; } else { match = (k >> 10) == pre; bin = k & 1023u; }
                    if (valid && match) __hip_atomic_fetch_add(histw + r32 * 1024 + ((bin >> 1) ^ (unsigned)r32), 1u << (16 * (bin & 1u)), __ATOMIC_RELAXED, __HIP_MEMORY_SCOPE_WORKGROUP);
                }
            }
            __syncthreads();
            hist_scan<true>(hist, 1024, pass == 2 ? 1024 : 2048, true, pass == 2 ? 10 : 11, aux, tid);
            __syncthreads();
        }
        if (tid < 32) { aux[AX_THR + tid] = aux[AX_SPRE + tid]; if (aux[AX_SREM + tid] < aux[AX_SCNT + tid]) aux[AX_FLAG] = 1u; }
        __syncthreads();
        if (aux[AX_FLAG] != 0u) {
            hist_zero(lds, tid);
            __syncthreads();
            const unsigned thr = aux[AX_THR + r32];
            for (int kb = wave; kb <= qg; kb += 8) {
                unsigned key[16];
                idx_keys(key, C.misc, rowbase, kb, qf, w, r32, hh);
#pragma unroll
                for (int r = 0; r < 16; ++r) {
                    const int s = kb * 32 + crow(r, hh);
                    if (s <= t && key[r] == thr) { const unsigned bin = (unsigned)s >> 2; __hip_atomic_fetch_add(histw + r32 * 1024 + ((bin >> 1) ^ (unsigned)r32), 1u << (16 * (bin & 1u)), __ATOMIC_RELAXED, __HIP_MEMORY_SCOPE_WORKGROUP); }
                }
            }
            __syncthreads();
            hist_scan<false>(hist, 1024, 2048, true, 11, aux, tid);
            __syncthreads();
        }
    }
    __syncthreads();
    {
        const unsigned thr = aux[AX_THR + r32]; const unsigned tb = aux[AX_TB + r32], trem = aux[AX_TREM + r32];
        for (int kb = wave; kb <= kb_last; kb += 8) {
            unsigned word = 0u;
            if (kb <= qg) {
                unsigned key[16];
                idx_keys(key, C.misc, rowbase, kb, qf, w, r32, hh);
#pragma unroll
                for (int g = 0; g < 4; ++g) {
                    unsigned rank = 0u; const unsigned s4 = (unsigned)(kb * 8 + 2 * g + hh);
#pragma unroll
                    for (int e = 0; e < 4; ++e) {
                        const int r = 4 * g + e; const int s = kb * 32 + crow(r, hh);
                        const bool valid = s <= t; const unsigned k = key[r];
                        bool sel = valid && (k > thr);
                        if (valid && k == thr) { ++rank; sel = (s4 < tb) || (s4 == tb && rank <= trem); }
                        word |= (sel ? 1u : 0u) << crow(r, hh);
                    }
                }
            }
            word = xl::hor(word);
            if (hh == 0) C.bits[(rowbase + t) * 256 + kb] = word;
        }
    }
    __syncthreads();
}

constexpr int SL_CKEY = 0, SL_CIDX = 65536, SL_BITW = 98304;
constexpr int SL_SHIST = AUX_OFF + 2048;
constexpr int AX_CCNT = 224;
__device__ __forceinline__ void idx_load(bf16x8& k0, bf16x8& k1, const bf16* misc, size_t rowbase, int kb, int r32, int hh) {
    const bf16* kr = misc + (rowbase + kb * 32 + r32) * 128 + 32 + 8 * hh; k0 = *(const bf16x8*)kr; k1 = *(const bf16x8*)(kr + 16);
}
typedef float f32x2v __attribute__((ext_vector_type(2)));
__device__ __forceinline__ float relu1(float x) { const int b = __float_as_int(x); return __int_as_float(b > 0 ? b : 0); }
__device__ __forceinline__ void idx_keys2(unsigned (&key)[16], const bf16x8 k0, const bf16x8 k1, const bf16x8 (&qf)[16], const float (&w)[8]) {
    f32x2v sc[8];
#pragma unroll
    for (int hd = 0; hd < 8; ++hd) {
        f32x16 s = MFMA32(k0, qf[2 * hd], (f32x16){});
        s = MFMA32(k1, qf[2 * hd + 1], s);
        const f32x2v w2 = {w[hd], w[hd]};
#pragma unroll
        for (int j = 0; j < 8; ++j) { const f32x2v v = {relu1(s[2 * j]), relu1(s[2 * j + 1])}; sc[j] = (hd == 0) ? v * w2 : __builtin_elementwise_fma(v, w2, sc[j]); }
        if (hd & 1) {
#pragma unroll
            for (int j = 0; j < 8; ++j) asm volatile("" : "+v"(sc[j]));
            __builtin_amdgcn_sched_barrier(0);
        }
    }
#pragma unroll
    for (int j = 0; j < 8; ++j) { key[2 * j] = fkey(sc[j].x); key[2 * j + 1] = fkey(sc[j].y); }
}
__device__ __forceinline__ void idx_keys3(unsigned (&key)[16], const bf16x8 k0, const bf16x8 k1, const bf16x8 (&qf)[16], const float (&w2)[8], const bf16x8 ql0, const bf16x8 ql1) {
    float sc[16];
    { f32x16 lin = MFMA32(k0, ql0, (f32x16){}); lin = MFMA32(k1, ql1, lin);
#pragma unroll
      for (int r = 0; r < 16; ++r) sc[r] = lin[r]; }
#pragma unroll
    for (int hd = 0; hd < 8; ++hd) {
        f32x16 s = MFMA32(k0, qf[2 * hd], (f32x16){});
        s = MFMA32(k1, qf[2 * hd + 1], s);
#pragma unroll
        for (int r = 0; r < 16; ++r) sc[r] = __builtin_fmaf(__builtin_fabsf(s[r]), w2[hd], sc[r]);
        if (hd & 1) {
#pragma unroll
            for (int r = 0; r < 16; ++r) asm volatile("" : "+v"(sc[r]));
            __builtin_amdgcn_sched_barrier(0);
        }
    }
#pragma unroll
    for (int r = 0; r < 16; ++r) { const int u = __float_as_int(sc[r]); key[r] = (unsigned)u ^ ((unsigned)(u >> 31) | 0x80000000u); }
}
#ifndef MK_SELDRY
#define MK_SELDRY 0
#endif
__device__ __forceinline__ void sel_unit(const MixCtx& C, int b, int qg, LAS unsigned char* lds, const int wave0, const int dry = 0) {
    const int dm = dry ? MK_SELDRY : 0;
    int tid_ = (wave0 << 6) | xl::fresh_lane(); asm volatile("" : "+v"(tid_));
    const int tid = tid_, lane = tid & 63, r32 = lane & 31, hh = lane >> 5, wave = __builtin_amdgcn_readfirstlane(tid >> 6);
    const size_t rowbase = (size_t)b * S; const int t = 32 * qg + r32;
    const int kb_last = 8 * (qg >> 3) + 7;
    LAS unsigned* histw = (LAS unsigned*)(lds + RING_OFF);
    volatile LAS unsigned* hist = (volatile LAS unsigned*)(lds + RING_OFF);
    volatile LAS unsigned* aux = (volatile LAS unsigned*)(lds + AUX_OFF);
    LAS unsigned* ckey = (LAS unsigned*)(lds + RING_OFF + SL_CKEY); LAS unsigned short* cidx = (LAS unsigned short*)(lds + RING_OFF + SL_CIDX);
    LAS unsigned* bitw = (LAS unsigned*)(lds + RING_OFF + SL_BITW); LAS unsigned* shist = (LAS unsigned*)(lds + SL_SHIST);
    LAS unsigned* auxw = (LAS unsigned*)(lds + AUX_OFF);
    if (qg < 8) {
        { const int q = tid >> 4, tq = 32 * qg + q;
          for (int kb = tid & 15; kb <= kb_last; kb += 16) { const int nbit = tq + 1 - 32 * kb; const unsigned word = nbit <= 0 ? 0u : (nbit >= 32 ? 0xffffffffu : ((1u << nbit) - 1u));
            if (!(dm & 1)) C.bits[(rowbase + tq) * 256 + kb] = word; } }
        return;
    }
    bf16x8 qf[16]; float w[8];
    { const bf16* qp = C.zt + 3 * C.zts + (rowbase + t) * 256 + 8 * hh;
#pragma unroll
      for (int i = 0; i < 16; ++i) qf[i] = *(const bf16x8*)(qp + 16 * i);
      const v4u wr = *(const v4u*)(C.misc + (rowbase + t) * 128 + 64);
      w[0] = __uint_as_float(wr.x << 16); w[1] = __uint_as_float(wr.x & 0xffff0000u); w[2] = __uint_as_float(wr.y << 16); w[3] = __uint_as_float(wr.y & 0xffff0000u);
      w[4] = __uint_as_float(wr.z << 16); w[5] = __uint_as_float(wr.z & 0xffff0000u); w[6] = __uint_as_float(wr.w << 16); w[7] = __uint_as_float(wr.w & 0xffff0000u); }
    float w2[8]; bf16x8 ql0, ql1;
    {
#pragma unroll
        for (int hd = 0; hd < 8; ++hd) w2[hd] = 0.5f * w[hd];
        float a0[8], a1[8];
#pragma unroll
        for (int j = 0; j < 8; ++j) { a0[j] = 0.f; a1[j] = 0.f; }
#pragma unroll
        for (int hd = 0; hd < 8; ++hd)
#pragma unroll
            for (int j = 0; j < 8; ++j) { a0[j] = __builtin_fmaf(w2[hd], bf2f((unsigned short)qf[2 * hd][j]), a0[j]); a1[j] = __builtin_fmaf(w2[hd], bf2f((unsigned short)qf[2 * hd + 1][j]), a1[j]); }
        v4u p0, p1; p0.x = cvtpk(a0[0], a0[1]); p0.y = cvtpk(a0[2], a0[3]); p0.z = cvtpk(a0[4], a0[5]); p0.w = cvtpk(a0[6], a0[7]);
        p1.x = cvtpk(a1[0], a1[1]); p1.y = cvtpk(a1[2], a1[3]); p1.z = cvtpk(a1[4], a1[5]); p1.w = cvtpk(a1[6], a1[7]);
        ql0 = __builtin_bit_cast(bf16x8, p0); ql1 = __builtin_bit_cast(bf16x8, p1);
    }
    if (tid < 32) { aux[AX_SPRE + tid] = 0u; aux[AX_SREM + tid] = 256u; aux[AX_SCNT + tid] = 0u; aux[AX_CCNT + tid] = 0u; aux[AX_TB + tid] = 0u; }
    if (tid == 0) aux[AX_FLAG] = 0u;
    hist_zero(lds, tid);
    __syncthreads();
    {
        bf16x8 k0, k1, n0 = {}, n1 = {};
        int kb = wave;
        if (kb <= qg) idx_load(k0, k1, C.misc, rowbase, kb, r32, hh);
        for (; kb <= qg && !(dm & 16); kb += 8) {
            if (kb + 8 <= qg) idx_load(n0, n1, C.misc, rowbase, kb + 8, r32, hh);
            unsigned key[16];
            idx_keys3(key, k0, k1, qf, w2, ql0, ql1);
            if (dm & 2) { unsigned x = 0u;
#pragma unroll
                for (int r = 0; r < 16; ++r) x ^= key[r];
                asm volatile("" :: "v"(x)); }
            else if (dm & 32) {
#pragma unroll
                for (int r = 0; r < 16; ++r) { const unsigned bin = key[r] >> 21; histw[r32 * 1024 + ((bin >> 1) ^ (unsigned)r32)] = 1u << (16 * (bin & 1u)); }
            }
            else if (kb < qg) {
#pragma unroll
                for (int r = 0; r < 16; ++r) { const unsigned bin = key[r] >> 21; __hip_atomic_fetch_add(histw + r32 * 1024 + ((bin >> 1) ^ (unsigned)r32), 1u << (16 * (bin & 1u)), __ATOMIC_RELAXED, __HIP_MEMORY_SCOPE_WORKGROUP); }
            } else {
#pragma unroll
                for (int r = 0; r < 16; ++r) {
                    if (crow(r, hh) <= r32) { const unsigned bin = key[r] >> 21; __hip_atomic_fetch_add(histw + r32 * 1024 + ((bin >> 1) ^ (unsigned)r32), 1u << (16 * (bin & 1u)), __ATOMIC_RELAXED, __HIP_MEMORY_SCOPE_WORKGROUP); }
                }
            }
            k0 = n0; k1 = n1;
        }
    }
    __syncthreads();
    hist_scan<true>(hist, 1024, 2048, true, 11, aux, tid);
    __syncthreads();
    if (tid < 32) { if (aux[AX_SCNT + tid] > 512u) aux[AX_FLAG] = 1u; }
    __syncthreads();
    if (aux[AX_FLAG] != 0u && !dm) {
#ifdef MK_DIAG_FALLBACKS
        if (tid == 0) atomicAdd((unsigned*)C.diag, 1u);
#endif
        __syncthreads(); sel_unit_slow(C, b, qg, lds, wave0); return; }
    const unsigned b1 = aux[AX_SPRE + r32];
    __syncthreads();
    if (tid < 32) { aux[AX_SPRE + tid] = 0u; }
    {
        bf16x8 k0, k1, n0 = {}, n1 = {};
        int kb = wave;
        if (kb <= qg) idx_load(k0, k1, C.misc, rowbase, kb, r32, hh);
        for (; kb <= kb_last && !(dm & 4); kb += 8) {
            unsigned word = 0u;
            if (kb <= qg) {
                if (kb + 8 <= qg) idx_load(n0, n1, C.misc, rowbase, kb + 8, r32, hh);
                unsigned key[16];
                idx_keys3(key, k0, k1, qf, w2, ql0, ql1);
                const bool diag = (kb == qg);
                unsigned cm = 0u;
                const unsigned vm = diag ? ((2u << r32) - 1u) : 0xffffffffu;
#pragma unroll
                for (int r = 0; r < 16; ++r) {
                    const unsigned hi = key[r] >> 21; const unsigned ok = (vm >> crow(r, hh)) & 1u;
                    word |= (hi > b1 ? ok : 0u) << crow(r, hh); cm |= (hi == b1 ? ok : 0u) << r;
                }
                if (cm != 0u) {
                    unsigned pos = __hip_atomic_fetch_add(auxw + AX_CCNT + r32, (unsigned)__builtin_popcount(cm), __ATOMIC_RELAXED, __HIP_MEMORY_SCOPE_WORKGROUP);
#pragma unroll
                    for (int r = 0; r < 16; ++r) { if ((cm >> r) & 1u) { if (pos < 512u) { ckey[r32 * 512 + pos] = key[r] & 0x1fffffu; cidx[r32 * 512 + pos] = (unsigned short)(8191 - (kb * 32 + crow(r, hh))); } ++pos; } }
                }
                k0 = n0; k1 = n1;
            }
            word = xl::hor(word);
            if (hh == 0) bitw[r32 * 256 + kb] = word;
        }
    }
    __syncthreads();
    {
        const int q = tid >> 4, c16 = tid & 15; int cn = (int)aux[AX_CCNT + q]; cn = cn > 512 ? 512 : cn;
        for (int pass = 0; pass < ((dm & 8) ? 0 : 5); ++pass) {
            for (int i = tid; i < 32 * 64; i += NTHR) shist[i] = 0u;
            __syncthreads();
            const unsigned pre = aux[AX_SPRE + q], thk = aux[AX_THR + q];
            for (int i = c16; i < cn; i += 16) {
                const unsigned ck = ckey[q * 512 + i], cv = cidx[q * 512 + i];
                bool match; unsigned bin;
                if (pass == 0) { match = true; bin = ck >> 14; } else if (pass == 1) { match = (ck >> 14) == pre; bin = (ck >> 7) & 127u; } else if (pass == 2) { match = (ck >> 7) == pre; bin = ck & 127u; }
                else if (pass == 3) { match = ck == thk; bin = cv >> 6; } else { match = (ck == thk) && ((cv >> 6) == pre); bin = cv & 63u; }
                if (match) __hip_atomic_fetch_add(shist + q * 64 + (bin >> 1), 1u << (16 * (bin & 1u)), __ATOMIC_RELAXED, __HIP_MEMORY_SCOPE_WORKGROUP);
            }
            __syncthreads();
            hist_scan<true>((volatile LAS unsigned*)shist, 64, pass == 4 ? 64 : 128, false, pass == 4 ? 6 : 7, aux, tid);
            __syncthreads();
            if (pass == 2) {
                if (tid < 32) { aux[AX_THR + tid] = aux[AX_SPRE + tid]; aux[AX_SPRE + tid] = 0u; if (aux[AX_SREM + tid] < aux[AX_SCNT + tid]) aux[AX_FLAG] = 2u; }
                __syncthreads();
                if (aux[AX_FLAG] != 2u) break;
            }
        }
        const unsigned thk = aux[AX_THR + q], thv = aux[AX_SPRE + q];
        for (int i = c16; i < cn; i += 16) {
            const unsigned ck = ckey[q * 512 + i], cv = cidx[q * 512 + i];
            if (ck > thk || (ck == thk && cv >= thv)) { const unsigned s = 8191u - cv; __hip_atomic_fetch_or(bitw + q * 256 + (s >> 5), 1u << (s & 31u), __ATOMIC_RELAXED, __HIP_MEMORY_SCOPE_WORKGROUP); }
        }
    }
    __syncthreads();
    if (!(dm & 1)) { const int q = tid >> 4; unsigned* bp = C.bits + (rowbase + 32 * qg + q) * 256; for (int kb = tid & 15; kb <= kb_last; kb += 16) __builtin_nontemporal_store(bitw[q * 256 + kb], bp + kb); }
    __syncthreads();
}

constexpr int MOBA_MAXL = 7936, MOBA_PARTS = 2;
__device__ __forceinline__ void moba_gate_unit(const MixCtx& C, int b, int h, int qb, LAS unsigned char* lds, const int wave0) {
    int tid_ = (wave0 << 6) | xl::fresh_lane(); asm volatile("" : "+v"(tid_));
    const int tid = tid_, lane = tid & 63, r32 = lane & 31, hh = lane >> 5, wave = __builtin_amdgcn_readfirstlane(tid >> 6);
    const size_t rowbase = (size_t)b * S; const int t = qb * 256 + 32 * wave + r32; const int hcol = h * 64;
    LAS float* km = (LAS float*)(lds + RING_OFF + AT_KM);
    for (int e = tid; e < 32 * 64; e += NTHR) { const int n = e >> 6, d = e & 63; const float* p = C.kmp + (size_t)((b * 32 + n) * 2) * 256 + hcol + d; km[e] = (p[0] + p[256]) * (1.0f / 256.0f); }
    __syncthreads();
    float qv[32];
    { const bf16* Qg = C.zt + 7 * C.zts;
#pragma unroll
      for (int ks = 0; ks < 4; ++ks) { const bf16x8 q8 = *(const bf16x8*)(Qg + (rowbase + t) * 256 + hcol + 16 * ks + 8 * hh);
#pragma unroll
          for (int j = 0; j < 8; ++j) qv[ks * 8 + j] = bf2f((unsigned short)q8[j]); } }
    float g0 = -INFINITY, g1 = -INFINITY, g2 = -INFINITY; int i0 = -1, i1 = -1, i2 = -1;
    for (int n = 0; n < qb; ++n) {
        const LAS float* kp = km + n * 64 + 8 * hh;
        float dot = 0.f;
#pragma unroll
        for (int ks = 0; ks < 4; ++ks) { const f32x4 a4 = *(const LAS f32x4*)(kp + 16 * ks), c4 = *(const LAS f32x4*)(kp + 16 * ks + 4);
            dot += qv[ks * 8 + 0] * a4[0] + qv[ks * 8 + 1] * a4[1] + qv[ks * 8 + 2] * a4[2] + qv[ks * 8 + 3] * a4[3] + qv[ks * 8 + 4] * c4[0] + qv[ks * 8 + 5] * c4[1] + qv[ks * 8 + 6] * c4[2] + qv[ks * 8 + 7] * c4[3]; }
        dot = xl::hsum(dot);
        if (dot > g0) { g2 = g1; i2 = i1; g1 = g0; i1 = i0; g0 = dot; i0 = n; }
        else if (dot > g1) { g2 = g1; i2 = i1; g1 = dot; i1 = n; }
        else if (dot > g2) { g2 = dot; i2 = n; }
    }
    if (hh == 0) {
        const int sel[3] = {i0, i1, i2};
#pragma unroll
        for (int j = 0; j < 3; ++j) {
            if (sel[j] >= 0) { unsigned* cp = C.mcnt + (b * 4 + h) * 32 + sel[j]; const unsigned pos = atomicAdd(cp, 1u);
                if (pos < (unsigned)MOBA_MAXL) C.mlist[((size_t)((b * 4 + h) * 32 + sel[j])) * MOBA_MAXL + pos] = (unsigned short)(t | (j << 13)); }
            else C.lse[(rowbase + t) * 16 + h * 4 + j] = -INFINITY;
        }
    }
    __syncthreads();
}
__device__ __forceinline__ void moba_blk_unit(const MixCtx& C, int b, int h, int n, int p, bool own, LAS unsigned char* lds, const int wave0) {
    int tid_ = (wave0 << 6) | xl::fresh_lane(); asm volatile("" : "+v"(tid_));
    const int tid = tid_, lane = tid & 63, r32 = lane & 31, hh = lane >> 5, wave = __builtin_amdgcn_readfirstlane(tid >> 6);
    const size_t rowbase = (size_t)b * S; const int hcol = h * 64;
    const int len = own ? 256 : (int)min(C.mcnt[(b * 4 + h) * 32 + n], (unsigned)MOBA_MAXL);
    if (p * 256 >= len) return;
    const bf16* Qg = C.zt + 7 * C.zts; const bf16* Kg = C.zt + 8 * C.zts; const bf16* Vg = C.zt + 9 * C.zts;
    LAS unsigned char* Kb = lds + RING_OFF; LAS unsigned char* Vb = lds + RING_OFF + 256 * KSTR64;
    const unsigned short* lp = C.mlist + ((size_t)((b * 4 + h) * 32 + n)) * MOBA_MAXL;
    unsigned ent_n = 0u; { const int e0 = p * 256 + 32 * wave + r32; if (!own && e0 < len) ent_n = (unsigned)lp[e0]; }
    { v4u kr[4], vr[4];
#pragma unroll
      for (int i = 0; i < 4; ++i) { const int e = tid + i * NTHR, row = e >> 3, ch = e & 7; kr[i] = *(const v4u*)(Kg + (rowbase + n * 256 + row) * 256 + hcol + ch * 8); vr[i] = *(const v4u*)(Vg + (rowbase + n * 256 + row) * 256 + hcol + ch * 8); }
#pragma unroll
      for (int i = 0; i < 4; ++i) { const int e = tid + i * NTHR, row = e >> 3, ch = e & 7; *(LAS v4u*)(Kb + row * KSTR64 + ch * 16) = kr[i]; *(LAS v4u*)(Vb + row * VSTR + ch * 16) = vr[i]; } }
    bf16x8 qn[4];
    { const int tq0 = own ? n * 256 + 32 * wave + r32 : (int)(ent_n & 8191u);
#pragma unroll
      for (int ks = 0; ks < 4; ++ks) qn[ks] = *(const bf16x8*)(Qg + (rowbase + tq0) * 256 + hcol + 16 * ks + 8 * hh); }
    __syncthreads();
    for (int c = p; c * 256 < len; c += MOBA_PARTS) {
        const int e = c * 256 + 32 * wave + r32; const bool valid = e < len;
        int tq, slot;
        if (own) { tq = n * 256 + e; slot = 3; } else { tq = (int)(ent_n & 8191u); slot = (int)(ent_n >> 13); }
        bf16x8 qf[4];
#pragma unroll
        for (int ks = 0; ks < 4; ++ks) qf[ks] = qn[ks];
        if ((c + MOBA_PARTS) * 256 < len) {
            const int e2 = (c + MOBA_PARTS) * 256 + 32 * wave + r32; ent_n = (e2 < len) ? (unsigned)lp[e2] : 0u;
            const int tq2 = (int)(ent_n & 8191u);
#pragma unroll
            for (int ks = 0; ks < 4; ++ks) qn[ks] = *(const bf16x8*)(Qg + (rowbase + tq2) * 256 + hcol + 16 * ks + 8 * hh);
        }
        f32x16 o0 = {}, o1 = {}, negm = {}; float mref = 0.f, l = 0.f; bool mset = false;
#pragma unroll 1
        for (int i = 0; i < 4; ++i) {
            if (own && 64 * i > 32 * wave + 31) break;
            f32x16 s0, s1;
            qk_tile<4, KSTR64>(s0, s1, Kb + i * 64 * KSTR64, qf, lane, negm);
            if (own && 64 * i + 63 > 32 * wave) {
#pragma unroll
                for (int r = 0; r < 16; ++r) { const int kk = n * 256 + 64 * i + crow(r, hh); if (kk > tq) s0[r] = -INFINITY; if (kk + 32 > tq) s1[r] = -INFINITY; }
            }
            softmax_tile(s0, s1, mref, mset, negm, l, o0, o1);
            pv_tile(o0, o1, Vb + i * 64 * VSTR, s0, s1, lane);
        }
        l = xl::hsum(l);
        if (valid) {
            const float inv = 1.0f / l;
            bf16* op = C.part + ((rowbase + tq) * 16 + h * 4 + slot) * 64;
#pragma unroll
            for (int g = 0; g < 4; ++g) {
                v2u w0, w1;
                w0.x = cvtpk(o0[4 * g] * inv, o0[4 * g + 1] * inv); w0.y = cvtpk(o0[4 * g + 2] * inv, o0[4 * g + 3] * inv);
                w1.x = cvtpk(o1[4 * g] * inv, o1[4 * g + 1] * inv); w1.y = cvtpk(o1[4 * g + 2] * inv, o1[4 * g + 3] * inv);
                *(v2u*)(op + 8 * g + 4 * hh) = w0; *(v2u*)(op + 32 + 8 * g + 4 * hh) = w1;
            }
            if (hh == 0) C.lse[(rowbase + tq) * 16 + h * 4 + slot] = mref + lg2(l);
        }
    }
    __syncthreads();
}

#ifndef MK_REPEAT_LP
#define MK_REPEAT_LP -1
#endif
#ifndef MK_REPEAT_KINDS
#define MK_REPEAT_KINDS 15
#endif
#ifndef MK_REPEAT_LAYERS
#define MK_REPEAT_LAYERS 3
#endif
#ifndef MK_REPEAT_CONV
#define MK_REPEAT_CONV 0
#endif
#ifndef MK_EXTRA_BARRIERS
#define MK_EXTRA_BARRIERS 0
#endif
#ifndef MK_ONLY
#define MK_ONLY -1
#endif
#ifndef MK_SKIPMASK
#define MK_SKIPMASK 0
#endif
#define PHON(x) ((MK_ONLY < 0 || MK_ONLY == (x)) && !((MK_SKIPMASK >> (x)) & 1))
#ifndef MK_MIXONLY
#define MK_MIXONLY -1
#endif
#define MIXON(x) (MK_MIXONLY < 0 || MK_MIXONLY == (x))
constexpr int PH_CONV0 = 0, PH_L0 = 1, PH_CONV1 = 10, PH_L1 = 11, PH_FINAL = 20, N_PHASES = 21, PH_MERGE0 = 21, PH_MERGE1 = 22;
constexpr int LP_INPROJ = 0, LP_MLA = 1, LP_MIX = 2, LP_DSA = 3, LP_PROJ = 4, LP_GATE = 5, LP_OUT = 6, LP_UP = 7, LP_DOWN = 8;


#define P_WIN ((bf16*)(wbase + (WS_WIN - WS_WIN)))
#define P_WMLA ((bf16*)(wbase + (WS_WMLA - WS_WIN)))
#define P_WB ((bf16*)(wbase + (WS_WB - WS_WIN)))
#define P_WOUT ((bf16*)(wbase + (WS_WOUT - WS_WIN)))
#define P_WUP ((bf16*)(wbase + (WS_WUP - WS_WIN)))
#define P_WDOWN ((bf16*)(wbase + (WS_WDOWN - WS_WIN)))
#define P_XB    ((bf16*)(ws + WS_XB))
#define P_ZT    ((bf16*)(ws + WS_ZT))
#define P_MLAA  ((bf16*)(ws + WS_MLAA))
#define P_MISC  ((bf16*)(ws + WS_MISC))
#define P_QM    ((bf16*)(ws + WS_QM))
#define P_KN    ((bf16*)(ws + WS_KN))
#define P_VM    ((bf16*)(ws + WS_VM))
#define P_BITS  ((unsigned*)(ws + WS_BITS))
#define P_O4    ((bf16*)(ws + WS_O4))
#define P_PROJ  ((bf16*)(ws + WS_PROJ))
#define P_DSA2  ((bf16*)(ws + WS_DSA2))
#define P_LSED  ((float*)(ws + WS_LSED))
#define P_MERGED ((bf16*)(ws + WS_MERGED))
#define P_HID   ((bf16*)(ws + WS_HID))
#define P_SSA   ((float*)(ws + WS_SSA))
#define P_SSB   ((float*)(ws + WS_SSB))
#define P_SSQ   ((float*)(ws + WS_SSQ))
#define P_SSKV  ((float*)(ws + WS_SSKV))
#define P_KMP   ((float*)(ws + WS_KMP))
#define P_TP    ((const float*)(ws + WS_TP))
#define P_TI    ((const float*)(ws + WS_TI))
#define P_TM    ((const float*)(ws + WS_TM))

__device__ __forceinline__ int next_unit(gu32* ctr, volatile LAS unsigned* aux, int tid) {
    if (tid == 0) aux[AX_UNIT] = __hip_atomic_fetch_add(ctr, 1u, RLX_AGENT);
    __syncthreads();
    const int u = (int)aux[AX_UNIT];
    __syncthreads();
    return u;
}

template <int ph> __device__ __forceinline__ void run_phase(const Ptrs& P, LAS unsigned char* lds, gu32* ctl, int G, int bx, int vcu, const int wave0) {
    volatile LAS unsigned* aux = (volatile LAS unsigned*)(lds + AUX_OFF);
    const int M = P.mrows, nb = M / S;
    const int NGW = G * NWAVES;
    {
        unsigned char* ws = P.ws;
        unsigned char* wbase = (ph >= PH_L1) ? (unsigned char*)P.out : ws + WS_WIN;
        (void)wbase;
        const size_t zts = (size_t)M * 256;
        if (ph == PH_MERGE0 || ph == PH_MERGE1) {
            int tid_ = (wave0 << 6) | xl::fresh_lane(); asm volatile("" : "+v"(tid_)); const int tid = tid_, lane = tid & 63, wave = __builtin_amdgcn_readfirstlane(tid >> 6), gw = vcu * NWAVES + wave;
            const bf16* part = (const bf16*)(ws + WS_PART); const float* lse = (const float*)(ws + WS_LSE); bf16* oc = P_O4 + 2 * zts;
            const int head = lane >> 4, d0 = (lane & 15) * 4;
            for (int m = gw; m < M; m += NGW) {
                const f32x4 L4 = *(const f32x4*)(lse + (size_t)m * 16 + head * 4);
                const float mx = fmaxf(fmaxf(L4[0], L4[1]), fmaxf(L4[2], L4[3]));
                float wsum = 0.f; f32x4 acc = {0.f, 0.f, 0.f, 0.f};
#pragma unroll
                for (int j = 0; j < 4; ++j) { const float w = __builtin_amdgcn_exp2f(L4[j] - mx);
                    if (w > 0.f) { const v2u pv = *(const v2u*)(part + ((size_t)m * 16 + head * 4 + j) * 64 + d0);
                        acc = acc + w * (f32x4){__uint_as_float(pv.x << 16), __uint_as_float(pv.x & 0xffff0000u), __uint_as_float(pv.y << 16), __uint_as_float(pv.y & 0xffff0000u)}; wsum += w; } }
                const float inv = 1.0f / wsum;
                v2u o; o.x = pk2(acc[0] * inv, acc[1] * inv); o.y = pk2(acc[2] * inv, acc[3] * inv);
                *(v2u*)(oc + (size_t)m * 256 + head * 64 + d0) = o;
                {
                    const float la = P_LSED[((size_t)m * 4 + head) * 2], lb = P_LSED[((size_t)m * 4 + head) * 2 + 1];
                    if (lb > -INFINITY) {
                        bf16* oa = P_O4 + (size_t)m * 256 + head * 64 + d0; const bf16* ob = P_DSA2 + (size_t)m * 256 + head * 64 + d0;
                        const float mm = fmaxf(la, lb), wa = __builtin_amdgcn_exp2f(la - mm), wb = __builtin_amdgcn_exp2f(lb - mm), iv = 1.0f / (wa + wb);
                        const v2u pa = *(const v2u*)oa, pb = *(const v2u*)ob;
                        const f32x4 va = {__uint_as_float(pa.x << 16), __uint_as_float(pa.x & 0xffff0000u), __uint_as_float(pa.y << 16), __uint_as_float(pa.y & 0xffff0000u)};
                        const f32x4 vb = {__uint_as_float(pb.x << 16), __uint_as_float(pb.x & 0xffff0000u), __uint_as_float(pb.y << 16), __uint_as_float(pb.y & 0xffff0000u)};
                        const f32x4 r4 = (va * wa + vb * wb) * iv;
                        v2u o2; o2.x = pk2(r4[0], r4[1]); o2.y = pk2(r4[2], r4[3]);
                        *(v2u*)oa = o2;
                    }
                }
            }
        } else if (PHON(9) && ph == PH_CONV0) {
            int tid_ = (wave0 << 6) | xl::fresh_lane(); asm volatile("" : "+v"(tid_)); const int tid = tid_, lane = tid & 63, wave = __builtin_amdgcn_readfirstlane(tid >> 6), gw = vcu * NWAVES + wave; (void)lane; (void)gw;
            p0_convert(P, lds, gw, NGW, wave, lane);
        } else if (ph == PH_CONV1) {
        } else if (PHON(10) && ph == PH_FINAL) {
            int tid_ = (wave0 << 6) | xl::fresh_lane(); asm volatile("" : "+v"(tid_)); const int tid = tid_, lane = tid & 63, wave = __builtin_amdgcn_readfirstlane(tid >> 6), gw = vcu * NWAVES + wave; (void)lane; (void)gw;
            const float* gf = P.in[13];
            for (int m = gw; m < M; m += NGW) {
                const f32x4 pa = *(const f32x4*)(P_SSA + (size_t)m * 16 + 4 * (lane & 3));
                float s = (pa[0] + pa[1]) + (pa[2] + pa[3]); s += xl::sxor<1>(s); s += xl::sxor<2>(s);
                const float rs = rsqrtf(s * (1.0f / 1024.0f) + 1e-6f);
                const bf16* xr = P_XB + (size_t)m * D; float* orow = P.out + (size_t)m * D;
#pragma unroll
                for (int j = 0; j < 2; ++j) { const int c = 512 * j + 8 * lane; const v4u w = *(const v4u*)(xr + c);
                    const f32x4 g0 = *(const f32x4*)(gf + c), g1 = *(const f32x4*)(gf + c + 4);
                    f32x4 o0 = {__uint_as_float(w.x << 16), __uint_as_float(w.x & 0xffff0000u), __uint_as_float(w.y << 16), __uint_as_float(w.y & 0xffff0000u)};
                    f32x4 o1 = {__uint_as_float(w.z << 16), __uint_as_float(w.z & 0xffff0000u), __uint_as_float(w.w << 16), __uint_as_float(w.w & 0xffff0000u)};
                    *(f32x4*)(orow + c) = o0 * rs * g0; *(f32x4*)(orow + c + 4) = o1 * rs * g1; }
            }
#ifdef MK_DIAG_FALLBACKS
            if (gw == 0 && lane == 0) { const unsigned cnt = __hip_atomic_load(ctl + 12288, RLX_AGENT); if (cnt) { asm volatile("s_waitcnt vmcnt(0)" ::: "memory"); P.out[0] = sqrtf((float)cnt * (float)M * 1024.0f * 1.0025f); } }
#endif
        } else {
            const int l = (ph >= PH_L1) ? 1 : 0, lp = ph - (l ? PH_L1 : PH_L0);
            const int nrep = (lp == MK_REPEAT_LP && ((MK_REPEAT_LAYERS >> l) & 1)) ? 2 : 1;
            for (int rep = 0; rep < nrep; ++rep) {
            if (PHON(0) && lp == LP_INPROJ) {
                pg8::Gemm g{P_XB, P_WIN, M, 3072, D}; pg8::StaticOrder so; so.init(M, 3072, G, bx);
                pg8::EpiInProj E{P_ZT, zts, P_MLAA, P_MISC, P_SSA, P_SSQ, P_SSKV, P_KMP, P_TP, P_TI, P_TM};
                pg8::gemm_phase<pg8::EpiInProj, pg8::StaticOrder, true, true>(lds + RING_OFF, g, so, E, wave0);
            } else if (PHON(1) && lp == LP_MLA) {
                pg8::Gemm g{P_MLAA, P_WMLA, M, 1024, 384}; pg8::StaticOrder so; so.init(M, 1024, G, bx);
                pg8::EpiMla E{P_QM, P_KN, P_VM, P_SSQ, P_SSKV, P_TM};
                pg8::gemm_phase<pg8::EpiMla, pg8::StaticOrder, true, true>(lds + RING_OFF, g, so, E, wave0);
            } else if (PHON(2) && lp == LP_MIX) {
                MixCtx MC; MC.zt = P_ZT; MC.zts = zts; MC.misc = P_MISC; MC.qm = P_QM; MC.kn = P_KN; MC.vm = P_VM; MC.kmp = P_KMP; MC.bits = P_BITS; MC.o4 = P_O4; MC.o4s = zts; MC.diag = (unsigned*)(ctl + 12288); MC.mlist = (unsigned short*)(ws + WS_MLIST); MC.mcnt = (unsigned*)(ctl + CW_MCNT + 256 * l); MC.part = (bf16*)(ws + WS_PART); MC.lse = (float*)(ws + WS_LSE); MC.dsa2 = (bf16*)(ws + WS_DSA2); MC.lsed = (float*)(ws + WS_LSED);
                int tid_ = (wave0 << 6) | xl::fresh_lane(); asm volatile("" : "+v"(tid_)); const int tid = tid_, lane = tid & 63, wave = __builtin_amdgcn_readfirstlane(tid >> 6), gw = vcu * NWAVES + wave; (void)lane; (void)gw;
                gu32* ctr = ctl + CW_QUEUE + 64 * (2 * l + 4 * rep);
                const int per = 20 * nb, total = 32 * per;
                for (;;) {
                    const int u = next_unit(ctr, aux, tid);
                    if (u >= total) break;
                    const int L = 31 - u / per, r = u % per;
                    const int kmask = rep ? MK_REPEAT_KINDS : 15;
                    if (r < 12 * nb) { const int kind = r / (4 * nb), rr = r % (4 * nb), b = rr >> 2, h = rr & 3;
                        if (MIXON(0) && kind == 0 && (kmask & 1)) softmax_unit<0>(MC, b, h, L, lds, wave0, rep); else if (MIXON(2) && kind == 1 && (kmask & 4)) sb_unit(MC, b, h, L, lds, wave0);
                        else if (kind == 2 && !rep) moba_gate_unit(MC, b, h, L, lds, wave0); }
                    else if (MIXON(3) && (kmask & 8)) { const int r2 = r - 12 * nb, b = r2 >> 3, qg = 8 * L + 7 - (r2 & 7); sel_unit(MC, b, qg, lds, wave0, rep); }
                }
            } else if (PHON(3) && lp == LP_DSA) {
                MixCtx MC; MC.zt = P_ZT; MC.zts = zts; MC.misc = P_MISC; MC.qm = P_QM; MC.kn = P_KN; MC.vm = P_VM; MC.kmp = P_KMP; MC.bits = P_BITS; MC.o4 = P_O4; MC.o4s = zts; MC.diag = (unsigned*)(ctl + 12288); MC.mlist = (unsigned short*)(ws + WS_MLIST); MC.mcnt = (unsigned*)(ctl + CW_MCNT + 256 * l); MC.part = (bf16*)(ws + WS_PART); MC.lse = (float*)(ws + WS_LSE); MC.dsa2 = (bf16*)(ws + WS_DSA2); MC.lsed = (float*)(ws + WS_LSED);
                int tid_ = (wave0 << 6) | xl::fresh_lane(); asm volatile("" : "+v"(tid_)); const int tid = tid_, lane = tid & 63, wave = __builtin_amdgcn_readfirstlane(tid >> 6), gw = vcu * NWAVES + wave; (void)lane; (void)gw;
                gu32* ctr = ctl + CW_QUEUE + 64 * (2 * l + 1 + 4 * rep);
                const int per = (12 + 4 * MOBA_PARTS) * nb, total = 32 * per;
                for (;;) {
                    const int u = next_unit(ctr, aux, tid);
                    if (u >= total) break;
                    const int L = 31 - u / per, r = u % per;
                    const int kmask = rep ? MK_REPEAT_KINDS : 15;
                    if (r < 8 * nb) { const int hf = r / (4 * nb), rr = r % (4 * nb); softmax_unit<1>(MC, rr >> 2, rr & 3, L, lds, wave0, 0, hf); }
                    else if (r < 12 * nb) { const int rr = r - 8 * nb; if (MIXON(1) && (kmask & 2)) moba_blk_unit(MC, rr >> 2, rr & 3, L, 0, true, lds, wave0); }
                    else { const int rr = r - 12 * nb, bh = rr / MOBA_PARTS, p = rr % MOBA_PARTS; if (MIXON(1) && (kmask & 2) && L > 0) moba_blk_unit(MC, bh >> 2, bh & 3, 31 - L, p, false, lds, wave0); }
                }
            } else if (PHON(4) && lp == LP_PROJ) {
                pg8::Gemm g{P_O4, P_WB, 4 * M, 4096, 256}; pg8::ProjOrder so{M / 256, G, bx};
                pg8::EpiProj E{P_PROJ, M / 256};
                pg8::gemm_phase<pg8::EpiProj, pg8::ProjOrder, true, true>(lds + RING_OFF, g, so, E, wave0);
            } else if (PHON(5) && lp == LP_GATE) {
                pg8::Gemm g{P_XB, P_WIN, M, 7168, D}; pg8::GateOrder so; so.so.init(M, 1024, G, bx);
                pg8::EpiGate E{P_PROJ, P_MERGED, P_SSA, P.in[3] + (size_t)l * 4 * D};
                pg8::gemm_phase<pg8::EpiGate, pg8::GateOrder, true, true>(lds + RING_OFF, g, so, E, wave0);
            } else if (PHON(6) && lp == LP_OUT) {
                pg8::Gemm g{P_MERGED, P_WOUT, M, D, D}; pg8::StaticOrder so; so.init(M, D, G, bx);
                pg8::EpiResid E{(l == 0) ? P.in[0] : nullptr, P_XB, P_SSB};
                pg8::gemm_phase<pg8::EpiResid, pg8::StaticOrder, true, true>(lds + RING_OFF, g, so, E, wave0);
            } else if (PHON(7) && lp == LP_UP) {
                pg8::Gemm g{P_XB, P_WUP, M, FF, D}; pg8::StaticOrder so; so.init(M, FF, G, bx);
                pg8::EpiUp E{P_HID, P_SSB};
                pg8::gemm_phase<pg8::EpiUp, pg8::StaticOrder, true, true>(lds + RING_OFF, g, so, E, wave0);
            } else if (PHON(8)) {
                pg8::Gemm g{P_HID, P_WDOWN, M, D, FF}; pg8::StaticOrder so; so.init(M, D, G, bx);
                pg8::EpiResid E{nullptr, P_XB, P_SSA};
                pg8::gemm_phase<pg8::EpiResid, pg8::StaticOrder, true, true>(lds + RING_OFF, g, so, E, wave0);
            }
            }
        }
    }
}

__global__ void __launch_bounds__(NTHR, 2) mk_fwd(Ptrs P) {
    extern __shared__ __attribute__((aligned(16))) unsigned char lds_raw[];
    LAS unsigned char* lds = (LAS unsigned char*)lds_raw;
    const int tid0 = threadIdx.x;
    const int wave0 = __builtin_amdgcn_readfirstlane(tid0 >> 6);
#define LEADER (wave0 == 0 && xl::fresh_lane() == 0)
    const int G = gridDim.x, bx = blockIdx.x;
    const int vcu = (G % 8 == 0) ? (bx % 8) * (G / 8) + bx / 8 : bx;
    gu32* ctl = (gu32*)(P.ws + WS_CTL);
    volatile LAS unsigned* MISCW = (volatile LAS unsigned*)(lds + MISC_OFF);
    for (int u = tid0; u < (LDS_BYTES - LDSCTL_OFF) / 4; u += NTHR) ((LAS unsigned*)(lds + LDSCTL_OFF))[u] = 0u;
    __syncthreads();
    const bool multi = (P.ph_hi - P.ph_lo) > 1;
    XcdBarrier bar; bar.bar = (unsigned*)(ctl + CW_BAR); bar.x = 0; bar.st = nullptr;
    if (multi) bar = xcd_barrier_post((unsigned*)(ctl + CW_BAR), MISCW + 8, tid0 == 0);
#define RUNPH(k) if (P.ph_lo <= (k) && (k) < P.ph_hi) { run_phase<k>(P, lds, ctl, G, bx, vcu, wave0); if ((k) + 1 < P.ph_hi && (k) != PH_CONV1) xcd_barrier(bar, LEADER); }
    RUNPH(0) RUNPH(1) RUNPH(2) RUNPH(3) RUNPH(4)
    if (P.ph_lo <= PH_L0 + LP_DSA && PH_L0 + LP_PROJ < P.ph_hi) { run_phase<PH_MERGE0>(P, lds, ctl, G, bx, vcu, wave0); xcd_barrier(bar, LEADER); }
    RUNPH(5) RUNPH(6) RUNPH(7) RUNPH(8) RUNPH(9) RUNPH(10)
#if MK_REPEAT_CONV
    RUNPH(10)
#endif
    RUNPH(11) RUNPH(12) RUNPH(13) RUNPH(14)
    if (P.ph_lo <= PH_L1 + LP_DSA && PH_L1 + LP_PROJ < P.ph_hi) { run_phase<PH_MERGE1>(P, lds, ctl, G, bx, vcu, wave0); xcd_barrier(bar, LEADER); }
    RUNPH(15) RUNPH(16) RUNPH(17) RUNPH(18) RUNPH(19) RUNPH(20)
#undef RUNPH
    if (multi) { for (int i = 0; i < MK_EXTRA_BARRIERS; ++i) xcd_barrier(bar, LEADER); }
}

static int g_grid = 0;
static int mk_setup(size_t ws_size) {
    if (g_grid != 0) return g_grid;
    if (ws_size < WS_END) { fprintf(stderr, "kernel_launch: workspace too small (%zu < %zu)\n", ws_size, (size_t)WS_END); g_grid = -1; return g_grid; }
    int dev = 0, cus = 0, per_cu = 0;
    if (hipGetDevice(&dev) != hipSuccess || hipDeviceGetAttribute(&cus, hipDeviceAttributeMultiprocessorCount, dev) != hipSuccess) { g_grid = -1; return g_grid; }
    if (hipFuncSetAttribute((const void*)mk_fwd, hipFuncAttributeMaxDynamicSharedMemorySize, LDS_BYTES) != hipSuccess) { fprintf(stderr, "kernel_launch: hipFuncSetAttribute failed\n"); g_grid = -1; return g_grid; }
    if (hipOccupancyMaxActiveBlocksPerMultiprocessor(&per_cu, (const void*)mk_fwd, NTHR, LDS_BYTES) != hipSuccess || per_cu < 1) fprintf(stderr, "kernel_launch: occupancy query reports %d blocks per CU\n", per_cu);
    (void)hipGetLastError();
    g_grid = cus;
    return g_grid;
}
static void mk_launch(Ptrs a, int lo, int hi, int li, hipStream_t stream) {
    a.ph_lo = lo; a.ph_hi = hi; a.li = li;
    hipLaunchKernelGGL(mk_fwd, dim3(g_grid), dim3(NTHR), LDS_BYTES, stream, a);
}
}

extern "C" void kernel_launch(void* const* d_in, const int* in_sizes, int n_in, void* d_out, int out_size, void* d_ws, size_t ws_size, hipStream_t stream) {
    if (n_in != 14 || out_size != 2 * mk::S * mk::D) { fprintf(stderr, "kernel_launch: unexpected shapes\n"); return; }
    if (mk::mk_setup(ws_size) < 0) return;
    if (hipMemsetAsync((char*)d_ws + mk::WS_CTL, 0, mk::CTL_ZERO_BYTES, stream) != hipSuccess) return;
    mk::Ptrs a{};
    for (int i = 0; i < 14; ++i) a.in[i] = (const float*)d_in[i];
    a.out = (float*)d_out; a.ws = (unsigned char*)d_ws; a.mrows = 2 * mk::S;
#ifndef MK_PER_PHASE
    mk::mk_launch(a, 0, mk::N_PHASES, 0, stream);
#else
    for (int ph = 0; ph < mk::N_PHASES; ++ph) mk::mk_launch(a, ph, ph + 1, ph, stream);
#endif
}
```

```cpp
#include <hip/hip_runtime.h>
#include <hip/hip_bf16.h>
#include <cstdio>
#include <cstdint>
#include <cmath>

namespace xl {
template <int K> __device__ __forceinline__ float sxor(float v) { return __int_as_float(__builtin_amdgcn_ds_swizzle(__float_as_int(v), (K << 10) | 0x1F)); }
template <int K> __device__ __forceinline__ unsigned bcast16(unsigned v) { return (unsigned)__builtin_amdgcn_ds_swizzle((int)v, (K << 5) | 0x10); }
__device__ __forceinline__ void halves(float v, float& lo, float& hi) { auto rr = __builtin_amdgcn_permlane32_swap(__float_as_uint(v), __float_as_uint(v), false, false); lo = __uint_as_float(rr[0]); hi = __uint_as_float(rr[1]); }
__device__ __forceinline__ float hsum(float v) { float lo, hi; halves(v, lo, hi); return lo + hi; }
__device__ __forceinline__ float hmax(float v) { float lo, hi; halves(v, lo, hi); return fmaxf(lo, hi); }
__device__ __forceinline__ unsigned hor(unsigned v) { auto rr = __builtin_amdgcn_permlane32_swap(v, v, false, false); return rr[0] | rr[1]; }
__device__ __forceinline__ int fresh_lane() { int z = 0; asm volatile("" : "+v"(z)); return (int)__builtin_amdgcn_mbcnt_hi(~0u, __builtin_amdgcn_mbcnt_lo(~0u, (unsigned)z)); }
}
namespace pg8 {
#define PG8_LAS __attribute__((address_space(3)))
typedef unsigned short bf16_t;
typedef short bf16x8 __attribute__((ext_vector_type(8)));
typedef float f32x4 __attribute__((ext_vector_type(4)));
typedef unsigned u32x4 __attribute__((ext_vector_type(4)));
constexpr int BM = 256, BK = 64, HALF = 128, HTB = HALF * BK * 2  , STAGE_BYTES = 8 * HTB, NXCD = 8, WGM = 8;

__host__ __device__ __forceinline__ int lds_byte(int r, int c) { const int st = (r >> 4) * 2 + (c >> 5), rr = r & 15, cc = c & 31, ob = rr * 64 + cc * 2; return st * 1024 + (ob ^ (((ob >> 9) & 1) << 5)); }
__host__ __device__ __forceinline__ void stage_rc(int b, int& R, int& C) { const int st = b / 1024, sb = b % 1024, swz = sb ^ (((sb >> 9) & 1) << 5); R = (st >> 1) * 16 + swz / 64; C = (st & 1) * 32 + (swz % 64) / 2; }
__host__ __device__ __forceinline__ int perm32(int rho) { const int n = rho >> 4, i = rho & 15; return 8 * (i >> 2) + 4 * n + (i & 3); }

struct Unit { int pm, pn; };
struct Gemm { const bf16_t* A; const bf16_t* Bt; int M, N, K; };

struct StaticOrder {
    int nM, nN, nwg, G, c;
    __host__ __device__ void init(int M, int N, int G_, int c_) { nM = M / BM; nN = N / BM; nwg = nM * nN; G = G_; c = c_; }
    __host__ __device__ bool next(int i, Unit& u) const {
        const long L = (long)i * G + c; if (L >= nwg) return false;
        int wgid = (int)L; { const int q = nwg / NXCD, r = nwg % NXCD, xcd = wgid % NXCD, off = wgid / NXCD; wgid = (xcd < r ? xcd * (q + 1) : r * (q + 1) + (xcd - r) * q) + off; }
        const int nig = WGM * nN, gid = wgid / nig, fm = gid * WGM, gsz = (nM - fm) < WGM ? (nM - fm) : WGM;
        u.pm = fm + ((wgid % nig) % gsz); u.pn = (wgid % nig) / gsz; return true;
    }
    __device__ __forceinline__ void a_ready(const Unit&) const {}
    __device__ __forceinline__ void done(const Unit&) const {}
};

__device__ __forceinline__ unsigned cvt_pk_bf16(float lo, float hi) { unsigned r; asm volatile("v_cvt_pk_bf16_f32 %0, %1, %2" : "=v"(r) : "v"(lo), "v"(hi)); return r; }
template <class Epi, class Sched, bool ALIGN_EPI = false, bool SP2 = false>
__device__ __forceinline__ void gemm_phase(PG8_LAS unsigned char* lds, const Gemm g, const Sched& S, const Epi& E, const int wave0) {
    int tid_ = (wave0 << 6) | xl::fresh_lane(); asm volatile("" : "+v"(tid_));
    const int tid = tid_, wid = __builtin_amdgcn_readfirstlane(tid >> 6), lane = tid & 63, wr = wid >> 2, wc = wid & 3, fr = lane & 15, fq = lane >> 4;
    int K_ = g.K; asm volatile("" : "+s"(K_));
    const int K = K_, nt = K / BK;
    unsigned voffA[2], voffB[2];
#pragma unroll
    for (int i = 0; i < 2; ++i) { int R, C; stage_rc(tid * 16 + i * 8192, R, C); const int Rb = Epi::PERM ? ((R & ~31) + perm32(R & 31)) : R;
        voffA[i] = (unsigned)(R * K + C) * 2u; voffB[i] = (unsigned)(Rb * K + C) * 2u; }
    const size_t kstep = (size_t)(BK * 2);
    const size_t hstep = (size_t)HALF * K * 2;
    const size_t tstep = 2 * hstep;
    const unsigned ldsw = (unsigned)wid * 1024u;
    const int aoff = lds_byte(wr * 64 + fr, fq * 8), boff = lds_byte(wc * 32 + fr, fq * 8);
#define PG8_SA(b, h) (((b) * 2 + (h)) * HTB)
#define PG8_SB(b, h) ((4 + (b) * 2 + (h)) * HTB)
#define PG8_STAGE(bufoff, gbase, voff) do { _Pragma("unroll") for (int _i = 0; _i < 2; ++_i) \
        __builtin_amdgcn_global_load_lds((const unsigned*)((const char*)(gbase) + (voff)[_i]), (PG8_LAS unsigned*)(lds + (bufoff) + ldsw + _i * 8192), 16, 0, 0); } while (0)
#define PG8_LDA(dst, b, h) do { _Pragma("unroll") for (int m = 0; m < 4; ++m) _Pragma("unroll") for (int k = 0; k < 2; ++k) dst[m][k] = *(const PG8_LAS bf16x8*)(lds + PG8_SA(b, h) + aoff + m * 2048 + k * 1024); } while (0)
#define PG8_LDB(dst, b, h) do { _Pragma("unroll") for (int n = 0; n < 2; ++n) _Pragma("unroll") for (int k = 0; k < 2; ++k) dst[n][k] = *(const PG8_LAS bf16x8*)(lds + PG8_SB(b, h) + boff + n * 2048 + k * 1024); } while (0)
#define PG8_MMA(ai, bj, At, Bt) do { __builtin_amdgcn_s_setprio(1); _Pragma("unroll") for (int m = 0; m < 4; ++m) _Pragma("unroll") for (int n = 0; n < 2; ++n) _Pragma("unroll") for (int k = 0; k < 2; ++k) \
        acc[ai][bj][m][n] = __builtin_amdgcn_mfma_f32_16x16x32_bf16(Bt[n][k], At[m][k], acc[ai][bj][m][n], 0, 0, 0); __builtin_amdgcn_s_setprio(0); } while (0)
#define PG8_WAIT_V(n) asm volatile("s_waitcnt vmcnt(" #n ")" ::: "memory")
#define PG8_WAIT_L(n) asm volatile("s_waitcnt lgkmcnt(" #n ")" ::: "memory")
#define PG8_BAR __builtin_amdgcn_s_barrier()
#define PG8_SCHED __builtin_amdgcn_sched_barrier(0)
    Unit cur, nxt; int ui = 0;
    if (!S.next(0, cur)) return;
    f32x4 acc[2][2][4][2];
#pragma unroll
    for (int a = 0; a < 2; ++a)
#pragma unroll
        for (int b = 0; b < 2; ++b)
#pragma unroll
            for (int m = 0; m < 4; ++m)
#pragma unroll
                for (int n = 0; n < 2; ++n) acc[a][b][m][n] = (f32x4){0.f, 0.f, 0.f, 0.f};
    bf16x8 At[4][2], B0[2][2], B1[2][2];
    const char* cA = (const char*)g.A + (size_t)cur.pm * tstep; const char* cB = (const char*)g.Bt + (size_t)cur.pn * tstep;
    S.a_ready(cur);
    if constexpr (SP2) {
        PG8_STAGE(PG8_SB(0, 0), cB, voffB); PG8_STAGE(PG8_SB(0, 1), cB + hstep, voffB); PG8_STAGE(PG8_SA(0, 0), cA, voffA); PG8_STAGE(PG8_SA(0, 1), cA + hstep, voffA);
        if (wr == 1) PG8_BAR;
        PG8_WAIT_V(2); PG8_BAR;
        PG8_STAGE(PG8_SB(1, 0), cB + kstep, voffB); PG8_STAGE(PG8_SA(1, 0), cA + kstep, voffA); PG8_STAGE(PG8_SB(1, 1), cB + hstep + kstep, voffB);
        PG8_WAIT_V(6); PG8_BAR;
    } else {
        PG8_STAGE(PG8_SB(0, 0), cB, voffB); PG8_STAGE(PG8_SA(0, 0), cA, voffA); PG8_STAGE(PG8_SB(0, 1), cB + hstep, voffB); PG8_STAGE(PG8_SA(0, 1), cA + hstep, voffA);
        if (wr == 1) PG8_BAR;
        PG8_WAIT_V(4); PG8_BAR;
        PG8_STAGE(PG8_SB(1, 0), cB + kstep, voffB); PG8_STAGE(PG8_SA(1, 0), cA + kstep, voffA); PG8_STAGE(PG8_SB(1, 1), cB + hstep + kstep, voffB);
        PG8_WAIT_V(6); PG8_BAR;
    }
    for (;;) {
        const bool has_next = S.next(ui + 1, nxt);
        const char* nA = has_next ? (const char*)g.A + (size_t)nxt.pm * tstep : cA; const char* nB = has_next ? (const char*)g.Bt + (size_t)nxt.pn * tstep : cB;
        for (int t = 0; t < nt; t += 2) {
            const bool last = (t == nt - 2);
            const char* a1 = cA + (size_t)(t + 1) * kstep;
            const char* a2 = last ? nA : cA + (size_t)(t + 2) * kstep; const char* b2 = last ? nB : cB + (size_t)(t + 2) * kstep;
            const char* a3 = a2 + kstep; const char* b3 = b2 + kstep;
            if (last && has_next) S.a_ready(nxt);
            if constexpr (SP2) {
            PG8_LDB(B0, 0, 0); PG8_LDB(B1, 0, 1); PG8_SCHED; PG8_LDA(At, 0, 0); PG8_STAGE(PG8_SA(1, 1), a1 + hstep, voffA);
            PG8_WAIT_V(8); PG8_WAIT_L(0); PG8_BAR; PG8_MMA(0, 0, At, B0); PG8_MMA(0, 1, At, B1); PG8_BAR; PG8_SCHED;
            PG8_LDA(At, 0, 1); PG8_STAGE(PG8_SB(0, 0), b2, voffB); PG8_STAGE(PG8_SB(0, 1), b2 + hstep, voffB); PG8_STAGE(PG8_SA(0, 0), a2, voffA);
            PG8_WAIT_V(8); PG8_WAIT_L(0); PG8_BAR; PG8_MMA(1, 0, At, B0); PG8_MMA(1, 1, At, B1); PG8_BAR; PG8_SCHED;
            PG8_LDB(B0, 1, 0); PG8_LDB(B1, 1, 1); PG8_SCHED; PG8_LDA(At, 1, 0); PG8_STAGE(PG8_SA(0, 1), a2 + hstep, voffA);
            PG8_WAIT_V(8); PG8_WAIT_L(0); PG8_BAR; PG8_MMA(0, 0, At, B0); PG8_MMA(0, 1, At, B1); PG8_BAR; PG8_SCHED;
            PG8_LDA(At, 1, 1); PG8_STAGE(PG8_SB(1, 0), b3, voffB); PG8_STAGE(PG8_SB(1, 1), b3 + hstep, voffB); PG8_STAGE(PG8_SA(1, 0), a3, voffA);
            PG8_WAIT_V(8); PG8_WAIT_L(0); PG8_BAR; PG8_MMA(1, 0, At, B0); PG8_MMA(1, 1, At, B1); PG8_BAR; PG8_SCHED;
            } else {
            PG8_LDB(B0, 0, 0); PG8_SCHED; PG8_LDA(At, 0, 0); PG8_STAGE(PG8_SA(1, 1), a1 + hstep, voffA);
            PG8_WAIT_L(8); PG8_BAR; PG8_WAIT_L(0); PG8_MMA(0, 0, At, B0); PG8_BAR; PG8_SCHED;
            PG8_LDB(B1, 0, 1); PG8_STAGE(PG8_SB(0, 0), b2, voffB);
            PG8_BAR; PG8_WAIT_L(0); PG8_MMA(0, 1, At, B1); PG8_BAR;
            PG8_LDA(At, 0, 1); PG8_STAGE(PG8_SA(0, 0), a2, voffA);
            PG8_BAR; PG8_WAIT_L(0); PG8_MMA(1, 0, At, B0); PG8_BAR; PG8_SCHED;
            PG8_STAGE(PG8_SB(0, 1), b2 + hstep, voffB);
            PG8_WAIT_V(6); PG8_BAR; PG8_MMA(1, 1, At, B1); PG8_BAR;
            PG8_LDB(B0, 1, 0); PG8_SCHED; PG8_LDA(At, 1, 0); PG8_STAGE(PG8_SA(0, 1), a2 + hstep, voffA);
            PG8_WAIT_L(8); PG8_BAR; PG8_WAIT_L(0); PG8_MMA(0, 0, At, B0); PG8_BAR; PG8_SCHED;
            PG8_LDB(B1, 1, 1); PG8_STAGE(PG8_SB(1, 0), b3, voffB);
            PG8_BAR; PG8_WAIT_L(0); PG8_MMA(0, 1, At, B1); PG8_BAR;
            PG8_LDA(At, 1, 1); PG8_STAGE(PG8_SA(1, 0), a3, voffA);
            PG8_BAR; PG8_WAIT_L(0); PG8_MMA(1, 0, At, B0); PG8_BAR; PG8_SCHED;
            PG8_STAGE(PG8_SB(1, 1), b3 + hstep, voffB);
            PG8_WAIT_V(6); PG8_BAR; PG8_MMA(1, 1, At, B1); PG8_BAR;
            }
        }
        if constexpr (ALIGN_EPI) { if (wr == 0) PG8_BAR; }
        if constexpr (!Epi::AFTER_DRAIN) { E(acc, cur, wr, wc, fr, fq); S.done(cur); }
        if (!has_next) break;
#pragma unroll
        for (int a = 0; a < 2; ++a)
#pragma unroll
            for (int b = 0; b < 2; ++b)
#pragma unroll
                for (int m = 0; m < 4; ++m)
#pragma unroll
                    for (int n = 0; n < 2; ++n) acc[a][b][m][n] = (f32x4){0.f, 0.f, 0.f, 0.f};
        cur = nxt; cA = nA; cB = nB; ++ui;
        if constexpr (ALIGN_EPI) { if (wr == 1) PG8_BAR; }
    }
    PG8_WAIT_V(0);
    if constexpr (!ALIGN_EPI) { if (wr == 0) PG8_BAR; }
    PG8_BAR;
    if constexpr (Epi::AFTER_DRAIN) { E.fused(acc, cur, wr, wc, fr, fq, lds, wid, lane); S.done(cur); }
#undef PG8_SA
#undef PG8_SB
#undef PG8_STAGE
#undef PG8_LDA
#undef PG8_LDB
#undef PG8_MMA
#undef PG8_WAIT_V
#undef PG8_WAIT_L
#undef PG8_BAR
#undef PG8_SCHED
}

constexpr float NORM_EPS = 1e-6f;
constexpr float LOG2E = 1.4426950408889634f;
__device__ __forceinline__ u32x4 pack8(const f32x4 a, const f32x4 b) { u32x4 w; w.x = cvt_pk_bf16(a[0], a[1]); w.y = cvt_pk_bf16(a[2], a[3]); w.z = cvt_pk_bf16(b[0], b[1]); w.w = cvt_pk_bf16(b[2], b[3]); return w; }
__device__ __forceinline__ float bf_lo(unsigned w) { return __uint_as_float(w << 16); }
__device__ __forceinline__ float bf_hi(unsigned w) { return __uint_as_float(w & 0xffff0000u); }
__device__ __forceinline__ float row_total16(const float* ss, int row, int fq) {
    const f32x4 p = *(const f32x4*)(ss + (size_t)row * 16 + 4 * fq);
    float s = (p[0] + p[1]) + (p[2] + p[3]);
    s += xl::sxor<16>(s); s = xl::hsum(s);
    return s;
}
__device__ __forceinline__ void rot4(f32x4& v0, f32x4& v1, const f32x4 c4, const f32x4 s4) {
    const float a0 = v0[0] * c4[0] - v0[1] * s4[0], b0 = v0[1] * c4[0] + v0[0] * s4[0];
    const float a1 = v0[2] * c4[1] - v0[3] * s4[1], b1 = v0[3] * c4[1] + v0[2] * s4[1];
    const float a2 = v1[0] * c4[2] - v1[1] * s4[2], b2 = v1[1] * c4[2] + v1[0] * s4[2];
    const float a3 = v1[2] * c4[3] - v1[3] * s4[3], b3 = v1[3] * c4[3] + v1[2] * s4[3];
    v0 = (f32x4){a0, b0, a1, b1}; v1 = (f32x4){a2, b2, a3, b3};
}

struct EpiInProj {
    static constexpr bool PERM = true, AFTER_DRAIN = false;
    bf16_t* zt; size_t zt_stride; bf16_t* mla_a; bf16_t* misc; const float* ss; float* ssq; float* sskv; float* kmp; const float* tp; const float* ti; const float* tm;
    __device__ __forceinline__ void operator()(const f32x4 (&acc)[2][2][4][2], const Unit& u, int wr, int wc, int fr, int fq) const {
        const int tile = u.pn;
        const int row0 = u.pm * BM + wr * 64 + fr;
        const bool rot64 = (tile == 0) | (tile == 1) | (tile == 7) | (tile == 8);
        const float scl = (tile == 0 || tile == 7) ? 0.125f * LOG2E : (tile == 4 ? 0.125f : 1.0f);
        float ksum[2][8];
#pragma unroll
        for (int bj = 0; bj < 2; ++bj)
#pragma unroll
            for (int e = 0; e < 8; ++e) ksum[bj][e] = 0.f;
        float rsv[2][4];
#pragma unroll
        for (int ai = 0; ai < 2; ++ai)
#pragma unroll
            for (int m = 0; m < 4; ++m) rsv[ai][m] = rsqrtf(row_total16(ss, row0 + ai * HALF + m * 16, fq) * (1.0f / 1024.0f) + NORM_EPS);
        const int ct0 = wc * 32 + 8 * fq;
        const float* rtab = nullptr; int rstride = 0, coff = 0, soff = 0, rbj = 3;
        if (rot64) { if ((ct0 & 63) < 16) { rtab = tp; rstride = 16; coff = (ct0 & 63) >> 1; soff = coff + 8; } }
        else if (tile == 3) { if ((ct0 & 31) == 0) { rtab = ti; rstride = 8; coff = 0; soff = 4; } }
        else if (tile == 11) { rbj = 2; if (wc == 0) { rtab = tm; rstride = 32; coff = ct0 >> 1; soff = coff + 16; } else if (wc == 1 && fq == 0) { rtab = ti; rstride = 8; coff = 0; soff = 4; } }
#pragma unroll
        for (int am = 0; am < 4; ++am) {
            const int ai = am >> 1;
            f32x4 c4[2], s4[2];
            if (rtab) {
#pragma unroll
                for (int mm = 0; mm < 2; ++mm) { const int t = (row0 + ai * HALF + (2 * (am & 1) + mm) * 16) & 8191; c4[mm] = *(const f32x4*)(rtab + t * rstride + coff); s4[mm] = *(const f32x4*)(rtab + t * rstride + soff); }
            }
#pragma unroll
            for (int mm = 0; mm < 2; ++mm) {
                const int m = 2 * (am & 1) + mm;
                const int row = row0 + ai * HALF + m * 16;
                const float rs = rsv[ai][m];
                float sq0 = 0.f, sq1 = 0.f;
#pragma unroll
                for (int bj = 0; bj < 2; ++bj) {
                    const int ct = bj * HALF + ct0;
                    f32x4 v0 = acc[ai][bj][m][0] * rs, v1 = acc[ai][bj][m][1] * rs;
                    if (rtab && ((rbj >> bj) & 1)) rot4(v0, v1, c4[mm], s4[mm]);
                    if (tile <= 9) {
                        if (tile == 8) {
#pragma unroll
                            for (int e = 0; e < 4; ++e) { ksum[bj][e] += v0[e]; ksum[bj][4 + e] += v1[e]; }
                        }
                        v0 = v0 * scl; v1 = v1 * scl;
                        *(u32x4*)(zt + (size_t)tile * zt_stride + (size_t)row * 256 + ct) = pack8(v0, v1);
                    } else if (tile == 10) {
                        sq0 += (v0[0] * v0[0] + v0[1] * v0[1]) + (v0[2] * v0[2] + v0[3] * v0[3]) + (v1[0] * v1[0] + v1[1] * v1[1]) + (v1[2] * v1[2] + v1[3] * v1[3]);
                        *(u32x4*)(mla_a + (size_t)row * 384 + ct) = pack8(v0, v1);
                    } else {
                        if (bj == 0) {
                            sq1 += (v0[0] * v0[0] + v0[1] * v0[1]) + (v0[2] * v0[2] + v0[3] * v0[3]) + (v1[0] * v1[0] + v1[1] * v1[1]) + (v1[2] * v1[2] + v1[3] * v1[3]);
                            *(u32x4*)(mla_a + (size_t)row * 384 + 256 + ct) = pack8(v0, v1);
                        } else {
                            if (wc == 2) { v0 = v0 * 0.0625f; v1 = v1 * 0.0625f; }
                            *(u32x4*)(misc + (size_t)row * 128 + ct0) = pack8(v0, v1);
                        }
                    }
                }
                if (tile == 10) { sq0 += xl::sxor<16>(sq0); sq0 = xl::hsum(sq0); if (fq == 0) ssq[(size_t)row * 4 + wc] = sq0; }
                if (tile == 11) { sq1 += xl::sxor<16>(sq1); sq1 = xl::hsum(sq1); if (fq == 0) sskv[(size_t)row * 4 + wc] = sq1; }
            }
        }
        if (tile == 8) {
#pragma unroll
            for (int bj = 0; bj < 2; ++bj)
#pragma unroll
                for (int e = 0; e < 8; ++e) { float s = ksum[bj][e]; s += xl::sxor<1>(s); s += xl::sxor<2>(s); s += xl::sxor<4>(s); s += xl::sxor<8>(s); ksum[bj][e] = s; }
            if (fr == 0) {
#pragma unroll
                for (int bj = 0; bj < 2; ++bj) { float* kp = kmp + (size_t)(u.pm * 2 + wr) * 256 + bj * HALF + wc * 32 + 8 * fq;
                    *(f32x4*)kp = (f32x4){ksum[bj][0], ksum[bj][1], ksum[bj][2], ksum[bj][3]}; *(f32x4*)(kp + 4) = (f32x4){ksum[bj][4], ksum[bj][5], ksum[bj][6], ksum[bj][7]}; }
            }
        }
    }
};

struct EpiMla {
    static constexpr bool PERM = true, AFTER_DRAIN = false;
    bf16_t* qm; bf16_t* kn; bf16_t* vm; const float* ssq; const float* sskv; const float* tm;
    __device__ __forceinline__ void operator()(const f32x4 (&acc)[2][2][4][2], const Unit& u, int wr, int wc, int fr, int fq) const {
        const int tile = u.pn;
        const int row0 = u.pm * BM + wr * 64 + fr;
        const float QS = 0.10206207261596575f * LOG2E;
#pragma unroll
        for (int ai = 0; ai < 2; ++ai)
#pragma unroll
            for (int m = 0; m < 4; ++m) {
                const int row = row0 + ai * HALF + m * 16;
                const int t = row & 8191;
                float rs;
                if (tile < 2) { const f32x4 p = *(const f32x4*)(ssq + (size_t)row * 4); rs = rsqrtf(((p[0] + p[1]) + (p[2] + p[3])) * (1.0f / 256.0f) + NORM_EPS) * QS; }
                else { const f32x4 p = *(const f32x4*)(sskv + (size_t)row * 4); rs = rsqrtf(((p[0] + p[1]) + (p[2] + p[3])) * (1.0f / 128.0f) + NORM_EPS); }
#pragma unroll
                for (int bj = 0; bj < 2; ++bj) {
                    const int ct = bj * HALF + wc * 32 + 8 * fq;
                    f32x4 v0 = acc[ai][bj][m][0] * rs, v1 = acc[ai][bj][m][1] * rs;
                    if (tile == 0) { *(u32x4*)(qm + (size_t)row * 384 + (ct >> 6) * 96 + (ct & 63)) = pack8(v0, v1); }
                    else if (tile == 1) {
                        if (bj == 0) { const int j0 = (ct & 31) >> 1; const f32x4 c4 = *(const f32x4*)(tm + t * 32 + j0), s4 = *(const f32x4*)(tm + t * 32 + 16 + j0); rot4(v0, v1, c4, s4);
                            *(u32x4*)(qm + (size_t)row * 384 + (ct >> 5) * 96 + 64 + (ct & 31)) = pack8(v0, v1); }
                    }
                    else if (tile == 2) { *(u32x4*)(kn + (size_t)row * 256 + ct) = pack8(v0, v1); }
                    else { *(u32x4*)(vm + (size_t)row * 256 + ct) = pack8(v0, v1); }
                }
            }
    }
};

struct EpiProj {
    static constexpr bool PERM = true, AFTER_DRAIN = false;
    bf16_t* proj; int nM;
    __device__ __forceinline__ void operator()(const f32x4 (&acc)[2][2][4][2], const Unit& u, int wr, int wc, int fr, int fq) const {
        const int n = u.pn >> 2, pn = u.pn & 3, pm = u.pm - n * nM;
        const int row0 = pm * BM + wr * 64 + fr;
#pragma unroll
        for (int ai = 0; ai < 2; ++ai)
#pragma unroll
            for (int m = 0; m < 4; ++m) {
                const int row = row0 + ai * HALF + m * 16;
#pragma unroll
                for (int bj = 0; bj < 2; ++bj) { const int ct = bj * HALF + wc * 32 + 8 * fq;
                    *(u32x4*)(proj + (size_t)row * 4096 + n * 1024 + pn * 256 + ct) = pack8(acc[ai][bj][m][0], acc[ai][bj][m][1]); }
            }
    }
};

struct EpiGate {
    static constexpr bool PERM = true, AFTER_DRAIN = false;
    const bf16_t* proj; bf16_t* merged; const float* ss; const float* bgate;
    __device__ __forceinline__ void operator()(const f32x4 (&acc)[2][2][4][2], const Unit& u, int wr, int wc, int fr, int fq) const {
        const int n = (u.pn - 12) >> 2, pd = (u.pn - 12) & 3;
        const int row0 = u.pm * BM + wr * 64 + fr;
        const int d0 = pd * 256 + wc * 32 + 8 * fq;
        f32x4 bg[2][2];
#pragma unroll
        for (int bj = 0; bj < 2; ++bj) { bg[bj][0] = *(const f32x4*)(bgate + n * 1024 + d0 + bj * HALF); bg[bj][1] = *(const f32x4*)(bgate + n * 1024 + d0 + bj * HALF + 4); }
#pragma unroll
        for (int ai = 0; ai < 2; ++ai)
#pragma unroll
            for (int mp = 0; mp < 2; ++mp) {
                u32x4 pr[2][2], mo[2][2]; float rs[2];
#pragma unroll
                for (int mm = 0; mm < 2; ++mm) {
                    const int row = row0 + ai * HALF + (2 * mp + mm) * 16;
#pragma unroll
                    for (int bj = 0; bj < 2; ++bj) {
                        pr[mm][bj] = *(const u32x4*)(proj + (size_t)row * 4096 + n * 1024 + d0 + bj * HALF);
                        if (n > 0) mo[mm][bj] = *(const u32x4*)(merged + (size_t)row * 1024 + d0 + bj * HALF); else mo[mm][bj] = (u32x4){0u, 0u, 0u, 0u};
                    }
                    rs[mm] = rsqrtf(row_total16(ss, row, fq) * (1.0f / 1024.0f) + NORM_EPS);
                }
#pragma unroll
                for (int mm = 0; mm < 2; ++mm) {
                    const int m = 2 * mp + mm; const int row = row0 + ai * HALF + m * 16;
#pragma unroll
                    for (int bj = 0; bj < 2; ++bj) {
                        f32x4 g0 = acc[ai][bj][m][0] * rs[mm] + bg[bj][0], g1 = acc[ai][bj][m][1] * rs[mm] + bg[bj][1];
#pragma unroll
                        for (int e = 0; e < 4; ++e) { g0[e] = __builtin_amdgcn_rcpf(1.0f + __builtin_amdgcn_exp2f(-g0[e] * LOG2E)); g1[e] = __builtin_amdgcn_rcpf(1.0f + __builtin_amdgcn_exp2f(-g1[e] * LOG2E)); }
                        const u32x4 p = pr[mm][bj], q = mo[mm][bj];
                        f32x4 v0 = g0 * (f32x4){bf_lo(p.x), bf_hi(p.x), bf_lo(p.y), bf_hi(p.y)}, v1 = g1 * (f32x4){bf_lo(p.z), bf_hi(p.z), bf_lo(p.w), bf_hi(p.w)};
                        v0 = v0 + (f32x4){bf_lo(q.x), bf_hi(q.x), bf_lo(q.y), bf_hi(q.y)}; v1 = v1 + (f32x4){bf_lo(q.z), bf_hi(q.z), bf_lo(q.w), bf_hi(q.w)};
                        *(u32x4*)(merged + (size_t)row * 1024 + d0 + bj * HALF) = pack8(v0, v1);
                    }
                }
            }
    }
};

struct EpiResid {
    static constexpr bool PERM = true, AFTER_DRAIN = false;
    const float* basef; bf16_t* xb; float* ss;
    __device__ __forceinline__ void operator()(const f32x4 (&acc)[2][2][4][2], const Unit& u, int wr, int wc, int fr, int fq) const {
        const int row0 = u.pm * BM + wr * 64 + fr, col0 = u.pn * BM + wc * 32 + 8 * fq;
#pragma unroll
        for (int ai = 0; ai < 2; ++ai) {
            u32x4 wb[4][2];
            if (!basef) {
#pragma unroll
                for (int m = 0; m < 4; ++m)
#pragma unroll
                    for (int bj = 0; bj < 2; ++bj) wb[m][bj] = *(const u32x4*)(xb + (size_t)(row0 + ai * HALF + m * 16) * 1024 + col0 + bj * HALF);
            }
#pragma unroll
            for (int m = 0; m < 4; ++m) {
                const int row = row0 + ai * HALF + m * 16;
                const size_t off = (size_t)row * 1024 + col0;
                float sq = 0.f;
#pragma unroll
                for (int bj = 0; bj < 2; ++bj) {
                    f32x4 b0, b1;
                    if (basef) { b0 = *(const f32x4*)(basef + off + bj * HALF); b1 = *(const f32x4*)(basef + off + bj * HALF + 4); }
                    else { const u32x4 w = wb[m][bj]; b0 = (f32x4){bf_lo(w.x), bf_hi(w.x), bf_lo(w.y), bf_hi(w.y)}; b1 = (f32x4){bf_lo(w.z), bf_hi(w.z), bf_lo(w.w), bf_hi(w.w)}; }
                    const f32x4 v0 = b0 + acc[ai][bj][m][0], v1 = b1 + acc[ai][bj][m][1];
                    sq += ((v0[0] * v0[0] + v0[1] * v0[1]) + (v0[2] * v0[2] + v0[3] * v0[3])) + ((v1[0] * v1[0] + v1[1] * v1[1]) + (v1[2] * v1[2] + v1[3] * v1[3]));
                    *(u32x4*)(xb + off + bj * HALF) = pack8(v0, v1);
                }
                sq += xl::sxor<16>(sq); sq = xl::hsum(sq);
                if (fq == 0) ss[(size_t)row * 16 + u.pn * 4 + wc] = sq;
            }
        }
    }
};

struct EpiUp {
    static constexpr bool PERM = true, AFTER_DRAIN = false;
    bf16_t* hid; const float* ss;
    __device__ __forceinline__ void operator()(const f32x4 (&acc)[2][2][4][2], const Unit& u, int wr, int wc, int fr, int fq) const {
        const int row0 = u.pm * BM + wr * 64 + fr;
        float rsv[2][4];
#pragma unroll
        for (int ai = 0; ai < 2; ++ai)
#pragma unroll
            for (int m = 0; m < 4; ++m) rsv[ai][m] = rsqrtf(row_total16(ss, row0 + ai * HALF + m * 16, fq) * (1.0f / 1024.0f) + NORM_EPS);
#pragma unroll
        for (int ai = 0; ai < 2; ++ai)
#pragma unroll
            for (int m = 0; m < 4; ++m) {
                const int row = row0 + ai * HALF + m * 16;
                const float rs = rsv[ai][m];
#pragma unroll
                for (int bj = 0; bj < 2; ++bj) { const int ct = bj * HALF + wc * 32 + 8 * fq;
                    f32x4 v0 = acc[ai][bj][m][0] * rs, v1 = acc[ai][bj][m][1] * rs;
#pragma unroll
                    for (int e = 0; e < 4; ++e) { const float a = fmaxf(v0[e], 0.f), b = fmaxf(v1[e], 0.f); v0[e] = a * a; v1[e] = b * b; }
                    *(u32x4*)(hid + (size_t)row * 4096 + u.pn * 256 + ct) = pack8(v0, v1); }
            }
    }
};

struct ProjOrder {
    int nM, G, c;
    __device__ bool next(int i, Unit& u) const { const long L = (long)i * G + c; if (L >= 16L * nM) return false; const int n = (int)(L / (4 * nM)), r = (int)(L % (4 * nM)); u.pm = n * nM + (r >> 2); u.pn = n * 4 + (r & 3); return true; }
    __device__ __forceinline__ void a_ready(const Unit&) const {}
    __device__ __forceinline__ void done(const Unit&) const {}
};
struct GateOrder {
    StaticOrder so;
    __device__ bool next(int i, Unit& u) const { Unit p; if (!so.next(i >> 2, p)) return false; u.pm = p.pm; u.pn = 12 + 4 * (i & 3) + p.pn; return true; }
    __device__ __forceinline__ void a_ready(const Unit&) const {}
    __device__ __forceinline__ void done(const Unit&) const {}
};
}

namespace mk {
#define GAS __attribute__((address_space(1)))
#define LAS __attribute__((address_space(3)))
typedef unsigned short bf16;
typedef unsigned v4u __attribute__((ext_vector_type(4)));
typedef unsigned v2u __attribute__((ext_vector_type(2)));
typedef float f32x4 __attribute__((ext_vector_type(4)));
typedef float f32x16 __attribute__((ext_vector_type(16)));
typedef short bf16x8 __attribute__((ext_vector_type(8)));
typedef short s16x4 __attribute__((ext_vector_type(4)));
typedef GAS unsigned gu32;
#define RLX_AGENT __ATOMIC_RELAXED, __HIP_MEMORY_SCOPE_AGENT
#define LDS_WAIT() asm volatile("s_waitcnt lgkmcnt(0)" ::: "memory")
#define VM_WAIT() asm volatile("s_waitcnt vmcnt(0)" ::: "memory")

constexpr int NWAVES = 8, NTHR = 512;
constexpr int S = 8192, D = 1024, FF = 4096, NIN = 7112, DEPTH = 2;
constexpr int C_DQ = 0, C_DK = 256, C_DV = 512, C_IQ = 768, C_IK = 1024, C_IW = 1056, C_SQ = 1064, C_SK = 1320, C_SV = 1576,
              C_MQ = 1832, C_MK = 2088, C_MV = 2344, C_CQ = 2600, C_CKV = 2856, C_KR = 2984, C_GATE = 3016;
constexpr float LOG2E = 1.4426950408889634f, LN2 = 0.6931471805599453f;

constexpr size_t MiB = 1u << 20;
constexpr size_t WS_CTL = 0, CTL_ZERO_BYTES = 256 * 1024;
constexpr size_t WS_TP = 1 * MiB, WS_TI = WS_TP + 512 * 1024, WS_TM = 2 * MiB;
constexpr size_t WS_SSA = 3 * MiB, WS_SSB = 4 * MiB, WS_SSQ = 5 * MiB, WS_SSKV = WS_SSQ + 256 * 1024, WS_KMP = WS_SSKV + 256 * 1024;
constexpr size_t WS_WIN = 6 * MiB, WS_WMLA = 20 * MiB, WS_WB = 21 * MiB, WS_WOUT = 23 * MiB, WS_WUP = 25 * MiB, WS_WDOWN = 33 * MiB;
constexpr size_t WS_XB = 41 * MiB;
constexpr size_t WS_ZT = 73 * MiB;
constexpr size_t WS_MLAA = 153 * MiB, WS_MISC = 165 * MiB, WS_QM = 169 * MiB, WS_KN = 181 * MiB, WS_VM = 189 * MiB;
constexpr size_t WS_BITS = 197 * MiB;
constexpr size_t WS_O4 = 213 * MiB;
constexpr size_t WS_PROJ = 73 * MiB;
constexpr size_t WS_MERGED = 213 * MiB;
constexpr size_t WS_HID = 73 * MiB;
constexpr size_t WS_PART = 153 * MiB, WS_LSE = 250 * MiB;
constexpr size_t WS_MLIST = 245 * MiB;
constexpr size_t WS_DSA2 = 185 * MiB, WS_LSED = 251 * MiB;
constexpr size_t WS_END = 252 * MiB;
constexpr int CW_TMO = 0, CW_BAR = 4096, CW_QUEUE = 8192, CW_MCNT = 13312;

constexpr int RING_OFF = 0, RING_BYTES = 131072;
constexpr int LDSCTL_OFF = RING_BYTES, MISC_OFF = LDSCTL_OFF + 320;
constexpr int AUX_OFF = LDSCTL_OFF + 1024;
constexpr int LDS_BYTES = 147456;

__device__ __forceinline__ unsigned f2bf(float f) { unsigned u = __builtin_bit_cast(unsigned, f); return (u + 0x7fffu + ((u >> 16) & 1u)) >> 16; }
__device__ __forceinline__ unsigned pk2(float lo, float hi) { return f2bf(lo) | (f2bf(hi) << 16); }
__device__ __forceinline__ float bf2f(unsigned short b) { return __uint_as_float((unsigned)b << 16); }

#define XB_TMO      128
#define XB_XCNT(j)  (256  + 64 * (j))
#define XB_XSUB(j)  (1280 + 64 * (j))
#define XB_XGEN(j)  (2304 + 64 * (j))
#define XB_TOP      3328
#define XB_TOPGEN   3392
#define XCD_BAR_WORDS 3456
#define XB_SPIN_CAP (1u << 18)
__device__ __forceinline__ unsigned xb_ld(unsigned* p)              { return __hip_atomic_load(p, __ATOMIC_RELAXED, __HIP_MEMORY_SCOPE_AGENT); }
__device__ __forceinline__ unsigned xb_add(unsigned* p, unsigned v) { return __hip_atomic_fetch_add(p, v, __ATOMIC_RELAXED, __HIP_MEMORY_SCOPE_AGENT); }
__device__ __forceinline__ unsigned xb_xcc_id() { return (unsigned)__builtin_amdgcn_s_getreg((3 << 11) | 20) & 0xFu; }
#define XB_SPIN(cond, bar) do { unsigned _sp = 0; while (cond) { __builtin_amdgcn_s_sleep(1); \
    if ((++_sp & 255u) == 0u) { if (xb_ld(&(bar)[XB_TMO])) break; if (_sp > XB_SPIN_CAP) { atomicAdd(&(bar)[XB_TMO], 1u); break; } } } } while (0)
struct XcdBarrier { unsigned* bar; unsigned x; volatile LAS unsigned* st; };
__device__ __forceinline__ XcdBarrier xcd_barrier_post(unsigned* bar, volatile LAS unsigned* st, bool leader) {
    XcdBarrier b; b.bar = bar; b.x = xb_xcc_id(); b.st = st;
    if (leader) (void)xb_add(&bar[XB_XCNT(b.x)], 1u);
    return b;
}
__device__ __forceinline__ void xcd_barrier_complete(unsigned* bar, unsigned x, unsigned& nloc, unsigned& nx) {
    const unsigned G = gridDim.x * gridDim.y * gridDim.z;
    unsigned sum, cnt, mine, sp = 0u;
    for (;;) {
        sum = 0u; cnt = 0u; mine = 0u;
#pragma unroll
        for (unsigned j = 0; j < 16; ++j) { const unsigned c = xb_ld(&bar[XB_XCNT(j)]); sum += c; cnt += (c > 0u) ? 1u : 0u; mine = (j == x) ? c : mine; }
        if (sum == G) break;
        __builtin_amdgcn_s_sleep(1);
        if ((++sp & 255u) == 0u) { if (xb_ld(&bar[XB_TMO])) break; if (sp > XB_SPIN_CAP) { atomicAdd(&bar[XB_TMO], 1u); break; } }
    }
    nloc = mine > 0u ? mine : 1u; nx = cnt > 0u ? cnt : 1u;
}
__device__ __forceinline__ void xcd_barrier(const XcdBarrier& b, bool leader) {
    asm volatile("s_waitcnt vmcnt(0)" ::: "memory");
    __syncthreads();
    if (leader) {
        unsigned* bar = b.bar;
        __builtin_amdgcn_s_waitcnt(0);
        unsigned nloc = b.st[0], nx = b.st[1];
        if (nloc == 0u) { xcd_barrier_complete(bar, b.x, nloc, nx); b.st[0] = nloc; b.st[1] = nx; }
        const unsigned old = xb_add(&bar[XB_XSUB(b.x)], 1u);
        const unsigned gen = old / nloc;
        if (old + 1u == (gen + 1u) * nloc) {
            __builtin_amdgcn_fence(__ATOMIC_RELEASE, "agent");
            asm volatile("s_waitcnt vmcnt(0)" ::: "memory");
            const unsigned og = xb_add(&bar[XB_TOP], 1u);
            const unsigned tg = og / nx;
            if (og + 1u == (tg + 1u) * nx) xb_add(&bar[XB_TOPGEN], 1u);
            else XB_SPIN(xb_ld(&bar[XB_TOPGEN]) == tg, bar);
            __builtin_amdgcn_fence(__ATOMIC_ACQUIRE, "agent");
            xb_add(&bar[XB_XGEN(b.x)], 1u);
            asm volatile("s_waitcnt vmcnt(0)" ::: "memory");
        } else {
            XB_SPIN(xb_ld(&bar[XB_XGEN(b.x)]) == gen, bar);
            __builtin_amdgcn_fence(__ATOMIC_ACQUIRE, "agent");
            asm volatile("s_waitcnt vmcnt(0)" ::: "memory");
        }
    }
    __syncthreads();
}

struct Ptrs {
    const float* in[14]; float* out; unsigned char* ws;
    int ph_lo, ph_hi, li, mrows;
};

__device__ __forceinline__ int unperm(int p, int R) { return p < R ? ((p & 1) ? (p >> 1) + (R >> 1) : (p >> 1)) : p; }
__device__ __forceinline__ int win_src(int n) {
    if (n >= 3072) return C_GATE + (n - 3072);
    const int tile = n >> 8, p = n & 255;
    switch (tile) {
        case 0: return C_DQ + (p & ~63) + unperm(p & 63, 16);
        case 1: return C_DK + (p & ~63) + unperm(p & 63, 16);
        case 2: return C_DV + p;
        case 3: return C_IQ + (p & ~31) + unperm(p & 31, 8);
        case 4: return C_SQ + p;
        case 5: return C_SK + p;
        case 6: return C_SV + p;
        case 7: return C_MQ + (p & ~63) + unperm(p & 63, 16);
        case 8: return C_MK + (p & ~63) + unperm(p & 63, 16);
        case 9: return C_MV + p;
        case 10: return C_CQ + p;
        default:
            if (p < 128) return C_CKV + p;
            if (p < 160) return C_KR + unperm(p - 128, 32);
            if (p < 192) return C_IK + unperm(p - 160, 8);
            if (p < 200) return C_IW + (p - 192);
            return -1;
    }
}
__device__ __forceinline__ void conv_item(const float* W, int ldw, int srccol, int k0, const float* gsc, bf16* WT, int ldk, int kout0, int n0, LAS float* scr, int lane) {
#pragma unroll 8
    for (int i = 0; i < 32; ++i) { const int kk = 2 * i + (lane >> 5);
        float v = 0.f;
        if (srccol >= 0) { v = W[(size_t)(k0 + kk) * ldw + srccol]; if (gsc) v *= gsc[k0 + kk]; }
        scr[kk * 33 + (lane & 31)] = v; }
    LDS_WAIT(); asm volatile("" ::: "memory");
    const int c = lane & 7;
#pragma unroll
    for (int j = 0; j < 4; ++j) { const int n = (lane >> 3) + 8 * j; const LAS float* s = scr + (8 * c) * 33 + n;
        v4u o; o.x = pk2(s[0 * 33], s[1 * 33]); o.y = pk2(s[2 * 33], s[3 * 33]); o.z = pk2(s[4 * 33], s[5 * 33]); o.w = pk2(s[6 * 33], s[7 * 33]);
        *(GAS v4u*)(WT + (size_t)(n0 + n) * ldk + kout0 + 8 * c) = o; }
    LDS_WAIT(); asm volatile("" ::: "memory");
}
__device__ __forceinline__ void conv_item_wide(const float* W, int ldw, int src0, int k0, const float* gsc, bf16* WT, int ldk, int kout0, int n0, LAS float* scr, int lane) {
    const int rr = lane >> 4, c4 = (lane & 15) * 4;
    f32x4 v[16];
#pragma unroll
    for (int i = 0; i < 16; ++i) v[i] = *(const GAS f32x4*)(W + (size_t)(k0 + 4 * i + rr) * ldw + src0 + c4);
#pragma unroll
    for (int i = 0; i < 16; ++i) { f32x4 t = v[i]; if (gsc) t = t * gsc[k0 + 4 * i + rr]; const int row = 4 * i + rr; *(LAS f32x4*)(scr + row * 64 + (c4 ^ (8 * ((row >> 3) & 7)))) = t; }
    LDS_WAIT(); asm volatile("" ::: "memory");
    const int c = lane & 7;
#pragma unroll
    for (int j = 0; j < 8; ++j) { const int n = (lane >> 3) + 8 * j; const LAS float* s = scr + (8 * c) * 64 + (n ^ (8 * c));
        v4u o; o.x = pk2(s[0 * 64], s[1 * 64]); o.y = pk2(s[2 * 64], s[3 * 64]); o.z = pk2(s[4 * 64], s[5 * 64]); o.w = pk2(s[6 * 64], s[7 * 64]);
        *(GAS v4u*)(WT + (size_t)(n0 + n) * ldk + kout0 + 8 * c) = o; }
    LDS_WAIT(); asm volatile("" ::: "memory");
}
__device__ __forceinline__ float wave_sum(float v) {
    v += xl::sxor<1>(v); v += xl::sxor<2>(v); v += xl::sxor<4>(v); v += xl::sxor<8>(v); v += xl::sxor<16>(v); v = xl::hsum(v);
    return v;
}
__device__ __forceinline__ void p0_convert(const Ptrs& P, LAS unsigned char* lds, int gw, int NGW, int wave, int lane) {
    unsigned char* ws = P.ws;
    const int nlay = (P.li < 0) ? 1 : DEPTH;
    for (int l = 0; l < nlay; ++l) {
    unsigned char* wb = (l == 0) ? ws + WS_WIN : (unsigned char*)P.out;
    LAS float* scr = (LAS float*)(lds + RING_OFF + wave * 16384);
    const float* w_in = P.in[2] + (size_t)l * D * NIN; const float* norm_mix = P.in[1] + l * D;
    const float* qn = P.in[4] + l * 256; const float* kvn = P.in[5] + l * 128;
    const float* w_uq = P.in[6] + (size_t)l * 256 * 384; const float* w_ukv = P.in[7] + (size_t)l * 128 * 512;
    const float* w_br = P.in[8] + (size_t)l * 4 * 256 * D; const float* w_out = P.in[9] + (size_t)l * D * D;
    const float* norm_mlp = P.in[10] + l * D; const float* w_up = P.in[11] + (size_t)l * D * FF; const float* w_down = P.in[12] + (size_t)l * FF * D;
    bf16* Win = (bf16*)wb; bf16* Wmla = (bf16*)(wb + (WS_WMLA - WS_WIN)); bf16* Wb = (bf16*)(wb + (WS_WB - WS_WIN)); bf16* Wout = (bf16*)(wb + (WS_WOUT - WS_WIN)); bf16* Wup = (bf16*)(wb + (WS_WUP - WS_WIN)); bf16* Wdown = (bf16*)(wb + (WS_WDOWN - WS_WIN));
    constexpr int I_IN = (D / 64) * (3072 / 32), I_MLA = (384 / 64) * (1024 / 32);
    constexpr int J_G = (D / 64) * (4096 / 64), J_B = (256 / 64) * (4096 / 64), J_OUT = (D / 64) * (D / 64), J_UP = (D / 64) * (FF / 64), J_DOWN = (FF / 64) * (D / 64);
    constexpr int NITEMS = I_IN + I_MLA + J_G + J_B + J_OUT + J_UP + J_DOWN;
    for (int it = gw; it < NITEMS; it += NGW) {
        int r = it;
        if (r < I_IN) { const int nb_ = 3072 / 32, kb = r / nb_, nblk = r % nb_; conv_item(w_in, NIN, win_src(nblk * 32 + (lane & 31)), kb * 64, norm_mix, Win, D, kb * 64, nblk * 32, scr, lane); continue; } r -= I_IN;
        if (r < I_MLA) { const int nb_ = 1024 / 32, kb = r / nb_, nblk = r % nb_; const int n = nblk * 32 + (lane & 31);
            int sc = -1; const float* W = w_uq; int ldw = 384; const float* g = qn; int ks = kb * 64;
            if (kb < 4) { if (n < 256) sc = (n >> 6) * 96 + (n & 63); else if (n < 384) sc = ((n - 256) >> 5) * 96 + 64 + unperm((n - 256) & 31, 32); }
            else { W = w_ukv; ldw = 512; g = kvn; ks = kb * 64 - 256; if (n >= 512 && n < 768) sc = ((n - 512) >> 6) * 128 + ((n - 512) & 63); else if (n >= 768) sc = ((n - 768) >> 6) * 128 + 64 + ((n - 768) & 63); }
            conv_item(W, ldw, sc, ks, g, Wmla, 384, kb * 64, nblk * 32, scr, lane); continue; } r -= I_MLA;
        if (r < J_G) { const int nb_ = 4096 / 64, kb = r / nb_, nblk = r % nb_; conv_item_wide(w_in, NIN, C_GATE + nblk * 64, kb * 64, norm_mix, Win, D, kb * 64, 3072 + nblk * 64, scr, lane); continue; } r -= J_G;
        if (r < J_B) { const int nb_ = 4096 / 64, kb = r / nb_, nblk = r % nb_; const int n = nblk * 64;
            conv_item_wide(w_br + (size_t)(n >> 10) * 256 * D, D, n & 1023, kb * 64, nullptr, Wb, 256, kb * 64, n, scr, lane); continue; } r -= J_B;
        if (r < J_OUT) { const int nb_ = D / 64, kb = r / nb_, nblk = r % nb_; conv_item_wide(w_out, D, nblk * 64, kb * 64, nullptr, Wout, D, kb * 64, nblk * 64, scr, lane); continue; } r -= J_OUT;
        if (r < J_UP) { const int nb_ = FF / 64, kb = r / nb_, nblk = r % nb_; conv_item_wide(w_up, FF, nblk * 64, kb * 64, norm_mlp, Wup, D, kb * 64, nblk * 64, scr, lane); continue; } r -= J_UP;
        { const int nb_ = D / 64, kb = r / nb_, nblk = r % nb_; conv_item_wide(w_down, D, nblk * 64, kb * 64, nullptr, Wdown, FF, kb * 64, nblk * 64, scr, lane); }
    }
    }
    {
        const int M = P.mrows;
        const float* x = P.in[0]; bf16* xb = (bf16*)(ws + WS_XB); float* ssa = (float*)(ws + WS_SSA);
        for (int m = gw; m < M; m += NGW) {
            const GAS f32x4* xr = (const GAS f32x4*)(x + (size_t)m * D) + lane;
            f32x4 v[4]; float s = 0.f;
#pragma unroll
            for (int j = 0; j < 4; ++j) { v[j] = xr[64 * j]; s += (v[j].x * v[j].x + v[j].y * v[j].y) + (v[j].z * v[j].z + v[j].w * v[j].w); }
            s = wave_sum(s);
            GAS unsigned long long* o8 = (GAS unsigned long long*)(xb + (size_t)m * D) + lane;
#pragma unroll
            for (int j = 0; j < 4; ++j) o8[64 * j] = (unsigned long long)pk2(v[j].x, v[j].y) | ((unsigned long long)pk2(v[j].z, v[j].w) << 32);
            if (lane < 16) ssa[(size_t)m * 16 + lane] = (lane == 0) ? s : 0.f;
        }
        float* tp = (float*)(ws + WS_TP); float* ti = (float*)(ws + WS_TI); float* tm = (float*)(ws + WS_TM);
        const int gt = gw * 64 + lane, NGT = NGW * 64;
        for (int e = gt; e < S * 28; e += NGT) {
            const int t = e / 28, j = e % 28;
            int nrot, jj; float* dst; int nh;
            if (j < 8) { nrot = 16; jj = j; dst = tp + t * 16; nh = 8; } else if (j < 12) { nrot = 8; jj = j - 8; dst = ti + t * 8; nh = 4; } else { nrot = 32; jj = j - 12; dst = tm + t * 32; nh = 16; }
            const float inv_freq = 1.0f / powf(500000.0f, (float)(2 * jj) / (float)nrot);
            const float ang = (float)t * inv_freq;
            dst[jj] = cosf(ang); dst[nh + jj] = sinf(ang);
        }
    }
}

__device__ __forceinline__ int crow(int r, int hh) { return (r & 3) + 8 * (r >> 2) + 4 * hh; }
typedef float f32x2_t __attribute__((ext_vector_type(2))); typedef __bf16 bf16x2_t __attribute__((ext_vector_type(2)));
__device__ __forceinline__ unsigned cvtpk(float lo, float hi) { f32x2_t v = {lo, hi}; bf16x2_t b = __builtin_convertvector(v, bf16x2_t); return __builtin_bit_cast(unsigned, b); }
typedef short v4i16_t __attribute__((ext_vector_type(4)));
__device__ __forceinline__ s16x4 vtr(const LAS unsigned char* p) { return __builtin_bit_cast(s16x4, __builtin_amdgcn_ds_read_tr16_b64_v4i16((LAS v4i16_t*)p)); }
__device__ __forceinline__ float ex2(float x) { return __builtin_amdgcn_exp2f(x); }
__device__ __forceinline__ float lg2(float x) { return __builtin_amdgcn_logf(x); }
#define MFMA32(a, b, c) __builtin_amdgcn_mfma_f32_32x32x16_bf16((a), (b), (c), 0, 0, 0)

constexpr int VSTR = 144;
constexpr int KSTR64 = 144, KSTR96 = 208;
constexpr int AT_KBUF = 0, AT_VBUF = 2 * 64 * KSTR96, AT_END = AT_VBUF + 3 * 64 * VSTR;
constexpr int AT_KM = AT_END;
constexpr int AX_UNIT = 0, AX_FLAG = 1, AX_SBF = 8  , AX_SPRE = 32, AX_SREM = 64, AX_SCNT = 96, AX_THR = 128, AX_TB = 160, AX_TREM = 192;

struct MixCtx {
    const bf16* zt; size_t zts;
    const bf16* misc; const bf16* qm; const bf16* kn; const bf16* vm; const float* kmp;
    unsigned* bits; bf16* o4; size_t o4s;
    unsigned* diag;
    unsigned short* mlist; unsigned* mcnt; bf16* part; float* lse; bf16* dsa2; float* lsed;
};
struct TileRegs { v4u k, kx, v; };
template <bool MLA> __device__ __forceinline__ void tile_load(TileRegs& tr, const bf16* Kg, const bf16* Xg, const bf16* Vg, size_t rowbase, int key0, int hcol, int tid) {
    const int row = tid >> 3, ch = tid & 7;
    tr.k = *(const v4u*)(Kg + (rowbase + key0 + row) * 256 + hcol + ch * 8);
    tr.v = *(const v4u*)(Vg + (rowbase + key0 + row) * 256 + hcol + ch * 8);
    if (MLA) { if (tid < 256) { const int r2 = tid >> 2, c2 = tid & 3; tr.kx = *(const v4u*)(Xg + (rowbase + key0 + r2) * 128 + c2 * 8); } }
}
template <bool MLA, int KSTR> __device__ __forceinline__ void tile_store(const TileRegs& tr, LAS unsigned char* Kb, LAS unsigned char* Vb, int tid) {
    const int row = tid >> 3, ch = tid & 7;
    *(LAS v4u*)(Kb + row * KSTR + ch * 16) = tr.k;
    *(LAS v4u*)(Vb + row * VSTR + ch * 16) = tr.v;
    if (MLA) { if (tid < 256) { const int r2 = tid >> 2, c2 = tid & 3; *(LAS v4u*)(Kb + r2 * KSTR + 128 + c2 * 16) = tr.kx; } }
}
template <int NKS, int KSTR> __device__ __forceinline__ void qk_tile(f32x16& s0, f32x16& s1, const LAS unsigned char* Kb, const bf16x8 (&qf)[NKS], int lane, const f32x16 cinit = (f32x16){}) {
    const LAS unsigned char* kp = Kb + (lane & 31) * KSTR + (lane >> 5) * 16;
    s0 = cinit; s1 = cinit;
#pragma unroll
    for (int ks = 0; ks < NKS; ++ks) {
        const bf16x8 a0 = *(const LAS bf16x8*)(kp + ks * 32), a1 = *(const LAS bf16x8*)(kp + 32 * KSTR + ks * 32);
        s0 = MFMA32(a0, qf[ks], s0); s1 = MFMA32(a1, qf[ks], s1);
    }
}
__device__ __forceinline__ bf16x8 packp(const f32x16& p, int b) {
    v4u w; w.x = cvtpk(p[b], p[b + 1]); w.y = cvtpk(p[b + 2], p[b + 3]); w.z = cvtpk(p[b + 4], p[b + 5]); w.w = cvtpk(p[b + 6], p[b + 7]);
    return __builtin_bit_cast(bf16x8, w);
}
__device__ __forceinline__ void pv_tile(f32x16& o0, f32x16& o1, const LAS unsigned char* Vb, const f32x16& p0, const f32x16& p1, int lane) {
    bf16x8 pb[4]; pb[0] = packp(p0, 0); pb[1] = packp(p0, 8); pb[2] = packp(p1, 0); pb[3] = packp(p1, 8);
    const int i = lane & 15, G = lane >> 4, hh = G >> 1;
    const LAS unsigned char* vp = Vb + (4 * hh + (i >> 2)) * VSTR + (16 * (G & 1) + 4 * (i & 3)) * 2;
#pragma unroll
    for (int kb = 0; kb < 2; ++kb)
#pragma unroll
        for (int s = 0; s < 2; ++s) {
            const LAS unsigned char* vq = vp + (kb * 32 + 16 * s) * VSTR;
            const s16x4 l0 = vtr(vq), h0 = vtr(vq + 8 * VSTR), l1 = vtr(vq + 64), h1 = vtr(vq + 8 * VSTR + 64);
            const bf16x8 f0 = (bf16x8){l0[0], l0[1], l0[2], l0[3], h0[0], h0[1], h0[2], h0[3]};
            const bf16x8 f1 = (bf16x8){l1[0], l1[1], l1[2], l1[3], h1[0], h1[1], h1[2], h1[3]};
            o0 = MFMA32(f0, pb[kb * 2 + s], o0); o1 = MFMA32(f1, pb[kb * 2 + s], o1);
        }
}
typedef float f32x2s __attribute__((ext_vector_type(2)));
constexpr float SM_THR = 6.0f;
__device__ __forceinline__ void softmax_tile(f32x16& s0, f32x16& s1, float& mref, bool& mset, f32x16& negm, float& l, f32x16& o0, f32x16& o1) {
    float mx = fmaxf(fmaxf(s0[0], s0[1]), s1[0]);
#pragma unroll
    for (int r = 1; r < 16; ++r) { mx = fmaxf(mx, s0[r]); if (r > 1) mx = fmaxf(mx, s1[r - 1]); }
    mx = fmaxf(mx, s1[15]); mx = fmaxf(mx, s1[0]);
    mx = xl::hmax(mx);
    float dl; const bool was_set = mset;
    if (!mset) { dl = (mx > -INFINITY) ? mx : 0.f; mset = mx > -INFINITY; } else dl = (mx > SM_THR) ? mx : 0.f;
    if (__any(dl != 0.f)) {
        const float alpha = was_set ? ex2(-dl) : 1.0f;
#pragma unroll
        for (int r = 0; r < 16; ++r) { s0[r] -= dl; s1[r] -= dl; o0[r] *= alpha; o1[r] *= alpha; }
        l *= alpha; mref += dl;
#pragma unroll
        for (int r = 0; r < 16; ++r) negm[r] = -mref;
    }
    f32x2s ps = {0.f, 0.f};
#pragma unroll
    for (int r = 0; r < 16; r += 2) { s0[r] = ex2(s0[r]); s0[r + 1] = ex2(s0[r + 1]); s1[r] = ex2(s1[r]); s1[r + 1] = ex2(s1[r + 1]); ps += (f32x2s){s0[r], s0[r + 1]}; ps += (f32x2s){s1[r], s1[r + 1]}; }
    l += ps.x + ps.y;
}
__device__ __forceinline__ void store_ot(bf16* O, size_t row, int hcol, const f32x16& o0, const f32x16& o1, float inv, int hh) {
#pragma unroll
    for (int g = 0; g < 4; ++g) {
        v2u w0, w1;
        w0.x = cvtpk(o0[4 * g] * inv, o0[4 * g + 1] * inv); w0.y = cvtpk(o0[4 * g + 2] * inv, o0[4 * g + 3] * inv);
        w1.x = cvtpk(o1[4 * g] * inv, o1[4 * g + 1] * inv); w1.y = cvtpk(o1[4 * g + 2] * inv, o1[4 * g + 3] * inv);
        *(v2u*)(O + row * 256 + hcol + 8 * g + 4 * hh) = w0;
        *(v2u*)(O + row * 256 + hcol + 32 + 8 * g + 4 * hh) = w1;
    }
}

#ifndef MK_ATTDRY
#define MK_ATTDRY 0
#endif
template <int KIND> __device__ __forceinline__ void softmax_unit(const MixCtx& C, int b, int h, int qb, LAS unsigned char* lds, const int wave0, const int dry = 0, const int half = -1) {
    const int dm = dry ? MK_ATTDRY : 0;
    constexpr bool MLA = (KIND == 0);
    constexpr int NKS = MLA ? 6 : 4, KSTR = MLA ? KSTR96 : KSTR64;
    int tid_ = (wave0 << 6) | xl::fresh_lane(); asm volatile("" : "+v"(tid_));
    const int tid = tid_, lane = tid & 63, r32 = lane & 31, hh = lane >> 5, wave = __builtin_amdgcn_readfirstlane(tid >> 6);
    const size_t rowbase = (size_t)b * S; const int q0 = qb * 256, qw = q0 + 32 * wave, t = qw + r32; const int hcol = h * 64;
    const bf16* Kg = MLA ? C.kn : (KIND == 1 ? C.zt + 1 * C.zts : C.zt + 8 * C.zts);
    const bf16* Vg = MLA ? C.vm : (KIND == 1 ? C.zt + 2 * C.zts : C.zt + 9 * C.zts);
    LAS unsigned char* Kb0 = lds + RING_OFF + AT_KBUF; LAS unsigned char* Vb0 = lds + RING_OFF + AT_VBUF;
    bf16x8 qf[NKS];
    if (MLA) {
#pragma unroll
        for (int ks = 0; ks < NKS; ++ks) qf[ks] = *(const bf16x8*)(C.qm + (rowbase + t) * 384 + h * 96 + 16 * ks + 8 * hh);
    } else {
        const bf16* Qg = (KIND == 1) ? C.zt : C.zt + 7 * C.zts;
#pragma unroll
        for (int ks = 0; ks < NKS; ++ks) qf[ks] = *(const bf16x8*)(Qg + (rowbase + t) * 256 + hcol + 16 * ks + 8 * hh);
    }
    const int NTall = 4 * qb + 4;
    const int jlo = (half == 1) ? NTall / 2 : 0, NT = (half == 0) ? NTall / 2 : NTall;
    TileRegs tr;
    tile_load<MLA>(tr, Kg, C.misc, Vg, rowbase, 64 * jlo, hcol, tid);
    unsigned selmask = 0u;
    if (KIND == 2) {
        LAS float* km = (LAS float*)(lds + RING_OFF + AT_KM);
        for (int e = tid; e < 32 * 64; e += NTHR) { const int n = e >> 6, d = e & 63; const float* p = C.kmp + (size_t)((b * 32 + n) * 2) * 256 + hcol + d; km[e] = (p[0] + p[256]) * (1.0f / 256.0f); }
        __syncthreads();
        float qv[32];
#pragma unroll
        for (int ks = 0; ks < 4; ++ks)
#pragma unroll
            for (int j = 0; j < 8; ++j) qv[ks * 8 + j] = bf2f((unsigned short)qf[ks][j]);
        float g0 = -INFINITY, g1 = -INFINITY, g2 = -INFINITY; int i0 = -1, i1 = -1, i2 = -1;
        for (int n = 0; n < qb; ++n) {
            const LAS float* kp = km + n * 64 + 8 * hh;
            float dot = 0.f;
#pragma unroll
            for (int ks = 0; ks < 4; ++ks) { const f32x4 a = *(const LAS f32x4*)(kp + 16 * ks), c = *(const LAS f32x4*)(kp + 16 * ks + 4);
                dot += qv[ks * 8 + 0] * a[0] + qv[ks * 8 + 1] * a[1] + qv[ks * 8 + 2] * a[2] + qv[ks * 8 + 3] * a[3] + qv[ks * 8 + 4] * c[0] + qv[ks * 8 + 5] * c[1] + qv[ks * 8 + 6] * c[2] + qv[ks * 8 + 7] * c[3]; }
            dot = xl::hsum(dot);
            if (dot > g0) { g2 = g1; i2 = i1; g1 = g0; i1 = i0; g0 = dot; i0 = n; }
            else if (dot > g1) { g2 = g1; i2 = i1; g1 = dot; i1 = n; }
            else if (dot > g2) { g2 = dot; i2 = n; }
        }
        if (i0 >= 0) selmask |= 1u << i0; if (i1 >= 0) selmask |= 1u << i1; if (i2 >= 0) selmask |= 1u << i2;
    }
    tile_store<MLA, KSTR>(tr, Kb0, Vb0, tid);
    __syncthreads();
    f32x16 o0 = {}, o1 = {}, negm = {}; float mref = 0.f, l = 0.f; bool mset = false;
    v2u wv_next = (v2u){0u, 0u};
    if (KIND == 1) wv_next = *(const v2u*)(C.bits + (rowbase + t) * 256 + 2 * jlo);
    const bool late = false;
    f32x16 c0 = {}, c1 = {}; bool cact = false;
    auto do_qk = [&](int j, const v2u wv, f32x16& s0, f32x16& s1) {
        qk_tile<NKS, KSTR>(s0, s1, Kb0 + ((j - jlo) & 1) * 64 * KSTR, qf, lane, negm);
        if (KIND == 1) {
            const unsigned w0 = wv.x >> (4 * hh), w1 = wv.y >> (4 * hh);
#pragma unroll
            for (int r = 0; r < 16; ++r) { const unsigned pos = (unsigned)((r & 3) + 8 * (r >> 2));
                const unsigned m0 = (unsigned)__builtin_amdgcn_sbfe((int)w0, pos, 1u), m1 = (unsigned)__builtin_amdgcn_sbfe((int)w1, pos, 1u);
                s0[r] = __uint_as_float((m0 & __float_as_uint(s0[r])) | (~m0 & 0xff800000u)); s1[r] = __uint_as_float((m1 & __float_as_uint(s1[r])) | (~m1 & 0xff800000u)); }
        } else {
            const bool past_blk = (KIND == 2) && ((j >> 2) < qb);
            if (past_blk) { if (!((selmask >> (j >> 2)) & 1u)) { s0 = s0 - INFINITY; s1 = s1 - INFINITY; } }
            else if (64 * j + 63 > qw) {
#pragma unroll
                for (int r = 0; r < 16; ++r) { const int kk = 64 * j + crow(r, hh); if (kk > t) s0[r] = -INFINITY; if (kk + 32 > t) s1[r] = -INFINITY; }
            }
        }
    };
    int vprev = 2 * 64 * VSTR, vcur = 0, vnext = 64 * VSTR;
    for (int j = jlo; j < NT; ++j) {
        if (j + 1 < NT && !(dm & 16)) tile_load<MLA>(tr, Kg, C.misc, Vg, rowbase, 64 * (j + 1), hcol, tid);
        v2u wv = wv_next;
        bool act = 64 * j <= qw + 31;
        if (KIND == 1) { if (64 * (j + 1) <= qw + 31) wv_next = *(const v2u*)(C.bits + (rowbase + t) * 256 + 2 * (j + 1));
                         if (act) act = __any((wv.x | wv.y) != 0u); }
        if (KIND == 2) { const int n = j >> 2; if (n < qb) act = __any((selmask >> n) & 1u); }
        if (!late) {
            if (act) { f32x16 s0, s1; if (dm & 8) { s0 = negm; s1 = negm; } else do_qk(j, wv, s0, s1); if (!(dm & 2)) softmax_tile(s0, s1, mref, mset, negm, l, o0, o1); if (!(dm & 4)) pv_tile(o0, o1, Vb0 + vcur, s0, s1, lane); else { o0 += s0; o1 += s1; } }
        } else {
            if (cact) { softmax_tile(c0, c1, mref, mset, negm, l, o0, o1); pv_tile(o0, o1, Vb0 + vprev, c0, c1, lane); }
            cact = act;
            if (act) do_qk(j, wv, c0, c1);
        }
        if (j + 1 < NT && !(dm & 16)) tile_store<MLA, KSTR>(tr, Kb0 + ((j + 1 - jlo) & 1) * 64 * KSTR, Vb0 + vnext, tid);
        __syncthreads();
        { const int tmp = vprev; vprev = vcur; vcur = vnext; vnext = tmp; }
    }
    if (late && cact) { softmax_tile(c0, c1, mref, mset, negm, l, o0, o1); pv_tile(o0, o1, Vb0 + vprev, c0, c1, lane); }
    __syncthreads();
    l = xl::hsum(l);
    const int branch = MLA ? 3 : (KIND == 1 ? 0 : 2);
    if (KIND == 1 && half >= 0) {
        const float inv = (l > 0.f) ? 1.0f / l : 0.f;
        store_ot(half == 0 ? C.o4 : C.dsa2, rowbase + t, hcol, o0, o1, inv, hh);
        if (hh == 0) C.lsed[((rowbase + t) * 4 + h) * 2 + half] = (l > 0.f) ? mref + lg2(l) : -INFINITY;
    } else
    if (!(dm & 1)) store_ot(C.o4 + branch * C.o4s, rowbase + t, hcol, o0, o1, 1.0f / l, hh);
    else { float x = l; for (int r = 0; r < 16; ++r) x += o0[r] + o1[r]; asm volatile("" :: "v"(x)); }
}

__device__ __forceinline__ float sb_block(f32x16& z, int kbase, int t, int hh, float cin) {
    float lf[16];
#pragma unroll
    for (int r = 0; r < 16; ++r) {
        const float zz = z[r]; const float e = ex2(-fabsf(zz) * LOG2E);
        const float sp = fmaxf(zz, 0.f) + lg2(1.0f + e) * LN2;
        lf[r] = (kbase + crow(r, hh) < t) ? -sp : 0.f;
    }
    float gs[4], pg[4];
#pragma unroll
    for (int g = 0; g < 4; ++g) { gs[g] = (lf[4 * g] + lf[4 * g + 1]) + (lf[4 * g + 2] + lf[4 * g + 3]); float lo_, hi_; xl::halves(gs[g], lo_, hi_); pg[g] = hh ? lo_ : hi_; }
    float run = 0.f;
#pragma unroll
    for (int g = 3; g >= 0; --g) {
        const float base = cin + run + (hh == 0 ? pg[g] : 0.f);
        const float l3 = base, l2 = l3 + lf[4 * g + 3], l1 = l2 + lf[4 * g + 2], l0 = l1 + lf[4 * g + 1];
        const float la[4] = {l0, l1, l2, l3};
#pragma unroll
        for (int e = 0; e < 4; ++e) { const int r = 4 * g + e; const bool past = kbase + crow(r, hh) < t; z[r] = past ? ex2((z[r] + lf[r] + la[e]) * LOG2E) : 0.f; }
        run += gs[g] + pg[g];
    }
    return run;
}
__device__ __forceinline__ void sb_unit(const MixCtx& C, int b, int h, int qb, LAS unsigned char* lds, const int wave0) {
    int tid_ = (wave0 << 6) | xl::fresh_lane(); asm volatile("" : "+v"(tid_));
    const int tid = tid_, lane = tid & 63, r32 = lane & 31, hh = lane >> 5, wave = __builtin_amdgcn_readfirstlane(tid >> 6);
    const size_t rowbase = (size_t)b * S; const int q0 = qb * 256, qw = q0 + 32 * wave, t = qw + r32; const int hcol = h * 64;
    const bf16* Qg = C.zt + 4 * C.zts; const bf16* Kg = C.zt + 5 * C.zts; const bf16* Vg = C.zt + 6 * C.zts;
    LAS unsigned char* Kb0 = lds + RING_OFF + AT_KBUF; LAS unsigned char* Vb0 = lds + RING_OFF + AT_VBUF;
    volatile LAS unsigned* aux = (volatile LAS unsigned*)(lds + AUX_OFF);
    bf16x8 qf[4];
#pragma unroll
    for (int ks = 0; ks < 4; ++ks) qf[ks] = *(const bf16x8*)(Qg + (rowbase + t) * 256 + hcol + 16 * ks + 8 * hh);
    const int NT = 4 * qb + 4;
    TileRegs tr;
    tile_load<false>(tr, Kg, nullptr, Vg, rowbase, 64 * (NT - 1), hcol, tid);
    tile_store<false, KSTR64>(tr, Kb0, Vb0, tid);
    __syncthreads();
    f32x16 o0 = {}, o1 = {}; float carry = 0.f;
    for (int it = 0; it < NT; ++it) {
        const int j = NT - 1 - it, cur = it & 1;
        if (j > 0) tile_load<false>(tr, Kg, nullptr, Vg, rowbase, 64 * (j - 1), hcol, tid);
        if (64 * j < qw + 31) {
            f32x16 s0, s1;
            qk_tile<4, KSTR64>(s0, s1, Kb0 + cur * 64 * KSTR64, qf, lane);
            const float b1 = sb_block(s1, 64 * j + 32, t, hh, carry);
            const float b0 = sb_block(s0, 64 * j, t, hh, carry + b1);
            carry += b1 + b0;
            pv_tile(o0, o1, Vb0 + cur * 64 * VSTR, s0, s1, lane);
        }
        const bool wdone = __all(carry < -110.0f);
        if (lane == 0) aux[AX_SBF + cur * 8 + wave] = wdone ? 1u : 0u;
        if (j > 0) tile_store<false, KSTR64>(tr, Kb0 + (cur ^ 1) * 64 * KSTR64, Vb0 + (cur ^ 1) * 64 * VSTR, tid);
        __syncthreads();
        unsigned alld = 1u;
#pragma unroll
        for (int w = 0; w < 8; ++w) alld &= aux[AX_SBF + cur * 8 + w];
        if (alld) break;
    }
    __syncthreads();
    store_ot(C.o4 + 1 * C.o4s, rowbase + t, hcol, o0, o1, 1.0f, hh);
}

__device__ __forceinline__ unsigned fkey(float f) { const int u = (int)__float_as_uint(f + 0.0f); return (unsigned)u ^ ((unsigned)(u >> 31) | 0x80000000u); }
__device__ __forceinline__ void idx_keys(unsigned (&key)[16], const bf16* misc, size_t rowbase, int kb, const bf16x8 (&qf)[16], const float (&w)[8], int r32, int hh) {
    const bf16* kr = misc + (rowbase + kb * 32 + r32) * 128 + 32 + 8 * hh;
    const bf16x8 k0 = *(const bf16x8*)kr, k1 = *(const bf16x8*)(kr + 16);
    float sc[16];
#pragma unroll
    for (int hd = 0; hd < 8; ++hd) {
        f32x16 s = MFMA32(k0, qf[2 * hd], (f32x16){});
        s = MFMA32(k1, qf[2 * hd + 1], s);
#pragma unroll
        for (int r = 0; r < 16; ++r) { const float v = fmaxf(s[r], 0.f); sc[r] = (hd == 0) ? w[0] * v : __builtin_fmaf(w[hd], v, sc[r]); }
        if (hd & 1) {
#pragma unroll
            for (int r = 0; r < 16; ++r) asm volatile("" : "+v"(sc[r]));
            __builtin_amdgcn_sched_barrier(0);
        }
    }
#pragma unroll
    for (int r = 0; r < 16; ++r) key[r] = fkey(sc[r]);
}
template <bool DESC, bool PEEK = false, bool RAW = false> __device__ __forceinline__ void hist_scan(volatile LAS unsigned* hist, int rowstride, int nbins, bool swz, int preshift, volatile LAS unsigned* aux, int tid) {
    const int q = tid >> 4, c = tid & 15, lane = tid & 63, wpc = nbins >> 5, sx = swz ? q : 0;
    unsigned csum = 0u;
    for (int i = 0; i < wpc; ++i) { const unsigned w = hist[q * rowstride + ((c * wpc + ((i + c) & (wpc - 1))) ^ sx)]; csum += (w & 0xffffu) + (w >> 16); }
    unsigned other = 0u;
#pragma unroll
    for (int k = 0; k < 16; ++k) { unsigned v; switch (k) { case 0: v = xl::bcast16<0>(csum); break; case 1: v = xl::bcast16<1>(csum); break; case 2: v = xl::bcast16<2>(csum); break; case 3: v = xl::bcast16<3>(csum); break; case 4: v = xl::bcast16<4>(csum); break; case 5: v = xl::bcast16<5>(csum); break; case 6: v = xl::bcast16<6>(csum); break; case 7: v = xl::bcast16<7>(csum); break; case 8: v = xl::bcast16<8>(csum); break; case 9: v = xl::bcast16<9>(csum); break; case 10: v = xl::bcast16<10>(csum); break; case 11: v = xl::bcast16<11>(csum); break; case 12: v = xl::bcast16<12>(csum); break; case 13: v = xl::bcast16<13>(csum); break; case 14: v = xl::bcast16<14>(csum); break; default: v = xl::bcast16<15>(csum); break; }
        if (RAW ? (c < 8 ? (k > c && k < 8) : (k < c)) : (DESC ? (k > c) : (k < c))) other += v; }
    const unsigned rem = aux[AX_SREM + q];
    if (other < rem && other + csum >= rem) {
        unsigned cum = other; bool found = false; unsigned bin = 0u, cnt = 0u;
        const bool dsc = RAW ? (c < 8) : DESC;
        for (int ii = 0; ii < wpc; ++ii) {
            const int i = dsc ? (wpc - 1 - ii) : ii;
            const unsigned w = hist[q * rowstride + ((c * wpc + i) ^ sx)];
            const unsigned first = dsc ? (w >> 16) : (w & 0xffffu), second = dsc ? (w & 0xffffu) : (w >> 16);
            if (!found) { if (cum + first >= rem) { found = true; bin = 2u * (unsigned)(c * wpc + i) + (dsc ? 1u : 0u); cnt = first; } else cum += first; }
            if (!found) { if (cum + second >= rem) { found = true; bin = 2u * (unsigned)(c * wpc + i) + (dsc ? 0u : 1u); cnt = second; } else cum += second; }
        }
        if (PEEK) { aux[AX_TB + q] = bin; }
        else {
        aux[AX_SPRE + q] = (aux[AX_SPRE + q] << preshift) | bin;
        aux[AX_SREM + q] = rem - cum; aux[AX_SCNT + q] = cnt;
        if (!DESC) { aux[AX_TB + q] = bin; aux[AX_TREM + q] = rem - cum; }
        }
    }
}
__device__ __forceinline__ void hist_zero(LAS unsigned char* lds, int tid) {
    LAS v4u* h4 = (LAS v4u*)(lds + RING_OFF);
    for (int i = tid; i < 8192; i += NTHR) h4[i] = (v4u){0u, 0u, 0u, 0u};
}
__device__ __forceinline__ void sel_unit_slow(const MixCtx& C, int b, int qg, LAS unsigned char* lds, const int wave0) {
    int tid_ = (wave0 << 6) | xl::fresh_lane(); asm volatile("" : "+v"(tid_));
    const int tid = tid_, lane = tid & 63, r32 = lane & 31, hh = lane >> 5, wave = __builtin_amdgcn_readfirstlane(tid >> 6);
    const size_t rowbase = (size_t)b * S; const int t = 32 * qg + r32;
    volatile LAS unsigned* hist = (volatile LAS unsigned*)(lds + RING_OFF);
    LAS unsigned* histw = (LAS unsigned*)(lds + RING_OFF);
    volatile LAS unsigned* aux = (volatile LAS unsigned*)(lds + AUX_OFF);
    bf16x8 qf[16]; float w[8];
    { const bf16* qp = C.zt + 3 * C.zts + (rowbase + t) * 256 + 8 * hh;
#pragma unroll
      for (int i = 0; i < 16; ++i) qf[i] = *(const bf16x8*)(qp + 16 * i);
      const v4u wr = *(const v4u*)(C.misc + (rowbase + t) * 128 + 64);
      w[0] = __uint_as_float(wr.x << 16); w[1] = __uint_as_float(wr.x & 0xffff0000u); w[2] = __uint_as_float(wr.y << 16); w[3] = __uint_as_float(wr.y & 0xffff0000u);
      w[4] = __uint_as_float(wr.z << 16); w[5] = __uint_as_float(wr.z & 0xffff0000u); w[6] = __uint_as_float(wr.w << 16); w[7] = __uint_as_float(wr.w & 0xffff0000u); }
    const int kb_last = 8 * (qg >> 3) + 7;
    if (tid < 32) { aux[AX_SPRE + tid] = 0u; aux[AX_SREM + tid] = 256u; aux[AX_SCNT + tid] = 0u; aux[AX_THR + tid] = 0u; aux[AX_TB + tid] = 0x7fffffffu; aux[AX_TREM + tid] = 0u; }
    if (tid == 0) aux[AX_FLAG] = 0u;
    if (qg >= 8) {
        for (int pass = 0; pass < 3; ++pass) {
            hist_zero(lds, tid);
            __syncthreads();
            const unsigned pre = aux[AX_SPRE + r32];
            for (int kb = wave; kb <= qg; kb += 8) {
                unsigned key[16];
                idx_keys(key, C.misc, rowbase, kb, qf, w, r32, hh);
#pragma unroll
                for (int r = 0; r < 16; ++r) {
                    const bool valid = kb * 32 + crow(r, hh) <= t;
                    const unsigned k = key[r];
                    bool match; unsigned bin;
                    if (pass == 0) { match = true; bin = k >> 21; } else if (pass == 1) { match = (k >> 21) == pre; bin = (k >> 10) & 2047u; } else { match = (k >> 10) == pre; bin = k & 1023u; }
                    if (valid && match) __hip_atomic_fetch_add(histw + r32 * 1024 + ((bin >> 1) ^ (unsigned)r32), 1u << (16 * (bin & 1u)), __ATOMIC_RELAXED, __HIP_MEMORY_SCOPE_WORKGROUP);
                }
            }
            __syncthreads();
            hist_scan<true>(hist, 1024, pass == 2 ? 1024 : 2048, true, pass == 2 ? 10 : 11, aux, tid);
            __syncthreads();
        }
        if (tid < 32) { aux[AX_THR + tid] = aux[AX_SPRE + tid]; if (aux[AX_SREM + tid] < aux[AX_SCNT + tid]) aux[AX_FLAG] = 1u; }
        __syncthreads();
        if (aux[AX_FLAG] != 0u) {
            hist_zero(lds, tid);
            __syncthreads();
            const unsigned thr = aux[AX_THR + r32];
            for (int kb = wave; kb <= qg; kb += 8) {
                unsigned key[16];
                idx_keys(key, C.misc, rowbase, kb, qf, w, r32, hh);
#pragma unroll
                for (int r = 0; r < 16; ++r) {
                    const int s = kb * 32 + crow(r, hh);
                    if (s <= t && key[r] == thr) { const unsigned bin = (unsigned)s >> 2; __hip_atomic_fetch_add(histw + r32 * 1024 + ((bin >> 1) ^ (unsigned)r32), 1u << (16 * (bin & 1u)), __ATOMIC_RELAXED, __HIP_MEMORY_SCOPE_WORKGROUP); }
                }
            }
            __syncthreads();
            hist_scan<false>(hist, 1024, 2048, true, 11, aux, tid);
            __syncthreads();
        }
    }
    __syncthreads();
    {
        const unsigned thr = aux[AX_THR + r32]; const unsigned tb = aux[AX_TB + r32], trem = aux[AX_TREM + r32];
        for (int kb = wave; kb <= kb_last; kb += 8) {
            unsigned word = 0u;
            if (kb <= qg) {
                unsigned key[16];
                idx_keys(key, C.misc, rowbase, kb, qf, w, r32, hh);
#pragma unroll
                for (int g = 0; g < 4; ++g) {
                    unsigned rank = 0u; const unsigned s4 = (unsigned)(kb * 8 + 2 * g + hh);
#pragma unroll
                    for (int e = 0; e < 4; ++e) {
                        const int r = 4 * g + e; const int s = kb * 32 + crow(r, hh);
                        const bool valid = s <= t; const unsigned k = key[r];
                        bool sel = valid && (k > thr);
                        if (valid && k == thr) { ++rank; sel = (s4 < tb) || (s4 == tb && rank <= trem); }
                        word |= (sel ? 1u : 0u) << crow(r, hh);
                    }
                }
            }
            word = xl::hor(word);
            if (hh == 0) C.bits[(rowbase + t) * 256 + kb] = word;
        }
    }
    __syncthreads();
}

constexpr int SL_CKEY = 0, SL_CIDX = 65536, SL_BITW = 98304;
constexpr int SL_SHIST = AUX_OFF + 2048;
constexpr int AX_CCNT = 224;
constexpr int SL_SAMP = SL_SHIST + 8192;
constexpr int SEL_RANK_MAX = 64;
__device__ __forceinline__ void idx_load(bf16x8& k0, bf16x8& k1, const bf16* misc, size_t rowbase, int kb, int r32, int hh) {
    const bf16* kr = misc + (rowbase + kb * 32 + r32) * 128 + 32 + 8 * hh; k0 = *(const bf16x8*)kr; k1 = *(const bf16x8*)(kr + 16);
}
typedef float f32x2v __attribute__((ext_vector_type(2)));
__device__ __forceinline__ float relu1(float x) { const int b = __float_as_int(x); return __int_as_float(b > 0 ? b : 0); }
__device__ __forceinline__ void idx_keys2(unsigned (&key)[16], const bf16x8 k0, const bf16x8 k1, const bf16x8 (&qf)[16], const float (&w)[8]) {
    f32x2v sc[8];
#pragma unroll
    for (int hd = 0; hd < 8; ++hd) {
        f32x16 s = MFMA32(k0, qf[2 * hd], (f32x16){});
        s = MFMA32(k1, qf[2 * hd + 1], s);
        const f32x2v w2 = {w[hd], w[hd]};
#pragma unroll
        for (int j = 0; j < 8; ++j) { const f32x2v v = {relu1(s[2 * j]), relu1(s[2 * j + 1])}; sc[j] = (hd == 0) ? v * w2 : __builtin_elementwise_fma(v, w2, sc[j]); }
        if (hd & 1) {
#pragma unroll
            for (int j = 0; j < 8; ++j) asm volatile("" : "+v"(sc[j]));
            __builtin_amdgcn_sched_barrier(0);
        }
    }
#pragma unroll
    for (int j = 0; j < 8; ++j) { key[2 * j] = fkey(sc[j].x); key[2 * j + 1] = fkey(sc[j].y); }
}
__device__ __forceinline__ void idx_keys3(unsigned (&key)[16], const bf16x8 k0, const bf16x8 k1, const bf16x8 (&qf)[16], const float (&w2)[8], const bf16x8 ql0, const bf16x8 ql1) {
    float sc[16];
    { f32x16 lin = MFMA32(k0, ql0, (f32x16){}); lin = MFMA32(k1, ql1, lin);
#pragma unroll
      for (int r = 0; r < 16; ++r) sc[r] = lin[r]; }
#pragma unroll
    for (int hd = 0; hd < 8; ++hd) {
        f32x16 s = MFMA32(k0, qf[2 * hd], (f32x16){});
        s = MFMA32(k1, qf[2 * hd + 1], s);
#pragma unroll
        for (int r = 0; r < 16; ++r) sc[r] = __builtin_fmaf(__builtin_fabsf(s[r]), w2[hd], sc[r]);
        if (hd & 1) {
#pragma unroll
            for (int r = 0; r < 16; ++r) asm volatile("" : "+v"(sc[r]));
            __builtin_amdgcn_sched_barrier(0);
        }
    }
#pragma unroll
    for (int r = 0; r < 16; ++r) key[r] = __float_as_uint(sc[r]);
}
#ifndef MK_SELDRY
#define MK_SELDRY 0
#endif
__device__ __forceinline__ void sel_unit(const MixCtx& C, int b, int qg, LAS unsigned char* lds, const int wave0, const int dry = 0) {
    const int dm = dry ? MK_SELDRY : 0;
    int tid_ = (wave0 << 6) | xl::fresh_lane(); asm volatile("" : "+v"(tid_));
    const int tid = tid_, lane = tid & 63, r32 = lane & 31, hh = lane >> 5, wave = __builtin_amdgcn_readfirstlane(tid >> 6);
    const size_t rowbase = (size_t)b * S; const int t = 32 * qg + r32;
    const int kb_last = 8 * (qg >> 3) + 7;
    LAS unsigned* histw = (LAS unsigned*)(lds + RING_OFF);
    volatile LAS unsigned* hist = (volatile LAS unsigned*)(lds + RING_OFF);
    volatile LAS unsigned* aux = (volatile LAS unsigned*)(lds + AUX_OFF);
    LAS unsigned* ckey = (LAS unsigned*)(lds + RING_OFF + SL_CKEY); LAS unsigned short* cidx = (LAS unsigned short*)(lds + RING_OFF + SL_CIDX);
    LAS unsigned* bitw = (LAS unsigned*)(lds + RING_OFF + SL_BITW); LAS unsigned* shist = (LAS unsigned*)(lds + SL_SHIST);
    LAS unsigned* auxw = (LAS unsigned*)(lds + AUX_OFF);
    if (qg < 8) {
        { const int q = tid >> 4, tq = 32 * qg + q;
          for (int kb = tid & 15; kb <= kb_last; kb += 16) { const int nbit = tq + 1 - 32 * kb; const unsigned word = nbit <= 0 ? 0u : (nbit >= 32 ? 0xffffffffu : ((1u << nbit) - 1u));
            if (!(dm & 1)) C.bits[(rowbase + tq) * 256 + kb] = word; } }
        return;
    }
    bf16x8 qf[16]; float w[8];
    { const bf16* qp = C.zt + 3 * C.zts + (rowbase + t) * 256 + 8 * hh;
#pragma unroll
      for (int i = 0; i < 16; ++i) qf[i] = *(const bf16x8*)(qp + 16 * i);
      const v4u wr = *(const v4u*)(C.misc + (rowbase + t) * 128 + 64);
      w[0] = __uint_as_float(wr.x << 16); w[1] = __uint_as_float(wr.x & 0xffff0000u); w[2] = __uint_as_float(wr.y << 16); w[3] = __uint_as_float(wr.y & 0xffff0000u);
      w[4] = __uint_as_float(wr.z << 16); w[5] = __uint_as_float(wr.z & 0xffff0000u); w[6] = __uint_as_float(wr.w << 16); w[7] = __uint_as_float(wr.w & 0xffff0000u); }
    float w2[8]; bf16x8 ql0, ql1;
    {
#pragma unroll
        for (int hd = 0; hd < 8; ++hd) w2[hd] = 0.5f * w[hd];
        float a0[8], a1[8];
#pragma unroll
        for (int j = 0; j < 8; ++j) { a0[j] = 0.f; a1[j] = 0.f; }
#pragma unroll
        for (int hd = 0; hd < 8; ++hd)
#pragma unroll
            for (int j = 0; j < 8; ++j) { a0[j] = __builtin_fmaf(w2[hd], bf2f((unsigned short)qf[2 * hd][j]), a0[j]); a1[j] = __builtin_fmaf(w2[hd], bf2f((unsigned short)qf[2 * hd + 1][j]), a1[j]); }
        v4u p0, p1; p0.x = cvtpk(a0[0], a0[1]); p0.y = cvtpk(a0[2], a0[3]); p0.z = cvtpk(a0[4], a0[5]); p0.w = cvtpk(a0[6], a0[7]);
        p1.x = cvtpk(a1[0], a1[1]); p1.y = cvtpk(a1[2], a1[3]); p1.z = cvtpk(a1[4], a1[5]); p1.w = cvtpk(a1[6], a1[7]);
        ql0 = __builtin_bit_cast(bf16x8, p0); ql1 = __builtin_bit_cast(bf16x8, p1);
    }
    if (tid < 32) { aux[AX_SPRE + tid] = 0u; aux[AX_SREM + tid] = 256u; aux[AX_SCNT + tid] = 0u; aux[AX_CCNT + tid] = 0u; aux[AX_TB + tid] = 0u; }
    if (tid == 0) aux[AX_FLAG] = 0u;
    hist_zero(lds, tid);
    {
        LAS float* samp = (LAS float*)(lds + SL_SAMP);
        bf16x8 k0, k1; idx_load(k0, k1, C.misc, rowbase, (wave * qg) >> 3, r32, hh);
        unsigned key[16]; idx_keys3(key, k0, k1, qf, w2, ql0, ql1);
        float mx = __uint_as_float(key[0]), mn = mx;
#pragma unroll
        for (int r = 1; r < 16; ++r) { const float v = __uint_as_float(key[r]); mx = fmaxf(mx, v); mn = fminf(mn, v); }
        mx = xl::hmax(mx); mn = -xl::hmax(-mn);
        if (hh == 0) { samp[wave * 32 + r32] = mx; samp[256 + wave * 32 + r32] = mn; }
    }
    __syncthreads();
    float scale, off;
    { const LAS float* samp = (const LAS float*)(lds + SL_SAMP);
      float hi = samp[r32], lo = samp[256 + r32];
#pragma unroll
      for (int wv = 1; wv < 8; ++wv) { hi = fmaxf(hi, samp[wv * 32 + r32]); lo = fminf(lo, samp[256 + wv * 32 + r32]); }
      const float range = hi - lo; const bool ok = range > 1e-30f && range < 1e30f;
      scale = ok ? 2047.0f / (1.28f * range) : 0.f; off = ok ? (0.03f * range - lo) * scale : 0.f; }
    {
        bf16x8 k0, k1, n0 = {}, n1 = {};
        int kb = wave;
        LAS unsigned* hrow = histw + r32 * 1024;
        if (kb <= qg) idx_load(k0, k1, C.misc, rowbase, kb, r32, hh);
        for (; kb <= qg && !(dm & 16); kb += 8) {
            if (kb + 8 <= qg) idx_load(n0, n1, C.misc, rowbase, kb + 8, r32, hh);
            unsigned key[16];
            idx_keys3(key, k0, k1, qf, w2, ql0, ql1);
            if (dm & 2) { unsigned x = 0u;
#pragma unroll
                for (int r = 0; r < 16; ++r) x ^= key[r];
                asm volatile("" :: "v"(x)); }
            else if (dm & 32) {
#pragma unroll
                for (int r = 0; r < 16; ++r) { const unsigned bin = key[r] >> 21; hrow[(bin >> 1) ^ (unsigned)r32] = 1u << (16 * (bin & 1u)); }
            }
            else if (kb < qg) {
#pragma unroll
                for (int r = 0; r < 16; ++r) { const unsigned bin = (unsigned)__builtin_amdgcn_fmed3f(__builtin_fmaf(__uint_as_float(key[r]), scale, off), 0.f, 2047.f); __hip_atomic_fetch_add(hrow + ((bin >> 1) ^ (unsigned)r32), (bin & 1u) * 0xffffu + 1u, __ATOMIC_RELAXED, __HIP_MEMORY_SCOPE_WORKGROUP); }
            } else {
#pragma unroll
                for (int r = 0; r < 16; ++r) {
                    if (crow(r, hh) <= r32) { const unsigned bin = (unsigned)__builtin_amdgcn_fmed3f(__builtin_fmaf(__uint_as_float(key[r]), scale, off), 0.f, 2047.f); __hip_atomic_fetch_add(hrow + ((bin >> 1) ^ (unsigned)r32), (bin & 1u) * 0xffffu + 1u, __ATOMIC_RELAXED, __HIP_MEMORY_SCOPE_WORKGROUP); }
                }
            }
            k0 = n0; k1 = n1;
        }
    }
    __syncthreads();
    hist_scan<true>(hist, 1024, 2048, true, 11, aux, tid);
    __syncthreads();
    if (tid < 32) { if (aux[AX_SCNT + tid] > 512u) aux[AX_FLAG] = 1u; }
    __syncthreads();
    if (aux[AX_FLAG] != 0u && !dm) {
#ifdef MK_DIAG_FALLBACKS
        if (tid == 0) atomicAdd((unsigned*)C.diag, 1u);
#endif
        __syncthreads(); sel_unit_slow(C, b, qg, lds, wave0); return; }
    const unsigned b1 = aux[AX_SPRE + r32];
    const float Ef = b1 < 2047u ? (float)(b1 + 1u) : INFINITY, Lf = b1 > 0u ? (float)b1 : -INFINITY;
    unsigned vmr = 0u;
#pragma unroll
    for (int r = 0; r < 16; ++r) vmr |= (crow(r, hh) <= r32 ? 1u : 0u) << r;
    __syncthreads();
    if (tid < 32) { aux[AX_SPRE + tid] = 0u; }
    {
        bf16x8 k0, k1, n0 = {}, n1 = {};
        int kb = wave;
        if (kb <= qg) idx_load(k0, k1, C.misc, rowbase, kb, r32, hh);
        for (; kb <= kb_last && !(dm & 4); kb += 8) {
            unsigned word = 0u;
            if (kb <= qg) {
                if (kb + 8 <= qg) idx_load(n0, n1, C.misc, rowbase, kb + 8, r32, hh);
                unsigned key[16];
                idx_keys3(key, k0, k1, qf, w2, ql0, ql1);
                const bool diag = (kb == qg);
                unsigned def = 0u, cd = 0u;
#pragma unroll
                for (int r = 15; r >= 0; --r) { const float sv = __builtin_fmaf(__uint_as_float(key[r]), scale, off); def += def + (sv >= Ef ? 1u : 0u); cd += cd + (sv >= Lf ? 1u : 0u); }
                unsigned cm = cd & ~def;
                word = ((def & 0xfu) | ((def & 0xf0u) << 4) | ((def & 0xf00u) << 8) | ((def & 0xf000u) << 12)) << (4 * hh);
                if (diag) { word &= (2u << r32) - 1u; cm &= vmr; }
                if (cm != 0u) {
                    unsigned pos = __hip_atomic_fetch_add(auxw + AX_CCNT + r32, (unsigned)__builtin_popcount(cm), __ATOMIC_RELAXED, __HIP_MEMORY_SCOPE_WORKGROUP);
#pragma unroll
                    for (int r = 0; r < 16; ++r) { if ((cm >> r) & 1u) { if (pos < 512u) { const unsigned u = key[r]; ckey[r32 * 512 + pos] = u ^ ((unsigned)((int)u >> 31) | 0x80000000u); cidx[r32 * 512 + pos] = (unsigned short)(8191 - (kb * 32 + crow(r, hh))); } ++pos; } }
                }
                k0 = n0; k1 = n1;
            }
            word = xl::hor(word);
            if (hh == 0) bitw[r32 * 256 + kb] = word;
        }
    }
    __syncthreads();
    if (tid < 32) { if (aux[AX_CCNT + tid] > (unsigned)SEL_RANK_MAX) aux[AX_FLAG] = 3u; }
    __syncthreads();
    if (aux[AX_FLAG] != 3u) {
        const int q = tid >> 4, c16 = tid & 15; const int cn = (dm & 8) ? 0 : (int)aux[AX_CCNT + q]; const unsigned rem = aux[AX_SREM + q];
        for (int i = c16; i < cn; i += 16) {
            const unsigned ki = ckey[q * 512 + i], vi = cidx[q * 512 + i];
            unsigned rank = 0u;
            for (int j = 0; j < cn; ++j) { const unsigned kj = ckey[q * 512 + j], vj = cidx[q * 512 + j]; rank += (kj > ki || (kj == ki && vj > vi)) ? 1u : 0u; }
            if (rank < rem) { const unsigned s = 8191u - vi; __hip_atomic_fetch_or(bitw + q * 256 + (s >> 5), 1u << (s & 31u), __ATOMIC_RELAXED, __HIP_MEMORY_SCOPE_WORKGROUP); }
        }
    } else {
        const int q = tid >> 4, c16 = tid & 15; int cn = (int)aux[AX_CCNT + q]; cn = cn > 512 ? 512 : cn;
        for (int pass = 0; pass < ((dm & 8) ? 0 : 7); ++pass) {
            for (int i = tid; i < 32 * 64; i += NTHR) shist[i] = 0u;
            __syncthreads();
            const unsigned pre = aux[AX_SPRE + q], thk = aux[AX_THR + q];
            for (int i = c16; i < cn; i += 16) {
                const unsigned ck = ckey[q * 512 + i], cv = cidx[q * 512 + i];
                bool match; unsigned bin;
                if (pass == 0) { match = true; bin = ck >> 28; } else if (pass < 5) { const int sh = 28 - 7 * pass; match = (ck >> (sh + 7)) == pre; bin = (ck >> sh) & 127u; }
                else if (pass == 5) { match = ck == thk; bin = cv >> 6; } else { match = (ck == thk) && ((cv >> 6) == pre); bin = cv & 63u; }
                if (match) __hip_atomic_fetch_add(shist + q * 64 + (bin >> 1), 1u << (16 * (bin & 1u)), __ATOMIC_RELAXED, __HIP_MEMORY_SCOPE_WORKGROUP);
            }
            __syncthreads();
            hist_scan<true>((volatile LAS unsigned*)shist, 64, pass == 6 ? 64 : 128, false, pass == 6 ? 6 : 7, aux, tid);
            __syncthreads();
            if (pass == 4) {
                if (tid < 32) { aux[AX_THR + tid] = aux[AX_SPRE + tid]; aux[AX_SPRE + tid] = 0u; if (aux[AX_SREM + tid] < aux[AX_SCNT + tid]) aux[AX_FLAG] = 2u; }
                __syncthreads();
                if (aux[AX_FLAG] != 2u) break;
            }
        }
        const unsigned thk = aux[AX_THR + q], thv = aux[AX_SPRE + q];
        for (int i = c16; i < cn; i += 16) {
            const unsigned ck = ckey[q * 512 + i], cv = cidx[q * 512 + i];
            if (ck > thk || (ck == thk && cv >= thv)) { const unsigned s = 8191u - cv; __hip_atomic_fetch_or(bitw + q * 256 + (s >> 5), 1u << (s & 31u), __ATOMIC_RELAXED, __HIP_MEMORY_SCOPE_WORKGROUP); }
        }
    }
    __syncthreads();
    if (!(dm & 1)) { const int q = tid >> 4; unsigned* bp = C.bits + (rowbase + 32 * qg + q) * 256; for (int kb = tid & 15; kb <= kb_last; kb += 16) __builtin_nontemporal_store(bitw[q * 256 + kb], bp + kb); }
    __syncthreads();
}

constexpr int MOBA_MAXL = 7936, MOBA_PARTS = 2;
__device__ __forceinline__ void moba_gate_unit(const MixCtx& C, int b, int h, int qb, LAS unsigned char* lds, const int wave0) {
    int tid_ = (wave0 << 6) | xl::fresh_lane(); asm volatile("" : "+v"(tid_));
    const int tid = tid_, lane = tid & 63, r32 = lane & 31, hh = lane >> 5, wave = __builtin_amdgcn_readfirstlane(tid >> 6);
    const size_t rowbase = (size_t)b * S; const int t = qb * 256 + 32 * wave + r32; const int hcol = h * 64;
    LAS float* km = (LAS float*)(lds + RING_OFF + AT_KM);
    for (int e = tid; e < 32 * 64; e += NTHR) { const int n = e >> 6, d = e & 63; const float* p = C.kmp + (size_t)((b * 32 + n) * 2) * 256 + hcol + d; km[e] = (p[0] + p[256]) * (1.0f / 256.0f); }
    __syncthreads();
    float qv[32];
    { const bf16* Qg = C.zt + 7 * C.zts;
#pragma unroll
      for (int ks = 0; ks < 4; ++ks) { const bf16x8 q8 = *(const bf16x8*)(Qg + (rowbase + t) * 256 + hcol + 16 * ks + 8 * hh);
#pragma unroll
          for (int j = 0; j < 8; ++j) qv[ks * 8 + j] = bf2f((unsigned short)q8[j]); } }
    float g0 = -INFINITY, g1 = -INFINITY, g2 = -INFINITY; int i0 = -1, i1 = -1, i2 = -1;
    for (int n = 0; n < qb; ++n) {
        const LAS float* kp = km + n * 64 + 8 * hh;
        float dot = 0.f;
#pragma unroll
        for (int ks = 0; ks < 4; ++ks) { const f32x4 a4 = *(const LAS f32x4*)(kp + 16 * ks), c4 = *(const LAS f32x4*)(kp + 16 * ks + 4);
            dot += qv[ks * 8 + 0] * a4[0] + qv[ks * 8 + 1] * a4[1] + qv[ks * 8 + 2] * a4[2] + qv[ks * 8 + 3] * a4[3] + qv[ks * 8 + 4] * c4[0] + qv[ks * 8 + 5] * c4[1] + qv[ks * 8 + 6] * c4[2] + qv[ks * 8 + 7] * c4[3]; }
        dot = xl::hsum(dot);
        if (dot > g0) { g2 = g1; i2 = i1; g1 = g0; i1 = i0; g0 = dot; i0 = n; }
        else if (dot > g1) { g2 = g1; i2 = i1; g1 = dot; i1 = n; }
        else if (dot > g2) { g2 = dot; i2 = n; }
    }
    if (hh == 0) {
        const int sel[3] = {i0, i1, i2};
#pragma unroll
        for (int j = 0; j < 3; ++j) {
            if (sel[j] >= 0) { unsigned* cp = C.mcnt + (b * 4 + h) * 32 + sel[j]; const unsigned pos = atomicAdd(cp, 1u);
                if (pos < (unsigned)MOBA_MAXL) C.mlist[((size_t)((b * 4 + h) * 32 + sel[j])) * MOBA_MAXL + pos] = (unsigned short)(t | (j << 13)); }
            else C.lse[(rowbase + t) * 16 + h * 4 + j] = -INFINITY;
        }
    }
    __syncthreads();
}
__device__ __forceinline__ void moba_blk_unit(const MixCtx& C, int b, int h, int n, int p, bool own, LAS unsigned char* lds, const int wave0) {
    int tid_ = (wave0 << 6) | xl::fresh_lane(); asm volatile("" : "+v"(tid_));
    const int tid = tid_, lane = tid & 63, r32 = lane & 31, hh = lane >> 5, wave = __builtin_amdgcn_readfirstlane(tid >> 6);
    const size_t rowbase = (size_t)b * S; const int hcol = h * 64;
    const int len = own ? 256 : (int)min(C.mcnt[(b * 4 + h) * 32 + n], (unsigned)MOBA_MAXL);
    if (p * 256 >= len) return;
    const bf16* Qg = C.zt + 7 * C.zts; const bf16* Kg = C.zt + 8 * C.zts; const bf16* Vg = C.zt + 9 * C.zts;
    LAS unsigned char* Kb = lds + RING_OFF; LAS unsigned char* Vb = lds + RING_OFF + 256 * KSTR64;
    const unsigned short* lp = C.mlist + ((size_t)((b * 4 + h) * 32 + n)) * MOBA_MAXL;
    unsigned ent_n = 0u; { const int e0 = p * 256 + 32 * wave + r32; if (!own && e0 < len) ent_n = (unsigned)lp[e0]; }
    { v4u kr[4], vr[4];
#pragma unroll
      for (int i = 0; i < 4; ++i) { const int e = tid + i * NTHR, row = e >> 3, ch = e & 7; kr[i] = *(const v4u*)(Kg + (rowbase + n * 256 + row) * 256 + hcol + ch * 8); vr[i] = *(const v4u*)(Vg + (rowbase + n * 256 + row) * 256 + hcol + ch * 8); }
#pragma unroll
      for (int i = 0; i < 4; ++i) { const int e = tid + i * NTHR, row = e >> 3, ch = e & 7; *(LAS v4u*)(Kb + row * KSTR64 + ch * 16) = kr[i]; *(LAS v4u*)(Vb + row * VSTR + ch * 16) = vr[i]; } }
    bf16x8 qn[4];
    { const int tq0 = own ? n * 256 + 32 * wave + r32 : (int)(ent_n & 8191u);
#pragma unroll
      for (int ks = 0; ks < 4; ++ks) qn[ks] = *(const bf16x8*)(Qg + (rowbase + tq0) * 256 + hcol + 16 * ks + 8 * hh); }
    __syncthreads();
    for (int c = p; c * 256 < len; c += MOBA_PARTS) {
        const int e = c * 256 + 32 * wave + r32; const bool valid = e < len;
        int tq, slot;
        if (own) { tq = n * 256 + e; slot = 3; } else { tq = (int)(ent_n & 8191u); slot = (int)(ent_n >> 13); }
        bf16x8 qf[4];
#pragma unroll
        for (int ks = 0; ks < 4; ++ks) qf[ks] = qn[ks];
        if ((c + MOBA_PARTS) * 256 < len) {
            const int e2 = (c + MOBA_PARTS) * 256 + 32 * wave + r32; ent_n = (e2 < len) ? (unsigned)lp[e2] : 0u;
            const int tq2 = (int)(ent_n & 8191u);
#pragma unroll
            for (int ks = 0; ks < 4; ++ks) qn[ks] = *(const bf16x8*)(Qg + (rowbase + tq2) * 256 + hcol + 16 * ks + 8 * hh);
        }
        f32x16 o0 = {}, o1 = {}, negm = {}; float mref = 0.f, l = 0.f; bool mset = false;
#pragma unroll 1
        for (int i = 0; i < 4; ++i) {
            if (own && 64 * i > 32 * wave + 31) break;
            f32x16 s0, s1;
            qk_tile<4, KSTR64>(s0, s1, Kb + i * 64 * KSTR64, qf, lane, negm);
            if (own && 64 * i + 63 > 32 * wave) {
#pragma unroll
                for (int r = 0; r < 16; ++r) { const int kk = n * 256 + 64 * i + crow(r, hh); if (kk > tq) s0[r] = -INFINITY; if (kk + 32 > tq) s1[r] = -INFINITY; }
            }
            softmax_tile(s0, s1, mref, mset, negm, l, o0, o1);
            pv_tile(o0, o1, Vb + i * 64 * VSTR, s0, s1, lane);
        }
        l = xl::hsum(l);
        if (valid) {
            const float inv = 1.0f / l;
            bf16* op = C.part + ((rowbase + tq) * 16 + h * 4 + slot) * 64;
#pragma unroll
            for (int g = 0; g < 4; ++g) {
                v2u w0, w1;
                w0.x = cvtpk(o0[4 * g] * inv, o0[4 * g + 1] * inv); w0.y = cvtpk(o0[4 * g + 2] * inv, o0[4 * g + 3] * inv);
                w1.x = cvtpk(o1[4 * g] * inv, o1[4 * g + 1] * inv); w1.y = cvtpk(o1[4 * g + 2] * inv, o1[4 * g + 3] * inv);
                *(v2u*)(op + 8 * g + 4 * hh) = w0; *(v2u*)(op + 32 + 8 * g + 4 * hh) = w1;
            }
            if (hh == 0) C.lse[(rowbase + tq) * 16 + h * 4 + slot] = mref + lg2(l);
        }
    }
    __syncthreads();
}

#ifndef MK_REPEAT_LP
#define MK_REPEAT_LP -1
#endif
#ifndef MK_REPEAT_KINDS
#define MK_REPEAT_KINDS 15
#endif
#ifndef MK_REPEAT_LAYERS
#define MK_REPEAT_LAYERS 3
#endif
#ifndef MK_REPEAT_CONV
#define MK_REPEAT_CONV 0
#endif
#ifndef MK_EXTRA_BARRIERS
#define MK_EXTRA_BARRIERS 0
#endif
#ifndef MK_ONLY
#define MK_ONLY -1
#endif
#ifndef MK_SKIPMASK
#define MK_SKIPMASK 0
#endif
#define PHON(x) ((MK_ONLY < 0 || MK_ONLY == (x)) && !((MK_SKIPMASK >> (x)) & 1))
#ifndef MK_MIXONLY
#define MK_MIXONLY -1
#endif
#define MIXON(x) (MK_MIXONLY < 0 || MK_MIXONLY == (x))
constexpr int PH_CONV0 = 0, PH_L0 = 1, PH_CONV1 = 10, PH_L1 = 11, PH_FINAL = 20, N_PHASES = 21, PH_MERGE0 = 21, PH_MERGE1 = 22;
constexpr int LP_INPROJ = 0, LP_MLA = 1, LP_MIX = 2, LP_DSA = 3, LP_PROJ = 4, LP_GATE = 5, LP_OUT = 6, LP_UP = 7, LP_DOWN = 8;


#define P_WIN ((bf16*)(wbase + (WS_WIN - WS_WIN)))
#define P_WMLA ((bf16*)(wbase + (WS_WMLA - WS_WIN)))
#define P_WB ((bf16*)(wbase + (WS_WB - WS_WIN)))
#define P_WOUT ((bf16*)(wbase + (WS_WOUT - WS_WIN)))
#define P_WUP ((bf16*)(wbase + (WS_WUP - WS_WIN)))
#define P_WDOWN ((bf16*)(wbase + (WS_WDOWN - WS_WIN)))
#define P_XB    ((bf16*)(ws + WS_XB))
#define P_ZT    ((bf16*)(ws + WS_ZT))
#define P_MLAA  ((bf16*)(ws + WS_MLAA))
#define P_MISC  ((bf16*)(ws + WS_MISC))
#define P_QM    ((bf16*)(ws + WS_QM))
#define P_KN    ((bf16*)(ws + WS_KN))
#define P_VM    ((bf16*)(ws + WS_VM))
#define P_BITS  ((unsigned*)(ws + WS_BITS))
#define P_O4    ((bf16*)(ws + WS_O4))
#define P_PROJ  ((bf16*)(ws + WS_PROJ))
#define P_DSA2  ((bf16*)(ws + WS_DSA2))
#define P_LSED  ((float*)(ws + WS_LSED))
#define P_MERGED ((bf16*)(ws + WS_MERGED))
#define P_HID   ((bf16*)(ws + WS_HID))
#define P_SSA   ((float*)(ws + WS_SSA))
#define P_SSB   ((float*)(ws + WS_SSB))
#define P_SSQ   ((float*)(ws + WS_SSQ))
#define P_SSKV  ((float*)(ws + WS_SSKV))
#define P_KMP   ((float*)(ws + WS_KMP))
#define P_TP    ((const float*)(ws + WS_TP))
#define P_TI    ((const float*)(ws + WS_TI))
#define P_TM    ((const float*)(ws + WS_TM))

__device__ __forceinline__ int next_unit(gu32* ctr, volatile LAS unsigned* aux, int tid) {
    if (tid == 0) aux[AX_UNIT] = __hip_atomic_fetch_add(ctr, 1u, RLX_AGENT);
    __syncthreads();
    const int u = (int)aux[AX_UNIT];
    __syncthreads();
    return u;
}

template <int ph> __device__ __forceinline__ void run_phase(const Ptrs& P, LAS unsigned char* lds, gu32* ctl, int G, int bx, int vcu, const int wave0) {
    volatile LAS unsigned* aux = (volatile LAS unsigned*)(lds + AUX_OFF);
    const int M = P.mrows, nb = M / S;
    const int NGW = G * NWAVES;
    {
        unsigned char* ws = P.ws;
        unsigned char* wbase = (ph >= PH_L1) ? (unsigned char*)P.out : ws + WS_WIN;
        (void)wbase;
        const size_t zts = (size_t)M * 256;
        if (ph == PH_MERGE0 || ph == PH_MERGE1) {
            int tid_ = (wave0 << 6) | xl::fresh_lane(); asm volatile("" : "+v"(tid_)); const int tid = tid_, lane = tid & 63, wave = __builtin_amdgcn_readfirstlane(tid >> 6), gw = vcu * NWAVES + wave;
            const bf16* part = (const bf16*)(ws + WS_PART); const float* lse = (const float*)(ws + WS_LSE); bf16* oc = P_O4 + 2 * zts;
            const int head = lane >> 4, d0 = (lane & 15) * 4;
            for (int m = gw; m < M; m += NGW) {
                const f32x4 L4 = *(const f32x4*)(lse + (size_t)m * 16 + head * 4);
                const float mx = fmaxf(fmaxf(L4[0], L4[1]), fmaxf(L4[2], L4[3]));
                float wsum = 0.f; f32x4 acc = {0.f, 0.f, 0.f, 0.f};
#pragma unroll
                for (int j = 0; j < 4; ++j) { const float w = __builtin_amdgcn_exp2f(L4[j] - mx);
                    if (w > 0.f) { const v2u pv = *(const v2u*)(part + ((size_t)m * 16 + head * 4 + j) * 64 + d0);
                        acc = acc + w * (f32x4){__uint_as_float(pv.x << 16), __uint_as_float(pv.x & 0xffff0000u), __uint_as_float(pv.y << 16), __uint_as_float(pv.y & 0xffff0000u)}; wsum += w; } }
                const float inv = 1.0f / wsum;
                v2u o; o.x = pk2(acc[0] * inv, acc[1] * inv); o.y = pk2(acc[2] * inv, acc[3] * inv);
                *(v2u*)(oc + (size_t)m * 256 + head * 64 + d0) = o;
                {
                    const float la = P_LSED[((size_t)m * 4 + head) * 2], lb = P_LSED[((size_t)m * 4 + head) * 2 + 1];
                    if (lb > -INFINITY) {
                        bf16* oa = P_O4 + (size_t)m * 256 + head * 64 + d0; const bf16* ob = P_DSA2 + (size_t)m * 256 + head * 64 + d0;
                        const float mm = fmaxf(la, lb), wa = __builtin_amdgcn_exp2f(la - mm), wb = __builtin_amdgcn_exp2f(lb - mm), iv = 1.0f / (wa + wb);
                        const v2u pa = *(const v2u*)oa, pb = *(const v2u*)ob;
                        const f32x4 va = {__uint_as_float(pa.x << 16), __uint_as_float(pa.x & 0xffff0000u), __uint_as_float(pa.y << 16), __uint_as_float(pa.y & 0xffff0000u)};
                        const f32x4 vb = {__uint_as_float(pb.x << 16), __uint_as_float(pb.x & 0xffff0000u), __uint_as_float(pb.y << 16), __uint_as_float(pb.y & 0xffff0000u)};
                        const f32x4 r4 = (va * wa + vb * wb) * iv;
                        v2u o2; o2.x = pk2(r4[0], r4[1]); o2.y = pk2(r4[2], r4[3]);
                        *(v2u*)oa = o2;
                    }
                }
            }
        } else if (PHON(9) && ph == PH_CONV0) {
            int tid_ = (wave0 << 6) | xl::fresh_lane(); asm volatile("" : "+v"(tid_)); const int tid = tid_, lane = tid & 63, wave = __builtin_amdgcn_readfirstlane(tid >> 6), gw = vcu * NWAVES + wave; (void)lane; (void)gw;
            p0_convert(P, lds, gw, NGW, wave, lane);
        } else if (ph == PH_CONV1) {
        } else if (PHON(10) && ph == PH_FINAL) {
            int tid_ = (wave0 << 6) | xl::fresh_lane(); asm volatile("" : "+v"(tid_)); const int tid = tid_, lane = tid & 63, wave = __builtin_amdgcn_readfirstlane(tid >> 6), gw = vcu * NWAVES + wave; (void)lane; (void)gw;
            const float* gf = P.in[13];
            for (int m = gw; m < M; m += NGW) {
                const f32x4 pa = *(const f32x4*)(P_SSA + (size_t)m * 16 + 4 * (lane & 3));
                float s = (pa[0] + pa[1]) + (pa[2] + pa[3]); s += xl::sxor<1>(s); s += xl::sxor<2>(s);
                const float rs = rsqrtf(s * (1.0f / 1024.0f) + 1e-6f);
                const bf16* xr = P_XB + (size_t)m * D; float* orow = P.out + (size_t)m * D;
#pragma unroll
                for (int j = 0; j < 2; ++j) { const int c = 512 * j + 8 * lane; const v4u w = *(const v4u*)(xr + c);
                    const f32x4 g0 = *(const f32x4*)(gf + c), g1 = *(const f32x4*)(gf + c + 4);
                    f32x4 o0 = {__uint_as_float(w.x << 16), __uint_as_float(w.x & 0xffff0000u), __uint_as_float(w.y << 16), __uint_as_float(w.y & 0xffff0000u)};
                    f32x4 o1 = {__uint_as_float(w.z << 16), __uint_as_float(w.z & 0xffff0000u), __uint_as_float(w.w << 16), __uint_as_float(w.w & 0xffff0000u)};
                    *(f32x4*)(orow + c) = o0 * rs * g0; *(f32x4*)(orow + c + 4) = o1 * rs * g1; }
            }
#ifdef MK_DIAG_FALLBACKS
            if (gw == 0 && lane == 0) { const unsigned cnt = __hip_atomic_load(ctl + 12288, RLX_AGENT); if (cnt) { asm volatile("s_waitcnt vmcnt(0)" ::: "memory"); P.out[0] = sqrtf((float)cnt * (float)M * 1024.0f * 1.0025f); } }
#endif
        } else {
            const int l = (ph >= PH_L1) ? 1 : 0, lp = ph - (l ? PH_L1 : PH_L0);
            const int nrep = (lp == MK_REPEAT_LP && ((MK_REPEAT_LAYERS >> l) & 1)) ? 2 : 1;
            for (int rep = 0; rep < nrep; ++rep) {
            if (PHON(0) && lp == LP_INPROJ) {
                pg8::Gemm g{P_XB, P_WIN, M, 3072, D}; pg8::StaticOrder so; so.init(M, 3072, G, bx);
                pg8::EpiInProj E{P_ZT, zts, P_MLAA, P_MISC, P_SSA, P_SSQ, P_SSKV, P_KMP, P_TP, P_TI, P_TM};
                pg8::gemm_phase<pg8::EpiInProj, pg8::StaticOrder, true, true>(lds + RING_OFF, g, so, E, wave0);
            } else if (PHON(1) && lp == LP_MLA) {
                pg8::Gemm g{P_MLAA, P_WMLA, M, 1024, 384}; pg8::StaticOrder so; so.init(M, 1024, G, bx);
                pg8::EpiMla E{P_QM, P_KN, P_VM, P_SSQ, P_SSKV, P_TM};
                pg8::gemm_phase<pg8::EpiMla, pg8::StaticOrder, true, true>(lds + RING_OFF, g, so, E, wave0);
            } else if (PHON(2) && lp == LP_MIX) {
                MixCtx MC; MC.zt = P_ZT; MC.zts = zts; MC.misc = P_MISC; MC.qm = P_QM; MC.kn = P_KN; MC.vm = P_VM; MC.kmp = P_KMP; MC.bits = P_BITS; MC.o4 = P_O4; MC.o4s = zts; MC.diag = (unsigned*)(ctl + 12288); MC.mlist = (unsigned short*)(ws + WS_MLIST); MC.mcnt = (unsigned*)(ctl + CW_MCNT + 256 * l); MC.part = (bf16*)(ws + WS_PART); MC.lse = (float*)(ws + WS_LSE); MC.dsa2 = (bf16*)(ws + WS_DSA2); MC.lsed = (float*)(ws + WS_LSED);
                int tid_ = (wave0 << 6) | xl::fresh_lane(); asm volatile("" : "+v"(tid_)); const int tid = tid_, lane = tid & 63, wave = __builtin_amdgcn_readfirstlane(tid >> 6), gw = vcu * NWAVES + wave; (void)lane; (void)gw;
                gu32* ctr = ctl + CW_QUEUE + 64 * (2 * l + 4 * rep);
                const int per = 20 * nb, total = 32 * per;
                for (;;) {
                    const int u = next_unit(ctr, aux, tid);
                    if (u >= total) break;
                    const int L = 31 - u / per, r = u % per;
                    const int kmask = rep ? MK_REPEAT_KINDS : 15;
                    if (r < 12 * nb) { const int kind = r / (4 * nb), rr = r % (4 * nb), b = rr >> 2, h = rr & 3;
                        if (MIXON(0) && kind == 0 && (kmask & 1)) softmax_unit<0>(MC, b, h, L, lds, wave0, rep); else if (MIXON(2) && kind == 1 && (kmask & 4)) sb_unit(MC, b, h, L, lds, wave0);
                        else if (kind == 2 && !rep) moba_gate_unit(MC, b, h, L, lds, wave0); }
                    else if (MIXON(3) && (kmask & 8)) { const int r2 = r - 12 * nb, b = r2 >> 3, qg = 8 * L + 7 - (r2 & 7); sel_unit(MC, b, qg, lds, wave0, rep); }
                }
            } else if (PHON(3) && lp == LP_DSA) {
                MixCtx MC; MC.zt = P_ZT; MC.zts = zts; MC.misc = P_MISC; MC.qm = P_QM; MC.kn = P_KN; MC.vm = P_VM; MC.kmp = P_KMP; MC.bits = P_BITS; MC.o4 = P_O4; MC.o4s = zts; MC.diag = (unsigned*)(ctl + 12288); MC.mlist = (unsigned short*)(ws + WS_MLIST); MC.mcnt = (unsigned*)(ctl + CW_MCNT + 256 * l); MC.part = (bf16*)(ws + WS_PART); MC.lse = (float*)(ws + WS_LSE); MC.dsa2 = (bf16*)(ws + WS_DSA2); MC.lsed = (float*)(ws + WS_LSED);
                int tid_ = (wave0 << 6) | xl::fresh_lane(); asm volatile("" : "+v"(tid_)); const int tid = tid_, lane = tid & 63, wave = __builtin_amdgcn_readfirstlane(tid >> 6), gw = vcu * NWAVES + wave; (void)lane; (void)gw;
                gu32* ctr = ctl + CW_QUEUE + 64 * (2 * l + 1 + 4 * rep);
                const int per = (12 + 4 * MOBA_PARTS) * nb, total = 32 * per;
                for (;;) {
                    const int u = next_unit(ctr, aux, tid);
                    if (u >= total) break;
                    const int L = 31 - u / per, r = u % per;
                    const int kmask = rep ? MK_REPEAT_KINDS : 15;
                    if (r < 8 * nb) { const int hf = r / (4 * nb), rr = r % (4 * nb); softmax_unit<1>(MC, rr >> 2, rr & 3, L, lds, wave0, 0, hf); }
                    else if (r < 12 * nb) { const int rr = r - 8 * nb; if (MIXON(1) && (kmask & 2)) moba_blk_unit(MC, rr >> 2, rr & 3, L, 0, true, lds, wave0); }
                    else { const int rr = r - 12 * nb, bh = rr / MOBA_PARTS, p = rr % MOBA_PARTS; if (MIXON(1) && (kmask & 2) && L > 0) moba_blk_unit(MC, bh >> 2, bh & 3, 31 - L, p, false, lds, wave0); }
                }
            } else if (PHON(4) && lp == LP_PROJ) {
                pg8::Gemm g{P_O4, P_WB, 4 * M, 4096, 256}; pg8::ProjOrder so{M / 256, G, bx};
                pg8::EpiProj E{P_PROJ, M / 256};
                pg8::gemm_phase<pg8::EpiProj, pg8::ProjOrder, true, true>(lds + RING_OFF, g, so, E, wave0);
            } else if (PHON(5) && lp == LP_GATE) {
                pg8::Gemm g{P_XB, P_WIN, M, 7168, D}; pg8::GateOrder so; so.so.init(M, 1024, G, bx);
                pg8::EpiGate E{P_PROJ, P_MERGED, P_SSA, P.in[3] + (size_t)l * 4 * D};
                pg8::gemm_phase<pg8::EpiGate, pg8::GateOrder, true, true>(lds + RING_OFF, g, so, E, wave0);
            } else if (PHON(6) && lp == LP_OUT) {
                pg8::Gemm g{P_MERGED, P_WOUT, M, D, D}; pg8::StaticOrder so; so.init(M, D, G, bx);
                pg8::EpiResid E{(l == 0) ? P.in[0] : nullptr, P_XB, P_SSB};
                pg8::gemm_phase<pg8::EpiResid, pg8::StaticOrder, true, true>(lds + RING_OFF, g, so, E, wave0);
            } else if (PHON(7) && lp == LP_UP) {
                pg8::Gemm g{P_XB, P_WUP, M, FF, D}; pg8::StaticOrder so; so.init(M, FF, G, bx);
                pg8::EpiUp E{P_HID, P_SSB};
                pg8::gemm_phase<pg8::EpiUp, pg8::StaticOrder, true, true>(lds + RING_OFF, g, so, E, wave0);
            } else if (PHON(8)) {
                pg8::Gemm g{P_HID, P_WDOWN, M, D, FF}; pg8::StaticOrder so; so.init(M, D, G, bx);
                pg8::EpiResid E{nullptr, P_XB, P_SSA};
                pg8::gemm_phase<pg8::EpiResid, pg8::StaticOrder, true, true>(lds + RING_OFF, g, so, E, wave0);
            }
            }
        }
    }
}

__global__ void __launch_bounds__(NTHR, 2) mk_fwd(Ptrs P) {
    extern __shared__ __attribute__((aligned(16))) unsigned char lds_raw[];
    LAS unsigned char* lds = (LAS unsigned char*)lds_raw;
    const int tid0 = threadIdx.x;
    const int wave0 = __builtin_amdgcn_readfirstlane(tid0 >> 6);
#define LEADER (wave0 == 0 && xl::fresh_lane() == 0)
    const int G = gridDim.x, bx = blockIdx.x;
    const int vcu = (G % 8 == 0) ? (bx % 8) * (G / 8) + bx / 8 : bx;
    gu32* ctl = (gu32*)(P.ws + WS_CTL);
    volatile LAS unsigned* MISCW = (volatile LAS unsigned*)(lds + MISC_OFF);
    for (int u = tid0; u < (LDS_BYTES - LDSCTL_OFF) / 4; u += NTHR) ((LAS unsigned*)(lds + LDSCTL_OFF))[u] = 0u;
    __syncthreads();
    const bool multi = (P.ph_hi - P.ph_lo) > 1;
    XcdBarrier bar; bar.bar = (unsigned*)(ctl + CW_BAR); bar.x = 0; bar.st = nullptr;
    if (multi) bar = xcd_barrier_post((unsigned*)(ctl + CW_BAR), MISCW + 8, tid0 == 0);
#define RUNPH(k) if (P.ph_lo <= (k) && (k) < P.ph_hi) { run_phase<k>(P, lds, ctl, G, bx, vcu, wave0); if ((k) + 1 < P.ph_hi && (k) != PH_CONV1) xcd_barrier(bar, LEADER); }
    RUNPH(0) RUNPH(1) RUNPH(2) RUNPH(3) RUNPH(4)
    if (P.ph_lo <= PH_L0 + LP_DSA && PH_L0 + LP_PROJ < P.ph_hi) { run_phase<PH_MERGE0>(P, lds, ctl, G, bx, vcu, wave0); xcd_barrier(bar, LEADER); }
    RUNPH(5) RUNPH(6) RUNPH(7) RUNPH(8) RUNPH(9) RUNPH(10)
#if MK_REPEAT_CONV
    RUNPH(10)
#endif
    RUNPH(11) RUNPH(12) RUNPH(13) RUNPH(14)
    if (P.ph_lo <= PH_L1 + LP_DSA && PH_L1 + LP_PROJ < P.ph_hi) { run_phase<PH_MERGE1>(P, lds, ctl, G, bx, vcu, wave0); xcd_barrier(bar, LEADER); }
    RUNPH(15) RUNPH(16) RUNPH(17) RUNPH(18) RUNPH(19) RUNPH(20)
#undef RUNPH
    if (multi) { for (int i = 0; i < MK_EXTRA_BARRIERS; ++i) xcd_barrier(bar, LEADER); }
}

static int g_grid = 0;
static int mk_setup(size_t ws_size) {
    if (g_grid != 0) return g_grid;
    if (ws_size < WS_END) { fprintf(stderr, "kernel_launch: workspace too small (%zu < %zu)\n", ws_size, (size_t)WS_END); g_grid = -1; return g_grid; }
    int dev = 0, cus = 0, per_cu = 0;
    if (hipGetDevice(&dev) != hipSuccess || hipDeviceGetAttribute(&cus, hipDeviceAttributeMultiprocessorCount, dev) != hipSuccess) { g_grid = -1; return g_grid; }
    if (hipFuncSetAttribute((const void*)mk_fwd, hipFuncAttributeMaxDynamicSharedMemorySize, LDS_BYTES) != hipSuccess) { fprintf(stderr, "kernel_launch: hipFuncSetAttribute failed\n"); g_grid = -1; return g_grid; }
    if (hipOccupancyMaxActiveBlocksPerMultiprocessor(&per_cu, (const void*)mk_fwd, NTHR, LDS_BYTES) != hipSuccess || per_cu < 1) fprintf(stderr, "kernel_launch: occupancy query reports %d blocks per CU\n", per_cu);
    (void)hipGetLastError();
    g_grid = cus;
    return g_grid;
}
static void mk_launch(Ptrs a, int lo, int hi, int li, hipStream_t stream) {
    a.ph_lo = lo; a.ph_hi = hi; a.li = li;
    hipLaunchKernelGGL(mk_fwd, dim3(g_grid), dim3(NTHR), LDS_BYTES, stream, a);
}
}

extern "C" void kernel_launch(void* const* d_in, const int* in_sizes, int n_in, void* d_out, int out_size, void* d_ws, size_t ws_size, hipStream_t stream) {
    if (n_in != 14 || out_size != 2 * mk::S * mk::D) { fprintf(stderr, "kernel_launch: unexpected shapes\n"); return; }
    if (mk::mk_setup(ws_size) < 0) return;
    if (hipMemsetAsync((char*)d_ws + mk::WS_CTL, 0, mk::CTL_ZERO_BYTES, stream) != hipSuccess) return;
    mk::Ptrs a{};
    for (int i = 0; i < 14; ++i) a.in[i] = (const float*)d_in[i];
    a.out = (float*)d_out; a.ws = (unsigned char*)d_ws; a.mrows = 2 * mk::S;
#ifndef MK_PER_PHASE
    mk::mk_launch(a, 0, mk::N_PHASES, 0, stream);
#else
    for (int ph = 0; ph < mk::N_PHASES; ++ph) mk::mk_launch(a, ph, ph + 1, ph, stream);
#endif
}
```

```cpp
#include <hip/hip_runtime.h>
#include <hip/hip_bf16.h>
#include <cstdio>
#include <cstdint>
#include <cmath>

namespace xl {
template <int K> __device__ __forceinline__ float sxor(float v) { return __int_as_float(__builtin_amdgcn_ds_swizzle(__float_as_int(v), (K << 10) | 0x1F)); }
template <int K> __device__ __forceinline__ unsigned bcast16(unsigned v) { return (unsigned)__builtin_amdgcn_ds_swizzle((int)v, (K << 5) | 0x10); }
__device__ __forceinline__ void halves(float v, float& lo, float& hi) { auto rr = __builtin_amdgcn_permlane32_swap(__float_as_uint(v), __float_as_uint(v), false, false); lo = __uint_as_float(rr[0]); hi = __uint_as_float(rr[1]); }
__device__ __forceinline__ float hsum(float v) { float lo, hi; halves(v, lo, hi); return lo + hi; }
__device__ __forceinline__ float hmax(float v) { float lo, hi; halves(v, lo, hi); return fmaxf(lo, hi); }
__device__ __forceinline__ unsigned hor(unsigned v) { auto rr = __builtin_amdgcn_permlane32_swap(v, v, false, false); return rr[0] | rr[1]; }
__device__ __forceinline__ int fresh_lane() { int z = 0; asm volatile("" : "+v"(z)); return (int)__builtin_amdgcn_mbcnt_hi(~0u, __builtin_amdgcn_mbcnt_lo(~0u, (unsigned)z)); }
}
namespace pg8 {
#define PG8_LAS __attribute__((address_space(3)))
typedef unsigned short bf16_t;
typedef short bf16x8 __attribute__((ext_vector_type(8)));
typedef float f32x4 __attribute__((ext_vector_type(4)));
typedef unsigned u32x4 __attribute__((ext_vector_type(4)));
constexpr int BM = 256, BK = 64, HALF = 128, HTB = HALF * BK * 2  , STAGE_BYTES = 8 * HTB, NXCD = 8, WGM = 8;

__host__ __device__ __forceinline__ int lds_byte(int r, int c) { const int st = (r >> 4) * 2 + (c >> 5), rr = r & 15, cc = c & 31, ob = rr * 64 + cc * 2; return st * 1024 + (ob ^ (((ob >> 9) & 1) << 5)); }
__host__ __device__ __forceinline__ void stage_rc(int b, int& R, int& C) { const int st = b / 1024, sb = b % 1024, swz = sb ^ (((sb >> 9) & 1) << 5); R = (st >> 1) * 16 + swz / 64; C = (st & 1) * 32 + (swz % 64) / 2; }
__host__ __device__ __forceinline__ int perm32(int rho) { const int n = rho >> 4, i = rho & 15; return 8 * (i >> 2) + 4 * n + (i & 3); }

struct Unit { int pm, pn; };
struct Gemm { const bf16_t* A; const bf16_t* Bt; int M, N, K; };

struct StaticOrder {
    int nM, nN, nwg, G, c;
    __host__ __device__ void init(int M, int N, int G_, int c_) { nM = M / BM; nN = N / BM; nwg = nM * nN; G = G_; c = c_; }
    __host__ __device__ bool next(int i, Unit& u) const {
        const long L = (long)i * G + c; if (L >= nwg) return false;
        int wgid = (int)L; { const int q = nwg / NXCD, r = nwg % NXCD, xcd = wgid % NXCD, off = wgid / NXCD; wgid = (xcd < r ? xcd * (q + 1) : r * (q + 1) + (xcd - r) * q) + off; }
        const int nig = WGM * nN, gid = wgid / nig, fm = gid * WGM, gsz = (nM - fm) < WGM ? (nM - fm) : WGM;
        u.pm = fm + ((wgid % nig) % gsz); u.pn = (wgid % nig) / gsz; return true;
    }
    __device__ __forceinline__ void a_ready(const Unit&) const {}
    __device__ __forceinline__ void done(const Unit&) const {}
};

__device__ __forceinline__ unsigned cvt_pk_bf16(float lo, float hi) { unsigned r; asm volatile("v_cvt_pk_bf16_f32 %0, %1, %2" : "=v"(r) : "v"(lo), "v"(hi)); return r; }
template <class Epi, class Sched, bool ALIGN_EPI = false, bool SP2 = false>
__device__ __forceinline__ void gemm_phase(PG8_LAS unsigned char* lds, const Gemm g, const Sched& S, const Epi& E, const int wave0) {
    int tid_ = (wave0 << 6) | xl::fresh_lane(); asm volatile("" : "+v"(tid_));
    const int tid = tid_, wid = __builtin_amdgcn_readfirstlane(tid >> 6), lane = tid & 63, wr = wid >> 2, wc = wid & 3, fr = lane & 15, fq = lane >> 4;
    int K_ = g.K; asm volatile("" : "+s"(K_));
    const int K = K_, nt = K / BK;
    unsigned voffA[2], voffB[2];
#pragma unroll
    for (int i = 0; i < 2; ++i) { int R, C; stage_rc(tid * 16 + i * 8192, R, C); const int Rb = Epi::PERM ? ((R & ~31) + perm32(R & 31)) : R;
        voffA[i] = (unsigned)(R * K + C) * 2u; voffB[i] = (unsigned)(Rb * K + C) * 2u; }
    const size_t kstep = (size_t)(BK * 2);
    const size_t hstep = (size_t)HALF * K * 2;
    const size_t tstep = 2 * hstep;
    const unsigned ldsw = (unsigned)wid * 1024u;
    const int aoff = lds_byte(wr * 64 + fr, fq * 8), boff = lds_byte(wc * 32 + fr, fq * 8);
#define PG8_SA(b, h) (((b) * 2 + (h)) * HTB)
#define PG8_SB(b, h) ((4 + (b) * 2 + (h)) * HTB)
#define PG8_STAGE(bufoff, gbase, voff) do { _Pragma("unroll") for (int _i = 0; _i < 2; ++_i) \
        __builtin_amdgcn_global_load_lds((const unsigned*)((const char*)(gbase) + (voff)[_i]), (PG8_LAS unsigned*)(lds + (bufoff) + ldsw + _i * 8192), 16, 0, 0); } while (0)
#define PG8_LDA(dst, b, h) do { _Pragma("unroll") for (int m = 0; m < 4; ++m) _Pragma("unroll") for (int k = 0; k < 2; ++k) dst[m][k] = *(const PG8_LAS bf16x8*)(lds + PG8_SA(b, h) + aoff + m * 2048 + k * 1024); } while (0)
#define PG8_LDB(dst, b, h) do { _Pragma("unroll") for (int n = 0; n < 2; ++n) _Pragma("unroll") for (int k = 0; k < 2; ++k) dst[n][k] = *(const PG8_LAS bf16x8*)(lds + PG8_SB(b, h) + boff + n * 2048 + k * 1024); } while (0)
#define PG8_MMA(ai, bj, At, Bt) do { __builtin_amdgcn_s_setprio(1); _Pragma("unroll") for (int m = 0; m < 4; ++m) _Pragma("unroll") for (int n = 0; n < 2; ++n) _Pragma("unroll") for (int k = 0; k < 2; ++k) \
        acc[ai][bj][m][n] = __builtin_amdgcn_mfma_f32_16x16x32_bf16(Bt[n][k], At[m][k], acc[ai][bj][m][n], 0, 0, 0); __builtin_amdgcn_s_setprio(0); } while (0)
#define PG8_WAIT_V(n) asm volatile("s_waitcnt vmcnt(" #n ")" ::: "memory")
#define PG8_WAIT_L(n) asm volatile("s_waitcnt lgkmcnt(" #n ")" ::: "memory")
#define PG8_BAR __builtin_amdgcn_s_barrier()
#define PG8_SCHED __builtin_amdgcn_sched_barrier(0)
    Unit cur, nxt; int ui = 0;
    if (!S.next(0, cur)) return;
    f32x4 acc[2][2][4][2];
#pragma unroll
    for (int a = 0; a < 2; ++a)
#pragma unroll
        for (int b = 0; b < 2; ++b)
#pragma unroll
            for (int m = 0; m < 4; ++m)
#pragma unroll
                for (int n = 0; n < 2; ++n) acc[a][b][m][n] = (f32x4){0.f, 0.f, 0.f, 0.f};
    bf16x8 At[4][2], B0[2][2], B1[2][2];
    const char* cA = (const char*)g.A + (size_t)cur.pm * tstep; const char* cB = (const char*)g.Bt + (size_t)cur.pn * tstep;
    S.a_ready(cur);
    if constexpr (SP2) {
        PG8_STAGE(PG8_SB(0, 0), cB, voffB); PG8_STAGE(PG8_SB(0, 1), cB + hstep, voffB); PG8_STAGE(PG8_SA(0, 0), cA, voffA); PG8_STAGE(PG8_SA(0, 1), cA + hstep, voffA);
        if (wr == 1) PG8_BAR;
        PG8_WAIT_V(2); PG8_BAR;
        PG8_STAGE(PG8_SB(1, 0), cB + kstep, voffB); PG8_STAGE(PG8_SA(1, 0), cA + kstep, voffA); PG8_STAGE(PG8_SB(1, 1), cB + hstep + kstep, voffB);
        PG8_WAIT_V(6); PG8_BAR;
    } else {
        PG8_STAGE(PG8_SB(0, 0), cB, voffB); PG8_STAGE(PG8_SA(0, 0), cA, voffA); PG8_STAGE(PG8_SB(0, 1), cB + hstep, voffB); PG8_STAGE(PG8_SA(0, 1), cA + hstep, voffA);
        if (wr == 1) PG8_BAR;
        PG8_WAIT_V(4); PG8_BAR;
        PG8_STAGE(PG8_SB(1, 0), cB + kstep, voffB); PG8_STAGE(PG8_SA(1, 0), cA + kstep, voffA); PG8_STAGE(PG8_SB(1, 1), cB + hstep + kstep, voffB);
        PG8_WAIT_V(6); PG8_BAR;
    }
    for (;;) {
        const bool has_next = S.next(ui + 1, nxt);
        const char* nA = has_next ? (const char*)g.A + (size_t)nxt.pm * tstep : cA; const char* nB = has_next ? (const char*)g.Bt + (size_t)nxt.pn * tstep : cB;
        for (int t = 0; t < nt; t += 2) {
            const bool last = (t == nt - 2);
            const char* a1 = cA + (size_t)(t + 1) * kstep;
            const char* a2 = last ? nA : cA + (size_t)(t + 2) * kstep; const char* b2 = last ? nB : cB + (size_t)(t + 2) * kstep;
            const char* a3 = a2 + kstep; const char* b3 = b2 + kstep;
            if (last && has_next) S.a_ready(nxt);
            if constexpr (SP2) {
            PG8_LDB(B0, 0, 0); PG8_LDB(B1, 0, 1); PG8_SCHED; PG8_LDA(At, 0, 0); PG8_STAGE(PG8_SA(1, 1), a1 + hstep, voffA);
            PG8_WAIT_V(8); PG8_WAIT_L(0); PG8_BAR; PG8_MMA(0, 0, At, B0); PG8_MMA(0, 1, At, B1); PG8_BAR; PG8_SCHED;
            PG8_LDA(At, 0, 1); PG8_STAGE(PG8_SB(0, 0), b2, voffB); PG8_STAGE(PG8_SB(0, 1), b2 + hstep, voffB); PG8_STAGE(PG8_SA(0, 0), a2, voffA);
            PG8_WAIT_V(8); PG8_WAIT_L(0); PG8_BAR; PG8_MMA(1, 0, At, B0); PG8_MMA(1, 1, At, B1); PG8_BAR; PG8_SCHED;
            PG8_LDB(B0, 1, 0); PG8_LDB(B1, 1, 1); PG8_SCHED; PG8_LDA(At, 1, 0); PG8_STAGE(PG8_SA(0, 1), a2 + hstep, voffA);
            PG8_WAIT_V(8); PG8_WAIT_L(0); PG8_BAR; PG8_MMA(0, 0, At, B0); PG8_MMA(0, 1, At, B1); PG8_BAR; PG8_SCHED;
            PG8_LDA(At, 1, 1); PG8_STAGE(PG8_SB(1, 0), b3, voffB); PG8_STAGE(PG8_SB(1, 1), b3 + hstep, voffB); PG8_STAGE(PG8_SA(1, 0), a3, voffA);
            PG8_WAIT_V(8); PG8_WAIT_L(0); PG8_BAR; PG8_MMA(1, 0, At, B0); PG8_MMA(1, 1, At, B1); PG8_BAR; PG8_SCHED;
            } else {
            PG8_LDB(B0, 0, 0); PG8_SCHED; PG8_LDA(At, 0, 0); PG8_STAGE(PG8_SA(1, 1), a1 + hstep, voffA);
            PG8_WAIT_L(8); PG8_BAR; PG8_WAIT_L(0); PG8_MMA(0, 0, At, B0); PG8_BAR; PG8_SCHED;
            PG8_LDB(B1, 0, 1); PG8_STAGE(PG8_SB(0, 0), b2, voffB);
            PG8_BAR; PG8_WAIT_L(0); PG8_MMA(0, 1, At, B1); PG8_BAR;
            PG8_LDA(At, 0, 1); PG8_STAGE(PG8_SA(0, 0), a2, voffA);
            PG8_BAR; PG8_WAIT_L(0); PG8_MMA(1, 0, At, B0); PG8_BAR; PG8_SCHED;
            PG8_STAGE(PG8_SB(0, 1), b2 + hstep, voffB);
            PG8_WAIT_V(6); PG8_BAR; PG8_MMA(1, 1, At, B1); PG8_BAR;
            PG8_LDB(B0, 1, 0); PG8_SCHED; PG8_LDA(At, 1, 0); PG8_STAGE(PG8_SA(0, 1), a2 + hstep, voffA);
            PG8_WAIT_L(8); PG8_BAR; PG8_WAIT_L(0); PG8_MMA(0, 0, At, B0); PG8_BAR; PG8_SCHED;
            PG8_LDB(B1, 1, 1); PG8_STAGE(PG8_SB(1, 0), b3, voffB);
            PG8_BAR; PG8_WAIT_L(0); PG8_MMA(0, 1, At, B1); PG8_BAR;
            PG8_LDA(At, 1, 1); PG8_STAGE(PG8_SA(1, 0), a3, voffA);
            PG8_BAR; PG8_WAIT_L(0); PG8_MMA(1, 0, At, B0); PG8_BAR; PG8_SCHED;
            PG8_STAGE(PG8_SB(1, 1), b3 + hstep, voffB);
            PG8_WAIT_V(6); PG8_BAR; PG8_MMA(1, 1, At, B1); PG8_BAR;
            }
        }
        if constexpr (ALIGN_EPI) { if (wr == 0) PG8_BAR; }
        if constexpr (!Epi::AFTER_DRAIN) { E(acc, cur, wr, wc, fr, fq); S.done(cur); }
        if (!has_next) break;
#pragma unroll
        for (int a = 0; a < 2; ++a)
#pragma unroll
            for (int b = 0; b < 2; ++b)
#pragma unroll
                for (int m = 0; m < 4; ++m)
#pragma unroll
                    for (int n = 0; n < 2; ++n) acc[a][b][m][n] = (f32x4){0.f, 0.f, 0.f, 0.f};
        cur = nxt; cA = nA; cB = nB; ++ui;
        if constexpr (ALIGN_EPI) { if (wr == 1) PG8_BAR; }
    }
    PG8_WAIT_V(0);
    if constexpr (!ALIGN_EPI) { if (wr == 0) PG8_BAR; }
    PG8_BAR;
    if constexpr (Epi::AFTER_DRAIN) { E.fused(acc, cur, wr, wc, fr, fq, lds, wid, lane); S.done(cur); }
#undef PG8_SA
#undef PG8_SB
#undef PG8_STAGE
#undef PG8_LDA
#undef PG8_LDB
#undef PG8_MMA
#undef PG8_WAIT_V
#undef PG8_WAIT_L
#undef PG8_BAR
#undef PG8_SCHED
}

constexpr float NORM_EPS = 1e-6f;
constexpr float LOG2E = 1.4426950408889634f;
__device__ __forceinline__ u32x4 pack8(const f32x4 a, const f32x4 b) { u32x4 w; w.x = cvt_pk_bf16(a[0], a[1]); w.y = cvt_pk_bf16(a[2], a[3]); w.z = cvt_pk_bf16(b[0], b[1]); w.w = cvt_pk_bf16(b[2], b[3]); return w; }
__device__ __forceinline__ float bf_lo(unsigned w) { return __uint_as_float(w << 16); }
__device__ __forceinline__ float bf_hi(unsigned w) { return __uint_as_float(w & 0xffff0000u); }
__device__ __forceinline__ float row_total16(const float* ss, int row, int fq) {
    const f32x4 p = *(const f32x4*)(ss + (size_t)row * 16 + 4 * fq);
    float s = (p[0] + p[1]) + (p[2] + p[3]);
    s += xl::sxor<16>(s); s = xl::hsum(s);
    return s;
}
__device__ __forceinline__ void rot4(f32x4& v0, f32x4& v1, const f32x4 c4, const f32x4 s4) {
    const float a0 = v0[0] * c4[0] - v0[1] * s4[0], b0 = v0[1] * c4[0] + v0[0] * s4[0];
    const float a1 = v0[2] * c4[1] - v0[3] * s4[1], b1 = v0[3] * c4[1] + v0[2] * s4[1];
    const float a2 = v1[0] * c4[2] - v1[1] * s4[2], b2 = v1[1] * c4[2] + v1[0] * s4[2];
    const float a3 = v1[2] * c4[3] - v1[3] * s4[3], b3 = v1[3] * c4[3] + v1[2] * s4[3];
    v0 = (f32x4){a0, b0, a1, b1}; v1 = (f32x4){a2, b2, a3, b3};
}

struct EpiInProj {
    static constexpr bool PERM = true, AFTER_DRAIN = false;
    bf16_t* zt; size_t zt_stride; bf16_t* mla_a; bf16_t* misc; const float* ss; float* ssq; float* sskv; float* kmp; const float* tp; const float* ti; const float* tm;
    __device__ __forceinline__ void operator()(const f32x4 (&acc)[2][2][4][2], const Unit& u, int wr, int wc, int fr, int fq) const {
        const int tile = u.pn;
        const int row0 = u.pm * BM + wr * 64 + fr;
        const bool rot64 = (tile == 0) | (tile == 1) | (tile == 7) | (tile == 8);
        const float scl = (tile == 0 || tile == 7) ? 0.125f * LOG2E : (tile == 4 ? 0.125f : 1.0f);
        float ksum[2][8];
#pragma unroll
        for (int bj = 0; bj < 2; ++bj)
#pragma unroll
            for (int e = 0; e < 8; ++e) ksum[bj][e] = 0.f;
        float rsv[2][4];
#pragma unroll
        for (int ai = 0; ai < 2; ++ai)
#pragma unroll
            for (int m = 0; m < 4; ++m) rsv[ai][m] = rsqrtf(row_total16(ss, row0 + ai * HALF + m * 16, fq) * (1.0f / 1024.0f) + NORM_EPS);
        const int ct0 = wc * 32 + 8 * fq;
        const float* rtab = nullptr; int rstride = 0, coff = 0, soff = 0, rbj = 3;
        if (rot64) { if ((ct0 & 63) < 16) { rtab = tp; rstride = 16; coff = (ct0 & 63) >> 1; soff = coff + 8; } }
        else if (tile == 3) { if ((ct0 & 31) == 0) { rtab = ti; rstride = 8; coff = 0; soff = 4; } }
        else if (tile == 11) { rbj = 2; if (wc == 0) { rtab = tm; rstride = 32; coff = ct0 >> 1; soff = coff + 16; } else if (wc == 1 && fq == 0) { rtab = ti; rstride = 8; coff = 0; soff = 4; } }
#pragma unroll
        for (int am = 0; am < 4; ++am) {
            const int ai = am >> 1;
            f32x4 c4[2], s4[2];
            if (rtab) {
#pragma unroll
                for (int mm = 0; mm < 2; ++mm) { const int t = (row0 + ai * HALF + (2 * (am & 1) + mm) * 16) & 8191; c4[mm] = *(const f32x4*)(rtab + t * rstride + coff); s4[mm] = *(const f32x4*)(rtab + t * rstride + soff); }
            }
#pragma unroll
            for (int mm = 0; mm < 2; ++mm) {
                const int m = 2 * (am & 1) + mm;
                const int row = row0 + ai * HALF + m * 16;
                const float rs = rsv[ai][m];
                float sq0 = 0.f, sq1 = 0.f;
#pragma unroll
                for (int bj = 0; bj < 2; ++bj) {
                    const int ct = bj * HALF + ct0;
                    f32x4 v0 = acc[ai][bj][m][0] * rs, v1 = acc[ai][bj][m][1] * rs;
                    if (rtab && ((rbj >> bj) & 1)) rot4(v0, v1, c4[mm], s4[mm]);
                    if (tile <= 9) {
                        if (tile == 8) {
#pragma unroll
                            for (int e = 0; e < 4; ++e) { ksum[bj][e] += v0[e]; ksum[bj][4 + e] += v1[e]; }
                        }
                        v0 = v0 * scl; v1 = v1 * scl;
                        *(u32x4*)(zt + (size_t)tile * zt_stride + (size_t)row * 256 + ct) = pack8(v0, v1);
                    } else if (tile == 10) {
                        sq0 += (v0[0] * v0[0] + v0[1] * v0[1]) + (v0[2] * v0[2] + v0[3] * v0[3]) + (v1[0] * v1[0] + v1[1] * v1[1]) + (v1[2] * v1[2] + v1[3] * v1[3]);
                        *(u32x4*)(mla_a + (size_t)row * 384 + ct) = pack8(v0, v1);
                    } else {
                        if (bj == 0) {
                            sq1 += (v0[0] * v0[0] + v0[1] * v0[1]) + (v0[2] * v0[2] + v0[3] * v0[3]) + (v1[0] * v1[0] + v1[1] * v1[1]) + (v1[2] * v1[2] + v1[3] * v1[3]);
                            *(u32x4*)(mla_a + (size_t)row * 384 + 256 + ct) = pack8(v0, v1);
                        } else {
                            if (wc == 2) { v0 = v0 * 0.0625f; v1 = v1 * 0.0625f; }
                            *(u32x4*)(misc + (size_t)row * 128 + ct0) = pack8(v0, v1);
                        }
                    }
                }
                if (tile == 10) { sq0 += xl::sxor<16>(sq0); sq0 = xl::hsum(sq0); if (fq == 0) ssq[(size_t)row * 4 + wc] = sq0; }
                if (tile == 11) { sq1 += xl::sxor<16>(sq1); sq1 = xl::hsum(sq1); if (fq == 0) sskv[(size_t)row * 4 + wc] = sq1; }
            }
        }
        if (tile == 8) {
#pragma unroll
            for (int bj = 0; bj < 2; ++bj)
#pragma unroll
                for (int e = 0; e < 8; ++e) { float s = ksum[bj][e]; s += xl::sxor<1>(s); s += xl::sxor<2>(s); s += xl::sxor<4>(s); s += xl::sxor<8>(s); ksum[bj][e] = s; }
            if (fr == 0) {
#pragma unroll
                for (int bj = 0; bj < 2; ++bj) { float* kp = kmp + (size_t)(u.pm * 2 + wr) * 256 + bj * HALF + wc * 32 + 8 * fq;
                    *(f32x4*)kp = (f32x4){ksum[bj][0], ksum[bj][1], ksum[bj][2], ksum[bj][3]}; *(f32x4*)(kp + 4) = (f32x4){ksum[bj][4], ksum[bj][5], ksum[bj][6], ksum[bj][7]}; }
            }
        }
    }
};

struct EpiMla {
    static constexpr bool PERM = true, AFTER_DRAIN = false;
    bf16_t* qm; bf16_t* kn; bf16_t* vm; const float* ssq; const float* sskv; const float* tm;
    __device__ __forceinline__ void operator()(const f32x4 (&acc)[2][2][4][2], const Unit& u, int wr, int wc, int fr, int fq) const {
        const int tile = u.pn;
        const int row0 = u.pm * BM + wr * 64 + fr;
        const float QS = 0.10206207261596575f * LOG2E;
#pragma unroll
        for (int ai = 0; ai < 2; ++ai)
#pragma unroll
            for (int m = 0; m < 4; ++m) {
                const int row = row0 + ai * HALF + m * 16;
                const int t = row & 8191;
                float rs;
                if (tile < 2) { const f32x4 p = *(const f32x4*)(ssq + (size_t)row * 4); rs = rsqrtf(((p[0] + p[1]) + (p[2] + p[3])) * (1.0f / 256.0f) + NORM_EPS) * QS; }
                else { const f32x4 p = *(const f32x4*)(sskv + (size_t)row * 4); rs = rsqrtf(((p[0] + p[1]) + (p[2] + p[3])) * (1.0f / 128.0f) + NORM_EPS); }
#pragma unroll
                for (int bj = 0; bj < 2; ++bj) {
                    const int ct = bj * HALF + wc * 32 + 8 * fq;
                    f32x4 v0 = acc[ai][bj][m][0] * rs, v1 = acc[ai][bj][m][1] * rs;
                    if (tile == 0) { *(u32x4*)(qm + (size_t)row * 384 + (ct >> 6) * 96 + (ct & 63)) = pack8(v0, v1); }
                    else if (tile == 1) {
                        if (bj == 0) { const int j0 = (ct & 31) >> 1; const f32x4 c4 = *(const f32x4*)(tm + t * 32 + j0), s4 = *(const f32x4*)(tm + t * 32 + 16 + j0); rot4(v0, v1, c4, s4);
                            *(u32x4*)(qm + (size_t)row * 384 + (ct >> 5) * 96 + 64 + (ct & 31)) = pack8(v0, v1); }
                    }
                    else if (tile == 2) { *(u32x4*)(kn + (size_t)row * 256 + ct) = pack8(v0, v1); }
                    else { *(u32x4*)(vm + (size_t)row * 256 + ct) = pack8(v0, v1); }
                }
            }
    }
};

struct EpiProj {
    static constexpr bool PERM = true, AFTER_DRAIN = false;
    bf16_t* proj; int nM;
    __device__ __forceinline__ void operator()(const f32x4 (&acc)[2][2][4][2], const Unit& u, int wr, int wc, int fr, int fq) const {
        const int n = u.pn >> 2, pn = u.pn & 3, pm = u.pm - n * nM;
        const int row0 = pm * BM + wr * 64 + fr;
#pragma unroll
        for (int ai = 0; ai < 2; ++ai)
#pragma unroll
            for (int m = 0; m < 4; ++m) {
                const int row = row0 + ai * HALF + m * 16;
#pragma unroll
                for (int bj = 0; bj < 2; ++bj) { const int ct = bj * HALF + wc * 32 + 8 * fq;
                    *(u32x4*)(proj + (size_t)row * 4096 + n * 1024 + pn * 256 + ct) = pack8(acc[ai][bj][m][0], acc[ai][bj][m][1]); }
            }
    }
};

struct EpiGate {
    static constexpr bool PERM = true, AFTER_DRAIN = false;
    const bf16_t* proj; bf16_t* merged; const float* ss; const float* bgate;
    __device__ __forceinline__ void operator()(const f32x4 (&acc)[2][2][4][2], const Unit& u, int wr, int wc, int fr, int fq) const {
        const int n = (u.pn - 12) >> 2, pd = (u.pn - 12) & 3;
        const int row0 = u.pm * BM + wr * 64 + fr;
        const int d0 = pd * 256 + wc * 32 + 8 * fq;
        f32x4 bg[2][2];
#pragma unroll
        for (int bj = 0; bj < 2; ++bj) { bg[bj][0] = *(const f32x4*)(bgate + n * 1024 + d0 + bj * HALF); bg[bj][1] = *(const f32x4*)(bgate + n * 1024 + d0 + bj * HALF + 4); }
#pragma unroll
        for (int ai = 0; ai < 2; ++ai)
#pragma unroll
            for (int mp = 0; mp < 2; ++mp) {
                u32x4 pr[2][2], mo[2][2]; float rs[2];
#pragma unroll
                for (int mm = 0; mm < 2; ++mm) {
                    const int row = row0 + ai * HALF + (2 * mp + mm) * 16;
#pragma unroll
                    for (int bj = 0; bj < 2; ++bj) {
                        pr[mm][bj] = *(const u32x4*)(proj + (size_t)row * 4096 + n * 1024 + d0 + bj * HALF);
                        if (n > 0) mo[mm][bj] = *(const u32x4*)(merged + (size_t)row * 1024 + d0 + bj * HALF); else mo[mm][bj] = (u32x4){0u, 0u, 0u, 0u};
                    }
                    rs[mm] = rsqrtf(row_total16(ss, row, fq) * (1.0f / 1024.0f) + NORM_EPS);
                }
#pragma unroll
                for (int mm = 0; mm < 2; ++mm) {
                    const int m = 2 * mp + mm; const int row = row0 + ai * HALF + m * 16;
#pragma unroll
                    for (int bj = 0; bj < 2; ++bj) {
                        f32x4 g0 = acc[ai][bj][m][0] * rs[mm] + bg[bj][0], g1 = acc[ai][bj][m][1] * rs[mm] + bg[bj][1];
#pragma unroll
                        for (int e = 0; e < 4; ++e) { g0[e] = __builtin_amdgcn_rcpf(1.0f + __builtin_amdgcn_exp2f(-g0[e] * LOG2E)); g1[e] = __builtin_amdgcn_rcpf(1.0f + __builtin_amdgcn_exp2f(-g1[e] * LOG2E)); }
                        const u32x4 p = pr[mm][bj], q = mo[mm][bj];
                        f32x4 v0 = g0 * (f32x4){bf_lo(p.x), bf_hi(p.x), bf_lo(p.y), bf_hi(p.y)}, v1 = g1 * (f32x4){bf_lo(p.z), bf_hi(p.z), bf_lo(p.w), bf_hi(p.w)};
                        v0 = v0 + (f32x4){bf_lo(q.x), bf_hi(q.x), bf_lo(q.y), bf_hi(q.y)}; v1 = v1 + (f32x4){bf_lo(q.z), bf_hi(q.z), bf_lo(q.w), bf_hi(q.w)};
                        *(u32x4*)(merged + (size_t)row * 1024 + d0 + bj * HALF) = pack8(v0, v1);
                    }
                }
            }
    }
};

struct EpiResid {
    static constexpr bool PERM = true, AFTER_DRAIN = false;
    const float* basef; bf16_t* xb; float* ss;
    __device__ __forceinline__ void operator()(const f32x4 (&acc)[2][2][4][2], const Unit& u, int wr, int wc, int fr, int fq) const {
        const int row0 = u.pm * BM + wr * 64 + fr, col0 = u.pn * BM + wc * 32 + 8 * fq;
#pragma unroll
        for (int ai = 0; ai < 2; ++ai) {
            u32x4 wb[4][2];
            if (!basef) {
#pragma unroll
                for (int m = 0; m < 4; ++m)
#pragma unroll
                    for (int bj = 0; bj < 2; ++bj) wb[m][bj] = *(const u32x4*)(xb + (size_t)(row0 + ai * HALF + m * 16) * 1024 + col0 + bj * HALF);
            }
#pragma unroll
            for (int m = 0; m < 4; ++m) {
                const int row = row0 + ai * HALF + m * 16;
                const size_t off = (size_t)row * 1024 + col0;
                float sq = 0.f;
#pragma unroll
                for (int bj = 0; bj < 2; ++bj) {
                    f32x4 b0, b1;
                    if (basef) { b0 = *(const f32x4*)(basef + off + bj * HALF); b1 = *(const f32x4*)(basef + off + bj * HALF + 4); }
                    else { const u32x4 w = wb[m][bj]; b0 = (f32x4){bf_lo(w.x), bf_hi(w.x), bf_lo(w.y), bf_hi(w.y)}; b1 = (f32x4){bf_lo(w.z), bf_hi(w.z), bf_lo(w.w), bf_hi(w.w)}; }
                    const f32x4 v0 = b0 + acc[ai][bj][m][0], v1 = b1 + acc[ai][bj][m][1];
                    sq += ((v0[0] * v0[0] + v0[1] * v0[1]) + (v0[2] * v0[2] + v0[3] * v0[3])) + ((v1[0] * v1[0] + v1[1] * v1[1]) + (v1[2] * v1[2] + v1[3] * v1[3]));
                    *(u32x4*)(xb + off + bj * HALF) = pack8(v0, v1);
                }
                sq += xl::sxor<16>(sq); sq = xl::hsum(sq);
                if (fq == 0) ss[(size_t)row * 16 + u.pn * 4 + wc] = sq;
            }
        }
    }
};

struct EpiUp {
    static constexpr bool PERM = true, AFTER_DRAIN = false;
    bf16_t* hid; const float* ss;
    __device__ __forceinline__ void operator()(const f32x4 (&acc)[2][2][4][2], const Unit& u, int wr, int wc, int fr, int fq) const {
        const int row0 = u.pm * BM + wr * 64 + fr;
        float rsv[2][4];
#pragma unroll
        for (int ai = 0; ai < 2; ++ai)
#pragma unroll
            for (int m = 0; m < 4; ++m) rsv[ai][m] = rsqrtf(row_total16(ss, row0 + ai * HALF + m * 16, fq) * (1.0f / 1024.0f) + NORM_EPS);
#pragma unroll
        for (int ai = 0; ai < 2; ++ai)
#pragma unroll
            for (int m = 0; m < 4; ++m) {
                const int row = row0 + ai * HALF + m * 16;
                const float rs = rsv[ai][m];
#pragma unroll
                for (int bj = 0; bj < 2; ++bj) { const int ct = bj * HALF + wc * 32 + 8 * fq;
                    f32x4 v0 = acc[ai][bj][m][0] * rs, v1 = acc[ai][bj][m][1] * rs;
#pragma unroll
                    for (int e = 0; e < 4; ++e) { const float a = fmaxf(v0[e], 0.f), b = fmaxf(v1[e], 0.f); v0[e] = a * a; v1[e] = b * b; }
                    *(u32x4*)(hid + (size_t)row * 4096 + u.pn * 256 + ct) = pack8(v0, v1); }
            }
    }
};

struct ProjOrder {
    int nM, G, c;
    __device__ bool next(int i, Unit& u) const { const long L = (long)i * G + c; if (L >= 16L * nM) return false; const int n = (int)(L / (4 * nM)), r = (int)(L % (4 * nM)); u.pm = n * nM + (r >> 2); u.pn = n * 4 + (r & 3); return true; }
    __device__ __forceinline__ void a_ready(const Unit&) const {}
    __device__ __forceinline__ void done(const Unit&) const {}
};
struct GateOrder {
    StaticOrder so;
    __device__ bool next(int i, Unit& u) const { Unit p; if (!so.next(i >> 2, p)) return false; u.pm = p.pm; u.pn = 12 + 4 * (i & 3) + p.pn; return true; }
    __device__ __forceinline__ void a_ready(const Unit&) const {}
    __device__ __forceinline__ void done(const Unit&) const {}
};
}

namespace mk {
#define GAS __attribute__((address_space(1)))
#define LAS __attribute__((address_space(3)))
typedef unsigned short bf16;
typedef unsigned v4u __attribute__((ext_vector_type(4)));
typedef unsigned v2u __attribute__((ext_vector_type(2)));
typedef float f32x4 __attribute__((ext_vector_type(4)));
typedef float f32x16 __attribute__((ext_vector_type(16)));
typedef short bf16x8 __attribute__((ext_vector_type(8)));
typedef short s16x4 __attribute__((ext_vector_type(4)));
typedef GAS unsigned gu32;
#define RLX_AGENT __ATOMIC_RELAXED, __HIP_MEMORY_SCOPE_AGENT
#define LDS_WAIT() asm volatile("s_waitcnt lgkmcnt(0)" ::: "memory")
#define VM_WAIT() asm volatile("s_waitcnt vmcnt(0)" ::: "memory")

constexpr int NWAVES = 8, NTHR = 512;
constexpr int S = 8192, D = 1024, FF = 4096, NIN = 7112, DEPTH = 2;
constexpr int C_DQ = 0, C_DK = 256, C_DV = 512, C_IQ = 768, C_IK = 1024, C_IW = 1056, C_SQ = 1064, C_SK = 1320, C_SV = 1576,
              C_MQ = 1832, C_MK = 2088, C_MV = 2344, C_CQ = 2600, C_CKV = 2856, C_KR = 2984, C_GATE = 3016;
constexpr float LOG2E = 1.4426950408889634f, LN2 = 0.6931471805599453f;

constexpr size_t MiB = 1u << 20;
constexpr size_t WS_CTL = 0, CTL_ZERO_BYTES = 256 * 1024;
constexpr size_t WS_TP = 1 * MiB, WS_TI = WS_TP + 512 * 1024, WS_TM = 2 * MiB;
constexpr size_t WS_SSA = 3 * MiB, WS_SSB = 4 * MiB, WS_SSQ = 5 * MiB, WS_SSKV = WS_SSQ + 256 * 1024, WS_KMP = WS_SSKV + 256 * 1024;
constexpr size_t WS_WIN = 6 * MiB, WS_WMLA = 20 * MiB, WS_WB = 21 * MiB, WS_WOUT = 23 * MiB, WS_WUP = 25 * MiB, WS_WDOWN = 33 * MiB;
constexpr size_t WS_XB = 41 * MiB;
constexpr size_t WS_ZT = 73 * MiB;
constexpr size_t WS_MLAA = 153 * MiB, WS_MISC = 165 * MiB, WS_QM = 169 * MiB, WS_KN = 181 * MiB, WS_VM = 189 * MiB;
constexpr size_t WS_BITS = 197 * MiB;
constexpr size_t WS_O4 = 213 * MiB;
constexpr size_t WS_PROJ = 73 * MiB;
constexpr size_t WS_MERGED = 213 * MiB;
constexpr size_t WS_HID = 73 * MiB;
constexpr size_t WS_PART = 153 * MiB, WS_LSE = 250 * MiB;
constexpr size_t WS_MLIST = 245 * MiB;
constexpr size_t WS_DSA2 = 185 * MiB, WS_LSED = 251 * MiB;
constexpr size_t WS_END = 252 * MiB;
constexpr int CW_TMO = 0, CW_BAR = 4096, CW_QUEUE = 8192, CW_MCNT = 13312;

constexpr int RING_OFF = 0, RING_BYTES = 131072;
constexpr int LDSCTL_OFF = RING_BYTES, MISC_OFF = LDSCTL_OFF + 320;
constexpr int AUX_OFF = LDSCTL_OFF + 1024;
constexpr int LDS_BYTES = 147456;

__device__ __forceinline__ unsigned f2bf(float f) { unsigned u = __builtin_bit_cast(unsigned, f); return (u + 0x7fffu + ((u >> 16) & 1u)) >> 16; }
__device__ __forceinline__ unsigned pk2(float lo, float hi) { return f2bf(lo) | (f2bf(hi) << 16); }
__device__ __forceinline__ float bf2f(unsigned short b) { return __uint_as_float((unsigned)b << 16); }

#define XB_TMO      128
#define XB_XCNT(j)  (256  + 64 * (j))
#define XB_XSUB(j)  (1280 + 64 * (j))
#define XB_XGEN(j)  (2304 + 64 * (j))
#define XB_TOP      3328
#define XB_TOPGEN   3392
#define XCD_BAR_WORDS 3456
#define XB_SPIN_CAP (1u << 18)
__device__ __forceinline__ unsigned xb_ld(unsigned* p)              { return __hip_atomic_load(p, __ATOMIC_RELAXED, __HIP_MEMORY_SCOPE_AGENT); }
__device__ __forceinline__ unsigned xb_add(unsigned* p, unsigned v) { return __hip_atomic_fetch_add(p, v, __ATOMIC_RELAXED, __HIP_MEMORY_SCOPE_AGENT); }
__device__ __forceinline__ unsigned xb_xcc_id() { return (unsigned)__builtin_amdgcn_s_getreg((3 << 11) | 20) & 0xFu; }
#define XB_SPIN(cond, bar) do { unsigned _sp = 0; while (cond) { __builtin_amdgcn_s_sleep(1); \
    if ((++_sp & 255u) == 0u) { if (xb_ld(&(bar)[XB_TMO])) break; if (_sp > XB_SPIN_CAP) { atomicAdd(&(bar)[XB_TMO], 1u); break; } } } } while (0)
struct XcdBarrier { unsigned* bar; unsigned x; volatile LAS unsigned* st; };
__device__ __forceinline__ XcdBarrier xcd_barrier_post(unsigned* bar, volatile LAS unsigned* st, bool leader) {
    XcdBarrier b; b.bar = bar; b.x = xb_xcc_id(); b.st = st;
    if (leader) (void)xb_add(&bar[XB_XCNT(b.x)], 1u);
    return b;
}
__device__ __forceinline__ void xcd_barrier_complete(unsigned* bar, unsigned x, unsigned& nloc, unsigned& nx) {
    const unsigned G = gridDim.x * gridDim.y * gridDim.z;
    unsigned sum, cnt, mine, sp = 0u;
    for (;;) {
        sum = 0u; cnt = 0u; mine = 0u;
#pragma unroll
        for (unsigned j = 0; j < 16; ++j) { const unsigned c = xb_ld(&bar[XB_XCNT(j)]); sum += c; cnt += (c > 0u) ? 1u : 0u; mine = (j == x) ? c : mine; }
        if (sum == G) break;
        __builtin_amdgcn_s_sleep(1);
        if ((++sp & 255u) == 0u) { if (xb_ld(&bar[XB_TMO])) break; if (sp > XB_SPIN_CAP) { atomicAdd(&bar[XB_TMO], 1u); break; } }
    }
    nloc = mine > 0u ? mine : 1u; nx = cnt > 0u ? cnt : 1u;
}
__device__ __forceinline__ void xcd_barrier(const XcdBarrier& b, bool leader) {
    asm volatile("s_waitcnt vmcnt(0)" ::: "memory");
    __syncthreads();
    if (leader) {
        unsigned* bar = b.bar;
        __builtin_amdgcn_s_waitcnt(0);
        unsigned nloc = b.st[0], nx = b.st[1];
        if (nloc == 0u) { xcd_barrier_complete(bar, b.x, nloc, nx); b.st[0] = nloc; b.st[1] = nx; }
        const unsigned old = xb_add(&bar[XB_XSUB(b.x)], 1u);
        const unsigned gen = old / nloc;
        if (old + 1u == (gen + 1u) * nloc) {
            __builtin_amdgcn_fence(__ATOMIC_RELEASE, "agent");
            asm volatile("s_waitcnt vmcnt(0)" ::: "memory");
            const unsigned og = xb_add(&bar[XB_TOP], 1u);
            const unsigned tg = og / nx;
            if (og + 1u == (tg + 1u) * nx) xb_add(&bar[XB_TOPGEN], 1u);
            else XB_SPIN(xb_ld(&bar[XB_TOPGEN]) == tg, bar);
            __builtin_amdgcn_fence(__ATOMIC_ACQUIRE, "agent");
            xb_add(&bar[XB_XGEN(b.x)], 1u);
            asm volatile("s_waitcnt vmcnt(0)" ::: "memory");
        } else {
            XB_SPIN(xb_ld(&bar[XB_XGEN(b.x)]) == gen, bar);
            __builtin_amdgcn_fence(__ATOMIC_ACQUIRE, "agent");
            asm volatile("s_waitcnt vmcnt(0)" ::: "memory");
        }
    }
    __syncthreads();
}

struct Ptrs {
    const float* in[14]; float* out; unsigned char* ws;
    int ph_lo, ph_hi, li, mrows;
};

__device__ __forceinline__ int unperm(int p, int R) { return p < R ? ((p & 1) ? (p >> 1) + (R >> 1) : (p >> 1)) : p; }
__device__ __forceinline__ int win_src(int n) {
    if (n >= 3072) return C_GATE + (n - 3072);
    const int tile = n >> 8, p = n & 255;
    switch (tile) {
        case 0: return C_DQ + (p & ~63) + unperm(p & 63, 16);
        case 1: return C_DK + (p & ~63) + unperm(p & 63, 16);
        case 2: return C_DV + p;
        case 3: return C_IQ + (p & ~31) + unperm(p & 31, 8);
        case 4: return C_SQ + p;
        case 5: return C_SK + p;
        case 6: return C_SV + p;
        case 7: return C_MQ + (p & ~63) + unperm(p & 63, 16);
        case 8: return C_MK + (p & ~63) + unperm(p & 63, 16);
        case 9: return C_MV + p;
        case 10: return C_CQ + p;
        default:
            if (p < 128) return C_CKV + p;
            if (p < 160) return C_KR + unperm(p - 128, 32);
            if (p < 192) return C_IK + unperm(p - 160, 8);
            if (p < 200) return C_IW + (p - 192);
            return -1;
    }
}
__device__ __forceinline__ void conv_item(const float* W, int ldw, int srccol, int k0, const float* gsc, bf16* WT, int ldk, int kout0, int n0, LAS float* scr, int lane) {
#pragma unroll 8
    for (int i = 0; i < 32; ++i) { const int kk = 2 * i + (lane >> 5);
        float v = 0.f;
        if (srccol >= 0) { v = W[(size_t)(k0 + kk) * ldw + srccol]; if (gsc) v *= gsc[k0 + kk]; }
        scr[kk * 33 + (lane & 31)] = v; }
    LDS_WAIT(); asm volatile("" ::: "memory");
    const int c = lane & 7;
#pragma unroll
    for (int j = 0; j < 4; ++j) { const int n = (lane >> 3) + 8 * j; const LAS float* s = scr + (8 * c) * 33 + n;
        v4u o; o.x = pk2(s[0 * 33], s[1 * 33]); o.y = pk2(s[2 * 33], s[3 * 33]); o.z = pk2(s[4 * 33], s[5 * 33]); o.w = pk2(s[6 * 33], s[7 * 33]);
        *(GAS v4u*)(WT + (size_t)(n0 + n) * ldk + kout0 + 8 * c) = o; }
    LDS_WAIT(); asm volatile("" ::: "memory");
}
__device__ __forceinline__ void conv_item_wide(const float* W, int ldw, int src0, int k0, const float* gsc, bf16* WT, int ldk, int kout0, int n0, LAS float* scr, int lane) {
    const int rr = lane >> 4, c4 = (lane & 15) * 4;
    f32x4 v[16];
#pragma unroll
    for (int i = 0; i < 16; ++i) v[i] = *(const GAS f32x4*)(W + (size_t)(k0 + 4 * i + rr) * ldw + src0 + c4);
#pragma unroll
    for (int i = 0; i < 16; ++i) { f32x4 t = v[i]; if (gsc) t = t * gsc[k0 + 4 * i + rr]; const int row = 4 * i + rr; *(LAS f32x4*)(scr + row * 64 + (c4 ^ (8 * ((row >> 3) & 7)))) = t; }
    LDS_WAIT(); asm volatile("" ::: "memory");
    const int c = lane & 7;
#pragma unroll
    for (int j = 0; j < 8; ++j) { const int n = (lane >> 3) + 8 * j; const LAS float* s = scr + (8 * c) * 64 + (n ^ (8 * c));
        v4u o; o.x = pk2(s[0 * 64], s[1 * 64]); o.y = pk2(s[2 * 64], s[3 * 64]); o.z = pk2(s[4 * 64], s[5 * 64]); o.w = pk2(s[6 * 64], s[7 * 64]);
        *(GAS v4u*)(WT + (size_t)(n0 + n) * ldk + kout0 + 8 * c) = o; }
    LDS_WAIT(); asm volatile("" ::: "memory");
}
__device__ __forceinline__ float wave_sum(float v) {
    v += xl::sxor<1>(v); v += xl::sxor<2>(v); v += xl::sxor<4>(v); v += xl::sxor<8>(v); v += xl::sxor<16>(v); v = xl::hsum(v);
    return v;
}
__device__ __forceinline__ void p0_convert(const Ptrs& P, LAS unsigned char* lds, int gw, int NGW, int wave, int lane) {
    unsigned char* ws = P.ws;
    const int nlay = (P.li < 0) ? 1 : DEPTH;
    for (int l = 0; l < nlay; ++l) {
    unsigned char* wb = (l == 0) ? ws + WS_WIN : (unsigned char*)P.out;
    LAS float* scr = (LAS float*)(lds + RING_OFF + wave * 16384);
    const float* w_in = P.in[2] + (size_t)l * D * NIN; const float* norm_mix = P.in[1] + l * D;
    const float* qn = P.in[4] + l * 256; const float* kvn = P.in[5] + l * 128;
    const float* w_uq = P.in[6] + (size_t)l * 256 * 384; const float* w_ukv = P.in[7] + (size_t)l * 128 * 512;
    const float* w_br = P.in[8] + (size_t)l * 4 * 256 * D; const float* w_out = P.in[9] + (size_t)l * D * D;
    const float* norm_mlp = P.in[10] + l * D; const float* w_up = P.in[11] + (size_t)l * D * FF; const float* w_down = P.in[12] + (size_t)l * FF * D;
    bf16* Win = (bf16*)wb; bf16* Wmla = (bf16*)(wb + (WS_WMLA - WS_WIN)); bf16* Wb = (bf16*)(wb + (WS_WB - WS_WIN)); bf16* Wout = (bf16*)(wb + (WS_WOUT - WS_WIN)); bf16* Wup = (bf16*)(wb + (WS_WUP - WS_WIN)); bf16* Wdown = (bf16*)(wb + (WS_WDOWN - WS_WIN));
    constexpr int I_IN = (D / 64) * (3072 / 32), I_MLA = (384 / 64) * (1024 / 32);
    constexpr int J_G = (D / 64) * (4096 / 64), J_B = (256 / 64) * (4096 / 64), J_OUT = (D / 64) * (D / 64), J_UP = (D / 64) * (FF / 64), J_DOWN = (FF / 64) * (D / 64);
    constexpr int NITEMS = I_IN + I_MLA + J_G + J_B + J_OUT + J_UP + J_DOWN;
    for (int it = gw; it < NITEMS; it += NGW) {
        int r = it;
        if (r < I_IN) { const int nb_ = 3072 / 32, kb = r / nb_, nblk = r % nb_; conv_item(w_in, NIN, win_src(nblk * 32 + (lane & 31)), kb * 64, norm_mix, Win, D, kb * 64, nblk * 32, scr, lane); continue; } r -= I_IN;
        if (r < I_MLA) { const int nb_ = 1024 / 32, kb = r / nb_, nblk = r % nb_; const int n = nblk * 32 + (lane & 31);
            int sc = -1; const float* W = w_uq; int ldw = 384; const float* g = qn; int ks = kb * 64;
            if (kb < 4) { if (n < 256) sc = (n >> 6) * 96 + (n & 63); else if (n < 384) sc = ((n - 256) >> 5) * 96 + 64 + unperm((n - 256) & 31, 32); }
            else { W = w_ukv; ldw = 512; g = kvn; ks = kb * 64 - 256; if (n >= 512 && n < 768) sc = ((n - 512) >> 6) * 128 + ((n - 512) & 63); else if (n >= 768) sc = ((n - 768) >> 6) * 128 + 64 + ((n - 768) & 63); }
            conv_item(W, ldw, sc, ks, g, Wmla, 384, kb * 64, nblk * 32, scr, lane); continue; } r -= I_MLA;
        if (r < J_G) { const int nb_ = 4096 / 64, kb = r / nb_, nblk = r % nb_; conv_item_wide(w_in, NIN, C_GATE + nblk * 64, kb * 64, norm_mix, Win, D, kb * 64, 3072 + nblk * 64, scr, lane); continue; } r -= J_G;
        if (r < J_B) { const int nb_ = 4096 / 64, kb = r / nb_, nblk = r % nb_; const int n = nblk * 64;
            conv_item_wide(w_br + (size_t)(n >> 10) * 256 * D, D, n & 1023, kb * 64, nullptr, Wb, 256, kb * 64, n, scr, lane); continue; } r -= J_B;
        if (r < J_OUT) { const int nb_ = D / 64, kb = r / nb_, nblk = r % nb_; conv_item_wide(w_out, D, nblk * 64, kb * 64, nullptr, Wout, D, kb * 64, nblk * 64, scr, lane); continue; } r -= J_OUT;
        if (r < J_UP) { const int nb_ = FF / 64, kb = r / nb_, nblk = r % nb_; conv_item_wide(w_up, FF, nblk * 64, kb * 64, norm_mlp, Wup, D, kb * 64, nblk * 64, scr, lane); continue; } r -= J_UP;
        { const int nb_ = D / 64, kb = r / nb_, nblk = r % nb_; conv_item_wide(w_down, D, nblk * 64, kb * 64, nullptr, Wdown, FF, kb * 64, nblk * 64, scr, lane); }
    }
    }
    {
        const int M = P.mrows;
        const float* x = P.in[0]; bf16* xb = (bf16*)(ws + WS_XB); float* ssa = (float*)(ws + WS_SSA);
        for (int m = gw; m < M; m += NGW) {
            const GAS f32x4* xr = (const GAS f32x4*)(x + (size_t)m * D) + lane;
            f32x4 v[4]; float s = 0.f;
#pragma unroll
            for (int j = 0; j < 4; ++j) { v[j] = xr[64 * j]; s += (v[j].x * v[j].x + v[j].y * v[j].y) + (v[j].z * v[j].z + v[j].w * v[j].w); }
            s = wave_sum(s);
            GAS unsigned long long* o8 = (GAS unsigned long long*)(xb + (size_t)m * D) + lane;
#pragma unroll
            for (int j = 0; j < 4; ++j) o8[64 * j] = (unsigned long long)pk2(v[j].x, v[j].y) | ((unsigned long long)pk2(v[j].z, v[j].w) << 32);
            if (lane < 16) ssa[(size_t)m * 16 + lane] = (lane == 0) ? s : 0.f;
        }
        float* tp = (float*)(ws + WS_TP); float* ti = (float*)(ws + WS_TI); float* tm = (float*)(ws + WS_TM);
        const int gt = gw * 64 + lane, NGT = NGW * 64;
        for (int e = gt; e < S * 28; e += NGT) {
            const int t = e / 28, j = e % 28;
            int nrot, jj; float* dst; int nh;
            if (j < 8) { nrot = 16; jj = j; dst = tp + t * 16; nh = 8; } else if (j < 12) { nrot = 8; jj = j - 8; dst = ti + t * 8; nh = 4; } else { nrot = 32; jj = j - 12; dst = tm + t * 32; nh = 16; }
            const float inv_freq = 1.0f / powf(500000.0f, (float)(2 * jj) / (float)nrot);
            const float ang = (float)t * inv_freq;
            dst[jj] = cosf(ang); dst[nh + jj] = sinf(ang);
        }
    }
}

__device__ __forceinline__ int crow(int r, int hh) { return (r & 3) + 8 * (r >> 2) + 4 * hh; }
typedef float f32x2_t __attribute__((ext_vector_type(2))); typedef __bf16 bf16x2_t __attribute__((ext_vector_type(2)));
__device__ __forceinline__ unsigned cvtpk(float lo, float hi) { f32x2_t v = {lo, hi}; bf16x2_t b = __builtin_convertvector(v, bf16x2_t); return __builtin_bit_cast(unsigned, b); }
typedef short v4i16_t __attribute__((ext_vector_type(4)));
__device__ __forceinline__ s16x4 vtr(const LAS unsigned char* p) { return __builtin_bit_cast(s16x4, __builtin_amdgcn_ds_read_tr16_b64_v4i16((LAS v4i16_t*)p)); }
__device__ __forceinline__ float ex2(float x) { return __builtin_amdgcn_exp2f(x); }
__device__ __forceinline__ float lg2(float x) { return __builtin_amdgcn_logf(x); }
#define MFMA32(a, b, c) __builtin_amdgcn_mfma_f32_32x32x16_bf16((a), (b), (c), 0, 0, 0)

constexpr int VSTR = 144;
constexpr int KSTR64 = 144, KSTR96 = 208;
constexpr int AT_KBUF = 0, AT_VBUF = 2 * 64 * KSTR96, AT_END = AT_VBUF + 3 * 64 * VSTR;
constexpr int AT_KM = AT_END;
constexpr int AX_UNIT = 0, AX_FLAG = 1, AX_SBF = 8  , AX_SPRE = 32, AX_SREM = 64, AX_SCNT = 96, AX_THR = 128, AX_TB = 160, AX_TREM = 192;

struct MixCtx {
    const bf16* zt; size_t zts;
    const bf16* misc; const bf16* qm; const bf16* kn; const bf16* vm; const float* kmp;
    unsigned* bits; bf16* o4; size_t o4s;
    unsigned* diag;
    unsigned short* mlist; unsigned* mcnt; bf16* part; float* lse; bf16* dsa2; float* lsed;
};
struct TileRegs { v4u k, kx, v; };
template <bool MLA> __device__ __forceinline__ void tile_load(TileRegs& tr, const bf16* Kg, const bf16* Xg, const bf16* Vg, size_t rowbase, int key0, int hcol, int tid) {
    const int row = tid >> 3, ch = tid & 7;
    tr.k = *(const v4u*)(Kg + (rowbase + key0 + row) * 256 + hcol + ch * 8);
    tr.v = *(const v4u*)(Vg + (rowbase + key0 + row) * 256 + hcol + ch * 8);
    if (MLA) { if (tid < 256) { const int r2 = tid >> 2, c2 = tid & 3; tr.kx = *(const v4u*)(Xg + (rowbase + key0 + r2) * 128 + c2 * 8); } }
}
template <bool MLA, int KSTR> __device__ __forceinline__ void tile_store(const TileRegs& tr, LAS unsigned char* Kb, LAS unsigned char* Vb, int tid) {
    const int row = tid >> 3, ch = tid & 7;
    *(LAS v4u*)(Kb + row * KSTR + ch * 16) = tr.k;
    *(LAS v4u*)(Vb + row * VSTR + ch * 16) = tr.v;
    if (MLA) { if (tid < 256) { const int r2 = tid >> 2, c2 = tid & 3; *(LAS v4u*)(Kb + r2 * KSTR + 128 + c2 * 16) = tr.kx; } }
}
template <int NKS, int KSTR> __device__ __forceinline__ void qk_tile(f32x16& s0, f32x16& s1, const LAS unsigned char* Kb, const bf16x8 (&qf)[NKS], int lane, const f32x16 cinit = (f32x16){}) {
    const LAS unsigned char* kp = Kb + (lane & 31) * KSTR + (lane >> 5) * 16;
    s0 = cinit; s1 = cinit;
#pragma unroll
    for (int ks = 0; ks < NKS; ++ks) {
        const bf16x8 a0 = *(const LAS bf16x8*)(kp + ks * 32), a1 = *(const LAS bf16x8*)(kp + 32 * KSTR + ks * 32);
        s0 = MFMA32(a0, qf[ks], s0); s1 = MFMA32(a1, qf[ks], s1);
    }
}
__device__ __forceinline__ bf16x8 packp(const f32x16& p, int b) {
    v4u w; w.x = cvtpk(p[b], p[b + 1]); w.y = cvtpk(p[b + 2], p[b + 3]); w.z = cvtpk(p[b + 4], p[b + 5]); w.w = cvtpk(p[b + 6], p[b + 7]);
    return __builtin_bit_cast(bf16x8, w);
}
__device__ __forceinline__ void pv_tile(f32x16& o0, f32x16& o1, const LAS unsigned char* Vb, const f32x16& p0, const f32x16& p1, int lane) {
    bf16x8 pb[4]; pb[0] = packp(p0, 0); pb[1] = packp(p0, 8); pb[2] = packp(p1, 0); pb[3] = packp(p1, 8);
    const int i = lane & 15, G = lane >> 4, hh = G >> 1;
    const LAS unsigned char* vp = Vb + (4 * hh + (i >> 2)) * VSTR + (16 * (G & 1) + 4 * (i & 3)) * 2;
#pragma unroll
    for (int kb = 0; kb < 2; ++kb)
#pragma unroll
        for (int s = 0; s < 2; ++s) {
            const LAS unsigned char* vq = vp + (kb * 32 + 16 * s) * VSTR;
            const s16x4 l0 = vtr(vq), h0 = vtr(vq + 8 * VSTR), l1 = vtr(vq + 64), h1 = vtr(vq + 8 * VSTR + 64);
            const bf16x8 f0 = (bf16x8){l0[0], l0[1], l0[2], l0[3], h0[0], h0[1], h0[2], h0[3]};
            const bf16x8 f1 = (bf16x8){l1[0], l1[1], l1[2], l1[3], h1[0], h1[1], h1[2], h1[3]};
            o0 = MFMA32(f0, pb[kb * 2 + s], o0); o1 = MFMA32(f1, pb[kb * 2 + s], o1);
        }
}
typedef float f32x2s __attribute__((ext_vector_type(2)));
constexpr float SM_THR = 6.0f;
__device__ __forceinline__ void softmax_tile(f32x16& s0, f32x16& s1, float& mref, bool& mset, f32x16& negm, float& l, f32x16& o0, f32x16& o1) {
    float mx = fmaxf(fmaxf(s0[0], s0[1]), s1[0]);
#pragma unroll
    for (int r = 1; r < 16; ++r) { mx = fmaxf(mx, s0[r]); if (r > 1) mx = fmaxf(mx, s1[r - 1]); }
    mx = fmaxf(mx, s1[15]); mx = fmaxf(mx, s1[0]);
    mx = xl::hmax(mx);
    float dl; const bool was_set = mset;
    if (!mset) { dl = (mx > -INFINITY) ? mx : 0.f; mset = mx > -INFINITY; } else dl = (mx > SM_THR) ? mx : 0.f;
    if (__any(dl != 0.f)) {
        const float alpha = was_set ? ex2(-dl) : 1.0f;
#pragma unroll
        for (int r = 0; r < 16; ++r) { s0[r] -= dl; s1[r] -= dl; o0[r] *= alpha; o1[r] *= alpha; }
        l *= alpha; mref += dl;
#pragma unroll
        for (int r = 0; r < 16; ++r) negm[r] = -mref;
    }
    f32x2s ps = {0.f, 0.f};
#pragma unroll
    for (int r = 0; r < 16; r += 2) { s0[r] = ex2(s0[r]); s0[r + 1] = ex2(s0[r + 1]); s1[r] = ex2(s1[r]); s1[r + 1] = ex2(s1[r + 1]); ps += (f32x2s){s0[r], s0[r + 1]}; ps += (f32x2s){s1[r], s1[r + 1]}; }
    l += ps.x + ps.y;
}
__device__ __forceinline__ void store_ot(bf16* O, size_t row, int hcol, const f32x16& o0, const f32x16& o1, float inv, int hh) {
#pragma unroll
    for (int g = 0; g < 4; ++g) {
        v2u w0, w1;
        w0.x = cvtpk(o0[4 * g] * inv, o0[4 * g + 1] * inv); w0.y = cvtpk(o0[4 * g + 2] * inv, o0[4 * g + 3] * inv);
        w1.x = cvtpk(o1[4 * g] * inv, o1[4 * g + 1] * inv); w1.y = cvtpk(o1[4 * g + 2] * inv, o1[4 * g + 3] * inv);
        *(v2u*)(O + row * 256 + hcol + 8 * g + 4 * hh) = w0;
        *(v2u*)(O + row * 256 + hcol + 32 + 8 * g + 4 * hh) = w1;
    }
}

#ifndef MK_ATTDRY
#define MK_ATTDRY 0
#endif
template <int KIND> __device__ __forceinline__ void softmax_unit(const MixCtx& C, int b, int h, int qb, LAS unsigned char* lds, const int wave0, const int dry = 0, const int half = -1) {
    const int dm = dry ? MK_ATTDRY : 0;
    constexpr bool MLA = (KIND == 0);
    constexpr int NKS = MLA ? 6 : 4, KSTR = MLA ? KSTR96 : KSTR64;
    int tid_ = (wave0 << 6) | xl::fresh_lane(); asm volatile("" : "+v"(tid_));
    const int tid = tid_, lane = tid & 63, r32 = lane & 31, hh = lane >> 5, wave = __builtin_amdgcn_readfirstlane(tid >> 6);
    const size_t rowbase = (size_t)b * S; const int q0 = qb * 256, qw = q0 + 32 * wave, t = qw + r32; const int hcol = h * 64;
    const bf16* Kg = MLA ? C.kn : (KIND == 1 ? C.zt + 1 * C.zts : C.zt + 8 * C.zts);
    const bf16* Vg = MLA ? C.vm : (KIND == 1 ? C.zt + 2 * C.zts : C.zt + 9 * C.zts);
    LAS unsigned char* Kb0 = lds + RING_OFF + AT_KBUF; LAS unsigned char* Vb0 = lds + RING_OFF + AT_VBUF;
    bf16x8 qf[NKS];
    if (MLA) {
#pragma unroll
        for (int ks = 0; ks < NKS; ++ks) qf[ks] = *(const bf16x8*)(C.qm + (rowbase + t) * 384 + h * 96 + 16 * ks + 8 * hh);
    } else {
        const bf16* Qg = (KIND == 1) ? C.zt : C.zt + 7 * C.zts;
#pragma unroll
        for (int ks = 0; ks < NKS; ++ks) qf[ks] = *(const bf16x8*)(Qg + (rowbase + t) * 256 + hcol + 16 * ks + 8 * hh);
    }
    const int NTall = 4 * qb + 4;
    const int jlo = (half == 1) ? NTall / 2 : 0, NT = (half == 0) ? NTall / 2 : NTall;
    TileRegs tr;
    tile_load<MLA>(tr, Kg, C.misc, Vg, rowbase, 64 * jlo, hcol, tid);
    unsigned selmask = 0u;
    if (KIND == 2) {
        LAS float* km = (LAS float*)(lds + RING_OFF + AT_KM);
        for (int e = tid; e < 32 * 64; e += NTHR) { const int n = e >> 6, d = e & 63; const float* p = C.kmp + (size_t)((b * 32 + n) * 2) * 256 + hcol + d; km[e] = (p[0] + p[256]) * (1.0f / 256.0f); }
        __syncthreads();
        float qv[32];
#pragma unroll
        for (int ks = 0; ks < 4; ++ks)
#pragma unroll
            for (int j = 0; j < 8; ++j) qv[ks * 8 + j] = bf2f((unsigned short)qf[ks][j]);
        float g0 = -INFINITY, g1 = -INFINITY, g2 = -INFINITY; int i0 = -1, i1 = -1, i2 = -1;
        for (int n = 0; n < qb; ++n) {
            const LAS float* kp = km + n * 64 + 8 * hh;
            float dot = 0.f;
#pragma unroll
            for (int ks = 0; ks < 4; ++ks) { const f32x4 a = *(const LAS f32x4*)(kp + 16 * ks), c = *(const LAS f32x4*)(kp + 16 * ks + 4);
                dot += qv[ks * 8 + 0] * a[0] + qv[ks * 8 + 1] * a[1] + qv[ks * 8 + 2] * a[2] + qv[ks * 8 + 3] * a[3] + qv[ks * 8 + 4] * c[0] + qv[ks * 8 + 5] * c[1] + qv[ks * 8 + 6] * c[2] + qv[ks * 8 + 7] * c[3]; }
            dot = xl::hsum(dot);
            if (dot > g0) { g2 = g1; i2 = i1; g1 = g0; i1 = i0; g0 = dot; i0 = n; }
            else if (dot > g1) { g2 = g1; i2 = i1; g1 = dot; i1 = n; }
            else if (dot > g2) { g2 = dot; i2 = n; }
        }
        if (i0 >= 0) selmask |= 1u << i0; if (i1 >= 0) selmask |= 1u << i1; if (i2 >= 0) selmask |= 1u << i2;
    }
    tile_store<MLA, KSTR>(tr, Kb0, Vb0, tid);
    __syncthreads();
    f32x16 o0 = {}, o1 = {}, negm = {}; float mref = 0.f, l = 0.f; bool mset = false;
    v2u wv_next = (v2u){0u, 0u};
    if (KIND == 1) wv_next = *(const v2u*)(C.bits + (rowbase + t) * 256 + 2 * jlo);
    const bool late = false;
    f32x16 c0 = {}, c1 = {}; bool cact = false;
    auto do_qk = [&](int j, const v2u wv, f32x16& s0, f32x16& s1) {
        qk_tile<NKS, KSTR>(s0, s1, Kb0 + ((j - jlo) & 1) * 64 * KSTR, qf, lane, negm);
        if (KIND == 1) {
            const unsigned w0 = wv.x >> (4 * hh), w1 = wv.y >> (4 * hh);
#pragma unroll
            for (int r = 0; r < 16; ++r) { const unsigned pos = (unsigned)((r & 3) + 8 * (r >> 2));
                const unsigned m0 = (unsigned)__builtin_amdgcn_sbfe((int)w0, pos, 1u), m1 = (unsigned)__builtin_amdgcn_sbfe((int)w1, pos, 1u);
                s0[r] = __uint_as_float((m0 & __float_as_uint(s0[r])) | (~m0 & 0xff800000u)); s1[r] = __uint_as_float((m1 & __float_as_uint(s1[r])) | (~m1 & 0xff800000u)); }
        } else {
            const bool past_blk = (KIND == 2) && ((j >> 2) < qb);
            if (past_blk) { if (!((selmask >> (j >> 2)) & 1u)) { s0 = s0 - INFINITY; s1 = s1 - INFINITY; } }
            else if (64 * j + 63 > qw) {
#pragma unroll
                for (int r = 0; r < 16; ++r) { const int kk = 64 * j + crow(r, hh); if (kk > t) s0[r] = -INFINITY; if (kk + 32 > t) s1[r] = -INFINITY; }
            }
        }
    };
    int vprev = 2 * 64 * VSTR, vcur = 0, vnext = 64 * VSTR;
    for (int j = jlo; j < NT; ++j) {
        if (j + 1 < NT && !(dm & 16)) tile_load<MLA>(tr, Kg, C.misc, Vg, rowbase, 64 * (j + 1), hcol, tid);
        v2u wv = wv_next;
        bool act = 64 * j <= qw + 31;
        if (KIND == 1) { if (64 * (j + 1) <= qw + 31) wv_next = *(const v2u*)(C.bits + (rowbase + t) * 256 + 2 * (j + 1));
                         if (act) act = __any((wv.x | wv.y) != 0u); }
        if (KIND == 2) { const int n = j >> 2; if (n < qb) act = __any((selmask >> n) & 1u); }
        if (!late) {
            if (act) { f32x16 s0, s1; if (dm & 8) { s0 = negm; s1 = negm; } else do_qk(j, wv, s0, s1); if (!(dm & 2)) softmax_tile(s0, s1, mref, mset, negm, l, o0, o1); if (!(dm & 4)) pv_tile(o0, o1, Vb0 + vcur, s0, s1, lane); else { o0 += s0; o1 += s1; } }
        } else {
            if (cact) { softmax_tile(c0, c1, mref, mset, negm, l, o0, o1); pv_tile(o0, o1, Vb0 + vprev, c0, c1, lane); }
            cact = act;
            if (act) do_qk(j, wv, c0, c1);
        }
        if (j + 1 < NT && !(dm & 16)) tile_store<MLA, KSTR>(tr, Kb0 + ((j + 1 - jlo) & 1) * 64 * KSTR, Vb0 + vnext, tid);
        __syncthreads();
        { const int tmp = vprev; vprev = vcur; vcur = vnext; vnext = tmp; }
    }
    if (late && cact) { softmax_tile(c0, c1, mref, mset, negm, l, o0, o1); pv_tile(o0, o1, Vb0 + vprev, c0, c1, lane); }
    __syncthreads();
    l = xl::hsum(l);
    const int branch = MLA ? 3 : (KIND == 1 ? 0 : 2);
    if (KIND == 1 && half >= 0) {
        const float inv = (l > 0.f) ? 1.0f / l : 0.f;
        store_ot(half == 0 ? C.o4 : C.dsa2, rowbase + t, hcol, o0, o1, inv, hh);
        if (hh == 0) C.lsed[((rowbase + t) * 4 + h) * 2 + half] = (l > 0.f) ? mref + lg2(l) : -INFINITY;
    } else
    if (!(dm & 1)) store_ot(C.o4 + branch * C.o4s, rowbase + t, hcol, o0, o1, 1.0f / l, hh);
    else { float x = l; for (int r = 0; r < 16; ++r) x += o0[r] + o1[r]; asm volatile("" :: "v"(x)); }
}

__device__ __forceinline__ float sb_block(f32x16& z, int kbase, int t, int hh, float cin) {
    float lf[16];
#pragma unroll
    for (int r = 0; r < 16; ++r) {
        const float zz = z[r]; const float e = ex2(-fabsf(zz) * LOG2E);
        const float sp = fmaxf(zz, 0.f) + lg2(1.0f + e) * LN2;
        lf[r] = (kbase + crow(r, hh) < t) ? -sp : 0.f;
    }
    float gs[4], pg[4];
#pragma unroll
    for (int g = 0; g < 4; ++g) { gs[g] = (lf[4 * g] + lf[4 * g + 1]) + (lf[4 * g + 2] + lf[4 * g + 3]); float lo_, hi_; xl::halves(gs[g], lo_, hi_); pg[g] = hh ? lo_ : hi_; }
    float run = 0.f;
#pragma unroll
    for (int g = 3; g >= 0; --g) {
        const float base = cin + run + (hh == 0 ? pg[g] : 0.f);
        const float l3 = base, l2 = l3 + lf[4 * g + 3], l1 = l2 + lf[4 * g + 2], l0 = l1 + lf[4 * g + 1];
        const float la[4] = {l0, l1, l2, l3};
#pragma unroll
        for (int e = 0; e < 4; ++e) { const int r = 4 * g + e; const bool past = kbase + crow(r, hh) < t; z[r] = past ? ex2((z[r] + lf[r] + la[e]) * LOG2E) : 0.f; }
        run += gs[g] + pg[g];
    }
    return run;
}
__device__ __forceinline__ void sb_unit(const MixCtx& C, int b, int h, int qb, LAS unsigned char* lds, const int wave0) {
    int tid_ = (wave0 << 6) | xl::fresh_lane(); asm volatile("" : "+v"(tid_));
    const int tid = tid_, lane = tid & 63, r32 = lane & 31, hh = lane >> 5, wave = __builtin_amdgcn_readfirstlane(tid >> 6);
    const size_t rowbase = (size_t)b * S; const int q0 = qb * 256, qw = q0 + 32 * wave, t = qw + r32; const int hcol = h * 64;
    const bf16* Qg = C.zt + 4 * C.zts; const bf16* Kg = C.zt + 5 * C.zts; const bf16* Vg = C.zt + 6 * C.zts;
    LAS unsigned char* Kb0 = lds + RING_OFF + AT_KBUF; LAS unsigned char* Vb0 = lds + RING_OFF + AT_VBUF;
    volatile LAS unsigned* aux = (volatile LAS unsigned*)(lds + AUX_OFF);
    bf16x8 qf[4];
#pragma unroll
    for (int ks = 0; ks < 4; ++ks) qf[ks] = *(const bf16x8*)(Qg + (rowbase + t) * 256 + hcol + 16 * ks + 8 * hh);
    const int NT = 4 * qb + 4;
    TileRegs tr;
    tile_load<false>(tr, Kg, nullptr, Vg, rowbase, 64 * (NT - 1), hcol, tid);
    tile_store<false, KSTR64>(tr, Kb0, Vb0, tid);
    __syncthreads();
    f32x16 o0 = {}, o1 = {}; float carry = 0.f;
    for (int it = 0; it < NT; ++it) {
        const int j = NT - 1 - it, cur = it & 1;
        if (j > 0) tile_load<false>(tr, Kg, nullptr, Vg, rowbase, 64 * (j - 1), hcol, tid);
        if (64 * j < qw + 31) {
            f32x16 s0, s1;
            qk_tile<4, KSTR64>(s0, s1, Kb0 + cur * 64 * KSTR64, qf, lane);
            const float b1 = sb_block(s1, 64 * j + 32, t, hh, carry);
            const float b0 = sb_block(s0, 64 * j, t, hh, carry + b1);
            carry += b1 + b0;
            pv_tile(o0, o1, Vb0 + cur * 64 * VSTR, s0, s1, lane);
        }
        const bool wdone = __all(carry < -110.0f);
        if (lane == 0) aux[AX_SBF + cur * 8 + wave] = wdone ? 1u : 0u;
        if (j > 0) tile_store<false, KSTR64>(tr, Kb0 + (cur ^ 1) * 64 * KSTR64, Vb0 + (cur ^ 1) * 64 * VSTR, tid);
        __syncthreads();
        unsigned alld = 1u;
#pragma unroll
        for (int w = 0; w < 8; ++w) alld &= aux[AX_SBF + cur * 8 + w];
        if (alld) break;
    }
    __syncthreads();
    store_ot(C.o4 + 1 * C.o4s, rowbase + t, hcol, o0, o1, 1.0f, hh);
}

__device__ __forceinline__ unsigned fkey(float f) { const int u = (int)__float_as_uint(f + 0.0f); return (unsigned)u ^ ((unsigned)(u >> 31) | 0x80000000u); }
__device__ __forceinline__ void idx_keys(unsigned (&key)[16], const bf16* misc, size_t rowbase, int kb, const bf16x8 (&qf)[16], const float (&w)[8], int r32, int hh) {
    const bf16* kr = misc + (rowbase + kb * 32 + r32) * 128 + 32 + 8 * hh;
    const bf16x8 k0 = *(const bf16x8*)kr, k1 = *(const bf16x8*)(kr + 16);
    float sc[16];
#pragma unroll
    for (int hd = 0; hd < 8; ++hd) {
        f32x16 s = MFMA32(k0, qf[2 * hd], (f32x16){});
        s = MFMA32(k1, qf[2 * hd + 1], s);
#pragma unroll
        for (int r = 0; r < 16; ++r) { const float v = fmaxf(s[r], 0.f); sc[r] = (hd == 0) ? w[0] * v : __builtin_fmaf(w[hd], v, sc[r]); }
        if (hd & 1) {
#pragma unroll
            for (int r = 0; r < 16; ++r) asm volatile("" : "+v"(sc[r]));
            __builtin_amdgcn_sched_barrier(0);
        }
    }
#pragma unroll
    for (int r = 0; r < 16; ++r) key[r] = fkey(sc[r]);
}
template <bool DESC, bool PEEK = false, bool RAW = false> __device__ __forceinline__ void hist_scan(volatile LAS unsigned* hist, int rowstride, int nbins, bool swz, int preshift, volatile LAS unsigned* aux, int tid) {
    const int q = tid >> 4, c = tid & 15, lane = tid & 63, wpc = nbins >> 5, sx = swz ? q : 0;
    unsigned csum = 0u;
    for (int i = 0; i < wpc; ++i) { const unsigned w = hist[q * rowstride + ((c * wpc + ((i + c) & (wpc - 1))) ^ sx)]; csum += (w & 0xffffu) + (w >> 16); }
    unsigned other = 0u;
#pragma unroll
    for (int k = 0; k < 16; ++k) { unsigned v; switch (k) { case 0: v = xl::bcast16<0>(csum); break; case 1: v = xl::bcast16<1>(csum); break; case 2: v = xl::bcast16<2>(csum); break; case 3: v = xl::bcast16<3>(csum); break; case 4: v = xl::bcast16<4>(csum); break; case 5: v = xl::bcast16<5>(csum); break; case 6: v = xl::bcast16<6>(csum); break; case 7: v = xl::bcast16<7>(csum); break; case 8: v = xl::bcast16<8>(csum); break; case 9: v = xl::bcast16<9>(csum); break; case 10: v = xl::bcast16<10>(csum); break; case 11: v = xl::bcast16<11>(csum); break; case 12: v = xl::bcast16<12>(csum); break; case 13: v = xl::bcast16<13>(csum); break; case 14: v = xl::bcast16<14>(csum); break; default: v = xl::bcast16<15>(csum); break; }
        if (RAW ? (c < 8 ? (k > c && k < 8) : (k < c)) : (DESC ? (k > c) : (k < c))) other += v; }
    const unsigned rem = aux[AX_SREM + q];
    if (other < rem && other + csum >= rem) {
        unsigned cum = other; bool found = false; unsigned bin = 0u, cnt = 0u;
        const bool dsc = RAW ? (c < 8) : DESC;
        for (int ii = 0; ii < wpc; ++ii) {
            const int i = dsc ? (wpc - 1 - ii) : ii;
            const unsigned w = hist[q * rowstride + ((c * wpc + i) ^ sx)];
            const unsigned first = dsc ? (w >> 16) : (w & 0xffffu), second = dsc ? (w & 0xffffu) : (w >> 16);
            if (!found) { if (cum + first >= rem) { found = true; bin = 2u * (unsigned)(c * wpc + i) + (dsc ? 1u : 0u); cnt = first; } else cum += first; }
            if (!found) { if (cum + second >= rem) { found = true; bin = 2u * (unsigned)(c * wpc + i) + (dsc ? 0u : 1u); cnt = second; } else cum += second; }
        }
        if (PEEK) { aux[AX_TB + q] = bin; }
        else {
        aux[AX_SPRE + q] = (aux[AX_SPRE + q] << preshift) | bin;
        aux[AX_SREM + q] = rem - cum; aux[AX_SCNT + q] = cnt;
        if (!DESC) { aux[AX_TB + q] = bin; aux[AX_TREM + q] = rem - cum; }
        }
    }
}
__device__ __forceinline__ void hist_zero(LAS unsigned char* lds, int tid) {
    LAS v4u* h4 = (LAS v4u*)(lds + RING_OFF);
    for (int i = tid; i < 8192; i += NTHR) h4[i] = (v4u){0u, 0u, 0u, 0u};
}
__device__ __forceinline__ void sel_unit_slow(const MixCtx& C, int b, int qg, LAS unsigned char* lds, const int wave0) {
    int tid_ = (wave0 << 6) | xl::fresh_lane(); asm volatile("" : "+v"(tid_));
    const int tid = tid_, lane = tid & 63, r32 = lane & 31, hh = lane >> 5, wave = __builtin_amdgcn_readfirstlane(tid >> 6);
    const size_t rowbase = (size_t)b * S; const int t = 32 * qg + r32;
    volatile LAS unsigned* hist = (volatile LAS unsigned*)(lds + RING_OFF);
    LAS unsigned* histw = (LAS unsigned*)(lds + RING_OFF);
    volatile LAS unsigned* aux = (volatile LAS unsigned*)(lds + AUX_OFF);
    bf16x8 qf[16]; float w[8];
    { const bf16* qp = C.zt + 3 * C.zts + (rowbase + t) * 256 + 8 * hh;
#pragma unroll
      for (int i = 0; i < 16; ++i) qf[i] = *(const bf16x8*)(qp + 16 * i);
      const v4u wr = *(const v4u*)(C.misc + (rowbase + t) * 128 + 64);
      w[0] = __uint_as_float(wr.x << 16); w[1] = __uint_as_float(wr.x & 0xffff0000u); w[2] = __uint_as_float(wr.y << 16); w[3] = __uint_as_float(wr.y & 0xffff0000u);
      w[4] = __uint_as_float(wr.z << 16); w[5] = __uint_as_float(wr.z & 0xffff0000u); w[6] = __uint_as_float(wr.w << 16); w[7] = __uint_as_float(wr.w & 0xffff0000u); }
    const int kb_last = 8 * (qg >> 3) + 7;
    if (tid < 32) { aux[AX_SPRE + tid] = 0u; aux[AX_SREM + tid] = 256u; aux[AX_SCNT + tid] = 0u; aux[AX_THR + tid] = 0u; aux[AX_TB + tid] = 0x7fffffffu; aux[AX_TREM + tid] = 0u; }
    if (tid == 0) aux[AX_FLAG] = 0u;
    if (qg >= 8) {
        for (int pass = 0; pass < 3; ++pass) {
            hist_zero(lds, tid);
            __syncthreads();
            const unsigned pre = aux[AX_SPRE + r32];
            for (int kb = wave; kb <= qg; kb += 8) {
                unsigned key[16];
                idx_keys(key, C.misc, rowbase, kb, qf, w, r32, hh);
#pragma unroll
                for (int r = 0; r < 16; ++r) {
                    const bool valid = kb * 32 + crow(r, hh) <= t;
                    const unsigned k = key[r];
                    bool match; unsigned bin;
                    if (pass == 0) { match = true; bin = k >> 21; } else if (pass == 1) { match = (k >> 21) == pre; bin = (k >> 10) & 2047u; } else { match = (k >> 10) == pre; bin = k & 1023u; }
                    if (valid && match) __hip_atomic_fetch_add(histw + r32 * 1024 + ((bin >> 1) ^ (unsigned)r32), 1u << (16 * (bin & 1u)), __ATOMIC_RELAXED, __HIP_MEMORY_SCOPE_WORKGROUP);
                }
            }
            __syncthreads();
            hist_scan<true>(hist, 1024, pass == 2 ? 1024 : 2048, true, pass == 2 ? 10 : 11, aux, tid);
            __syncthreads();
        }
        if (tid < 32) { aux[AX_THR + tid] = aux[AX_SPRE + tid]; if (aux[AX_SREM + tid] < aux[AX_SCNT + tid]) aux[AX_FLAG] = 1u; }
        __syncthreads();
        if (aux[AX_FLAG] != 0u) {
            hist_zero(lds, tid);
            __syncthreads();
            const unsigned thr = aux[AX_THR + r32];
            for (int kb = wave; kb <= qg; kb += 8) {
                unsigned key[16];
                idx_keys(key, C.misc, rowbase, kb, qf, w, r32, hh);
#pragma unroll
                for (int r = 0; r < 16; ++r) {
                    const int s = kb * 32 + crow(r, hh);
                    if (s <= t && key[r] == thr) { const unsigned bin = (unsigned)s >> 2; __hip_atomic_fetch_add(histw + r32 * 1024 + ((bin >> 1) ^ (unsigned)r32), 1u << (16 * (bin & 1u)), __ATOMIC_RELAXED, __HIP_MEMORY_SCOPE_WORKGROUP); }
                }
            }
            __syncthreads();
            hist_scan<false>(hist, 1024, 2048, true, 11, aux, tid);
            __syncthreads();
        }
    }
    __syncthreads();
    {
        const unsigned thr = aux[AX_THR + r32]; const unsigned tb = aux[AX_TB + r32], trem = aux[AX_TREM + r32];
        for (int kb = wave; kb <= kb_last; kb += 8) {
            unsigned word = 0u;
            if (kb <= qg) {
                unsigned key[16];
                idx_keys(key, C.misc, rowbase, kb, qf, w, r32, hh);
#pragma unroll
                for (int g = 0; g < 4; ++g) {
                    unsigned rank = 0u; const unsigned s4 = (unsigned)(kb * 8 + 2 * g + hh);
#pragma unroll
                    for (int e = 0; e < 4; ++e) {
                        const int r = 4 * g + e; const int s = kb * 32 + crow(r, hh);
                        const bool valid = s <= t; const unsigned k = key[r];
                        bool sel = valid && (k > thr);
                        if (valid && k == thr) { ++rank; sel = (s4 < tb) || (s4 == tb && rank <= trem); }
                        word |= (sel ? 1u : 0u) << crow(r, hh);
                    }
                }
            }
            word = xl::hor(word);
            if (hh == 0) C.bits[(rowbase + t) * 256 + kb] = word;
        }
    }
    __syncthreads();
}

constexpr int SL_CKEY = 0, SL_CIDX = 65536, SL_BITW = 98304;
constexpr int SL_SHIST = AUX_OFF + 2048;
constexpr int AX_CCNT = 224;
constexpr int SL_SAMP = SL_SHIST + 8192;
constexpr int SEL_RANK_MAX = 64;
__device__ __forceinline__ void idx_load(bf16x8& k0, bf16x8& k1, const bf16* misc, size_t rowbase, int kb, int r32, int hh) {
    const bf16* kr = misc + (rowbase + kb * 32 + r32) * 128 + 32 + 8 * hh; k0 = *(const bf16x8*)kr; k1 = *(const bf16x8*)(kr + 16);
}
typedef float f32x2v __attribute__((ext_vector_type(2)));
__device__ __forceinline__ float relu1(float x) { const int b = __float_as_int(x); return __int_as_float(b > 0 ? b : 0); }
__device__ __forceinline__ void idx_keys2(unsigned (&key)[16], const bf16x8 k0, const bf16x8 k1, const bf16x8 (&qf)[16], const float (&w)[8]) {
    f32x2v sc[8];
#pragma unroll
    for (int hd = 0; hd < 8; ++hd) {
        f32x16 s = MFMA32(k0, qf[2 * hd], (f32x16){});
        s = MFMA32(k1, qf[2 * hd + 1], s);
        const f32x2v w2 = {w[hd], w[hd]};
#pragma unroll
        for (int j = 0; j < 8; ++j) { const f32x2v v = {relu1(s[2 * j]), relu1(s[2 * j + 1])}; sc[j] = (hd == 0) ? v * w2 : __builtin_elementwise_fma(v, w2, sc[j]); }
        if (hd & 1) {
#pragma unroll
            for (int j = 0; j < 8; ++j) asm volatile("" : "+v"(sc[j]));
            __builtin_amdgcn_sched_barrier(0);
        }
    }
#pragma unroll
    for (int j = 0; j < 8; ++j) { key[2 * j] = fkey(sc[j].x); key[2 * j + 1] = fkey(sc[j].y); }
}
__device__ __forceinline__ void idx_keys3(unsigned (&key)[16], const bf16x8 k0, const bf16x8 k1, const bf16x8 (&qf)[16], const float (&w2)[8], const bf16x8 ql0, const bf16x8 ql1) {
    float sc[16];
    { f32x16 lin = MFMA32(k0, ql0, (f32x16){}); lin = MFMA32(k1, ql1, lin);
#pragma unroll
      for (int r = 0; r < 16; ++r) sc[r] = lin[r]; }
#pragma unroll
    for (int hd = 0; hd < 8; ++hd) {
        f32x16 s = MFMA32(k0, qf[2 * hd], (f32x16){});
        s = MFMA32(k1, qf[2 * hd + 1], s);
#pragma unroll
        for (int r = 0; r < 16; ++r) sc[r] = __builtin_fmaf(__builtin_fabsf(s[r]), w2[hd], sc[r]);
        if (hd & 1) {
#pragma unroll
            for (int r = 0; r < 16; ++r) asm volatile("" : "+v"(sc[r]));
            __builtin_amdgcn_sched_barrier(0);
        }
    }
#pragma unroll
    for (int r = 0; r < 16; ++r) key[r] = __float_as_uint(sc[r]);
}
__device__ __forceinline__ void idx_scores(float (&y)[16], const bf16x8 k0, const bf16x8 k1, const bf16x8 (&qf)[16], const float (&ws)[8], const bf16x8 ql0, const bf16x8 ql1, const float scale, const float off) {
    { f32x16 lin = MFMA32(k0, ql0, (f32x16){}); lin = MFMA32(k1, ql1, lin);
#pragma unroll
      for (int r = 0; r < 16; ++r) y[r] = __builtin_fmaf(lin[r], scale, off); }
#pragma unroll
    for (int hd = 0; hd < 8; ++hd) {
        f32x16 s = MFMA32(k0, qf[2 * hd], (f32x16){});
        s = MFMA32(k1, qf[2 * hd + 1], s);
#pragma unroll
        for (int r = 0; r < 16; ++r) y[r] = __builtin_fmaf(__builtin_fabsf(s[r]), ws[hd], y[r]);
        if (hd & 1) {
#pragma unroll
            for (int r = 0; r < 16; ++r) asm volatile("" : "+v"(y[r]));
            __builtin_amdgcn_sched_barrier(0);
        }
    }
}
__device__ __forceinline__ void hist_scan32(volatile LAS unsigned* hist, volatile LAS unsigned* aux, int tid) {
    const int q = tid >> 4, c = tid & 15;
    unsigned csum = 0u;
    for (int i = 0; i < 64; ++i) csum += hist[q * 1024 + c * 64 + ((i + 4 * c + q) & 63)];
    unsigned other = 0u;
#pragma unroll
    for (int k = 0; k < 16; ++k) { unsigned v; switch (k) { case 0: v = xl::bcast16<0>(csum); break; case 1: v = xl::bcast16<1>(csum); break; case 2: v = xl::bcast16<2>(csum); break; case 3: v = xl::bcast16<3>(csum); break; case 4: v = xl::bcast16<4>(csum); break; case 5: v = xl::bcast16<5>(csum); break; case 6: v = xl::bcast16<6>(csum); break; case 7: v = xl::bcast16<7>(csum); break; case 8: v = xl::bcast16<8>(csum); break; case 9: v = xl::bcast16<9>(csum); break; case 10: v = xl::bcast16<10>(csum); break; case 11: v = xl::bcast16<11>(csum); break; case 12: v = xl::bcast16<12>(csum); break; case 13: v = xl::bcast16<13>(csum); break; case 14: v = xl::bcast16<14>(csum); break; default: v = xl::bcast16<15>(csum); break; }
        if (k > c) other += v; }
    const unsigned rem = aux[AX_SREM + q];
    if (other < rem && other + csum >= rem) {
        unsigned cum = other; bool found = false; unsigned bin = 0u, cnt = 0u;
        for (int ii = 0; ii < 64; ++ii) {
            const int i = 63 - ii; const unsigned h = hist[q * 1024 + c * 64 + i];
            if (!found) { if (cum + h >= rem) { found = true; bin = (unsigned)(c * 64 + i); cnt = h; } else cum += h; }
        }
        aux[AX_SPRE + q] = bin; aux[AX_SREM + q] = rem - cum; aux[AX_SCNT + q] = cnt;
    }
}
#ifndef MK_SELDRY
#define MK_SELDRY 0
#endif
__device__ __forceinline__ void sel_unit(const MixCtx& C, int b, int qg, LAS unsigned char* lds, const int wave0, const int dry = 0) {
    const int dm = dry ? MK_SELDRY : 0;
    int tid_ = (wave0 << 6) | xl::fresh_lane(); asm volatile("" : "+v"(tid_));
    const int tid = tid_, lane = tid & 63, r32 = lane & 31, hh = lane >> 5, wave = __builtin_amdgcn_readfirstlane(tid >> 6);
    const size_t rowbase = (size_t)b * S; const int t = 32 * qg + r32;
    const int kb_last = 8 * (qg >> 3) + 7;
    LAS unsigned* histw = (LAS unsigned*)(lds + RING_OFF);
    volatile LAS unsigned* hist = (volatile LAS unsigned*)(lds + RING_OFF);
    volatile LAS unsigned* aux = (volatile LAS unsigned*)(lds + AUX_OFF);
    LAS unsigned* ckey = (LAS unsigned*)(lds + RING_OFF + SL_CKEY); LAS unsigned short* cidx = (LAS unsigned short*)(lds + RING_OFF + SL_CIDX);
    LAS unsigned* bitw = (LAS unsigned*)(lds + RING_OFF + SL_BITW); LAS unsigned* shist = (LAS unsigned*)(lds + SL_SHIST);
    LAS unsigned* auxw = (LAS unsigned*)(lds + AUX_OFF);
    if (qg < 8) {
        { const int q = tid >> 4, tq = 32 * qg + q;
          for (int kb = tid & 15; kb <= kb_last; kb += 16) { const int nbit = tq + 1 - 32 * kb; const unsigned word = nbit <= 0 ? 0u : (nbit >= 32 ? 0xffffffffu : ((1u << nbit) - 1u));
            if (!(dm & 1)) C.bits[(rowbase + tq) * 256 + kb] = word; } }
        return;
    }
    bf16x8 qf[16]; float w[8];
    { const bf16* qp = C.zt + 3 * C.zts + (rowbase + t) * 256 + 8 * hh;
#pragma unroll
      for (int i = 0; i < 16; ++i) qf[i] = *(const bf16x8*)(qp + 16 * i);
      const v4u wr = *(const v4u*)(C.misc + (rowbase + t) * 128 + 64);
      w[0] = __uint_as_float(wr.x << 16); w[1] = __uint_as_float(wr.x & 0xffff0000u); w[2] = __uint_as_float(wr.y << 16); w[3] = __uint_as_float(wr.y & 0xffff0000u);
      w[4] = __uint_as_float(wr.z << 16); w[5] = __uint_as_float(wr.z & 0xffff0000u); w[6] = __uint_as_float(wr.w << 16); w[7] = __uint_as_float(wr.w & 0xffff0000u); }
    float w2[8]; bf16x8 ql0, ql1;
    {
#pragma unroll
        for (int hd = 0; hd < 8; ++hd) w2[hd] = 0.5f * w[hd];
        float a0[8], a1[8];
#pragma unroll
        for (int j = 0; j < 8; ++j) { a0[j] = 0.f; a1[j] = 0.f; }
#pragma unroll
        for (int hd = 0; hd < 8; ++hd)
#pragma unroll
            for (int j = 0; j < 8; ++j) { a0[j] = __builtin_fmaf(w2[hd], bf2f((unsigned short)qf[2 * hd][j]), a0[j]); a1[j] = __builtin_fmaf(w2[hd], bf2f((unsigned short)qf[2 * hd + 1][j]), a1[j]); }
        v4u p0, p1; p0.x = cvtpk(a0[0], a0[1]); p0.y = cvtpk(a0[2], a0[3]); p0.z = cvtpk(a0[4], a0[5]); p0.w = cvtpk(a0[6], a0[7]);
        p1.x = cvtpk(a1[0], a1[1]); p1.y = cvtpk(a1[2], a1[3]); p1.z = cvtpk(a1[4], a1[5]); p1.w = cvtpk(a1[6], a1[7]);
        ql0 = __builtin_bit_cast(bf16x8, p0); ql1 = __builtin_bit_cast(bf16x8, p1);
    }
    if (tid < 32) { aux[AX_SPRE + tid] = 0u; aux[AX_SREM + tid] = 256u; aux[AX_SCNT + tid] = 0u; aux[AX_CCNT + tid] = 0u; aux[AX_TB + tid] = 0u; }
    if (tid == 0) aux[AX_FLAG] = 0u;
    hist_zero(lds, tid);
    {
        LAS float* samp = (LAS float*)(lds + SL_SAMP);
        bf16x8 k0, k1; idx_load(k0, k1, C.misc, rowbase, (wave * qg) >> 3, r32, hh);
        float y[16]; idx_scores(y, k0, k1, qf, w2, ql0, ql1, 1.0f, 0.0f);
        float mx = y[0], mn = mx;
#pragma unroll
        for (int r = 1; r < 16; ++r) { mx = fmaxf(mx, y[r]); mn = fminf(mn, y[r]); }
        mx = xl::hmax(mx); mn = -xl::hmax(-mn);
        if (hh == 0) { samp[wave * 32 + r32] = mx; samp[256 + wave * 32 + r32] = mn; }
    }
    __syncthreads();
    float scale, off;
    { const LAS float* samp = (const LAS float*)(lds + SL_SAMP);
      float hi = samp[r32], lo = samp[256 + r32];
#pragma unroll
      for (int wv = 1; wv < 8; ++wv) { hi = fmaxf(hi, samp[wv * 32 + r32]); lo = fminf(lo, samp[256 + wv * 32 + r32]); }
      const float range = hi - lo; const bool ok = range > 1e-30f && range < 1e30f;
      scale = ok ? 1023.0f / (1.28f * range) : 0.f; off = ok ? (0.03f * range - lo) * scale : 0.f;
#pragma unroll
      for (int hd = 0; hd < 8; ++hd) w2[hd] *= scale; }
    __builtin_amdgcn_sched_barrier(0);
    {
        bf16x8 k0, k1, n0 = {}, n1 = {};
        int kb = wave;
        LAS unsigned* hrow = histw + r32 * 1024;
        if (kb <= qg) idx_load(k0, k1, C.misc, rowbase, kb, r32, hh);
#pragma unroll 1
        for (; kb <= qg && !(dm & 16); kb += 8) {
            if (kb + 8 <= qg) idx_load(n0, n1, C.misc, rowbase, kb + 8, r32, hh);
            float y[16];
            idx_scores(y, k0, k1, qf, w2, ql0, ql1, scale, off);
            if (dm & 2) { float x = 0.f;
#pragma unroll
                for (int r = 0; r < 16; ++r) x += y[r];
                asm volatile("" :: "v"(x)); }
            else if (kb < qg) {
#pragma unroll
                for (int r = 0; r < 16; ++r) { const unsigned bin = (unsigned)__builtin_amdgcn_fmed3f(y[r], 0.f, 1023.f); __hip_atomic_fetch_add(hrow + bin, 1u, __ATOMIC_RELAXED, __HIP_MEMORY_SCOPE_WORKGROUP); }
            } else {
#pragma unroll
                for (int r = 0; r < 16; ++r) {
                    if (crow(r, hh) <= r32) { const unsigned bin = (unsigned)__builtin_amdgcn_fmed3f(y[r], 0.f, 1023.f); __hip_atomic_fetch_add(hrow + bin, 1u, __ATOMIC_RELAXED, __HIP_MEMORY_SCOPE_WORKGROUP); }
                }
            }
            k0 = n0; k1 = n1;
        }
    }
    __syncthreads();
    hist_scan32(hist, aux, tid);
    __syncthreads();
    if (tid < 32) { if (aux[AX_SCNT + tid] > 512u) aux[AX_FLAG] = 1u; }
    __syncthreads();
    if (aux[AX_FLAG] != 0u && !dm) {
#if defined(MK_DIAG_FALLBACKS) && MK_DIAG_FALLBACKS == 1
        if (tid == 0) atomicAdd((unsigned*)C.diag, 1u);
#endif
        __syncthreads(); sel_unit_slow(C, b, qg, lds, wave0); return; }
    const unsigned b1 = aux[AX_SPRE + r32];
    const float Ef = b1 < 1023u ? (float)(b1 + 1u) : INFINITY, Lf = b1 > 0u ? (float)b1 : -INFINITY;
    unsigned vmr = 0u;
#pragma unroll
    for (int r = 0; r < 16; ++r) vmr |= (crow(r, hh) <= r32 ? 1u : 0u) << r;
    __syncthreads();
    if (tid < 32) { aux[AX_SPRE + tid] = 0u; }
    {
        bf16x8 k0, k1, n0 = {}, n1 = {};
        int kb = wave;
        if (kb <= qg) idx_load(k0, k1, C.misc, rowbase, kb, r32, hh);
#pragma unroll 1
        for (; kb <= kb_last && !(dm & 4); kb += 8) {
            unsigned word = 0u;
            if (kb <= qg) {
                if (kb + 8 <= qg) idx_load(n0, n1, C.misc, rowbase, kb + 8, r32, hh);
                float y[16];
                idx_scores(y, k0, k1, qf, w2, ql0, ql1, scale, off);
                const bool diag = (kb == qg);
                unsigned def = 0u, cd = 0u;
#pragma unroll
                for (int r = 15; r >= 0; --r) { def += def + (y[r] >= Ef ? 1u : 0u); cd += cd + (y[r] >= Lf ? 1u : 0u); }
                unsigned cm = cd & ~def;
                word = ((def & 0xfu) | ((def & 0xf0u) << 4) | ((def & 0xf00u) << 8) | ((def & 0xf000u) << 12)) << (4 * hh);
                if (diag) { word &= (2u << r32) - 1u; cm &= vmr; }
                if (cm != 0u) {
                    unsigned pos = __hip_atomic_fetch_add(auxw + AX_CCNT + r32, (unsigned)__builtin_popcount(cm), __ATOMIC_RELAXED, __HIP_MEMORY_SCOPE_WORKGROUP);
#pragma unroll
                    for (int r = 0; r < 16; ++r) { if ((cm >> r) & 1u) { if (pos < 512u) { const unsigned u = __float_as_uint(y[r]); ckey[r32 * 512 + pos] = u ^ ((unsigned)((int)u >> 31) | 0x80000000u); cidx[r32 * 512 + pos] = (unsigned short)(8191 - (kb * 32 + crow(r, hh))); } ++pos; } }
                }
                k0 = n0; k1 = n1;
            }
            word = xl::hor(word);
            if (hh == 0) bitw[r32 * 256 + kb] = word;
        }
    }
    __syncthreads();
    if (tid < 32) { if (aux[AX_CCNT + tid] > (unsigned)SEL_RANK_MAX) aux[AX_FLAG] = 3u; }
    __syncthreads();
#if defined(MK_DIAG_FALLBACKS) && MK_DIAG_FALLBACKS == 2
    if (tid == 0 && aux[AX_FLAG] == 3u) atomicAdd((unsigned*)C.diag, 1u);
#endif
#if defined(MK_DIAG_FALLBACKS) && MK_DIAG_FALLBACKS == 3
    if (tid < 32) atomicAdd((unsigned*)C.diag, aux[AX_CCNT + tid]);
#endif
    if (aux[AX_FLAG] != 3u) {
        const int q = tid >> 4, c16 = tid & 15; const int cn = (dm & 8) ? 0 : (int)aux[AX_CCNT + q]; const unsigned rem = aux[AX_SREM + q];
        for (int i = c16; i < cn; i += 16) {
            const unsigned ki = ckey[q * 512 + i], vi = cidx[q * 512 + i];
            unsigned rank = 0u;
            for (int j = 0; j < cn; ++j) { const unsigned kj = ckey[q * 512 + j], vj = cidx[q * 512 + j]; rank += (kj > ki || (kj == ki && vj > vi)) ? 1u : 0u; }
            if (rank < rem) { const unsigned s = 8191u - vi; __hip_atomic_fetch_or(bitw + q * 256 + (s >> 5), 1u << (s & 31u), __ATOMIC_RELAXED, __HIP_MEMORY_SCOPE_WORKGROUP); }
        }
    } else {
        const int q = tid >> 4, c16 = tid & 15; int cn = (int)aux[AX_CCNT + q]; cn = cn > 512 ? 512 : cn;
        for (int pass = 0; pass < ((dm & 8) ? 0 : 7); ++pass) {
            for (int i = tid; i < 32 * 64; i += NTHR) shist[i] = 0u;
            __syncthreads();
            const unsigned pre = aux[AX_SPRE + q], thk = aux[AX_THR + q];
            for (int i = c16; i < cn; i += 16) {
                const unsigned ck = ckey[q * 512 + i], cv = cidx[q * 512 + i];
                bool match; unsigned bin;
                if (pass == 0) { match = true; bin = ck >> 28; } else if (pass < 5) { const int sh = 28 - 7 * pass; match = (ck >> (sh + 7)) == pre; bin = (ck >> sh) & 127u; }
                else if (pass == 5) { match = ck == thk; bin = cv >> 6; } else { match = (ck == thk) && ((cv >> 6) == pre); bin = cv & 63u; }
                if (match) __hip_atomic_fetch_add(shist + q * 64 + (bin >> 1), 1u << (16 * (bin & 1u)), __ATOMIC_RELAXED, __HIP_MEMORY_SCOPE_WORKGROUP);
            }
            __syncthreads();
            hist_scan<true>((volatile LAS unsigned*)shist, 64, pass == 6 ? 64 : 128, false, pass == 6 ? 6 : 7, aux, tid);
            __syncthreads();
            if (pass == 4) {
                if (tid < 32) { aux[AX_THR + tid] = aux[AX_SPRE + tid]; aux[AX_SPRE + tid] = 0u; if (aux[AX_SREM + tid] < aux[AX_SCNT + tid]) aux[AX_FLAG] = 2u; }
                __syncthreads();
                if (aux[AX_FLAG] != 2u) break;
            }
        }
        const unsigned thk = aux[AX_THR + q], thv = aux[AX_SPRE + q];
        for (int i = c16; i < cn; i += 16) {
            const unsigned ck = ckey[q * 512 + i], cv = cidx[q * 512 + i];
            if (ck > thk || (ck == thk && cv >= thv)) { const unsigned s = 8191u - cv; __hip_atomic_fetch_or(bitw + q * 256 + (s >> 5), 1u << (s & 31u), __ATOMIC_RELAXED, __HIP_MEMORY_SCOPE_WORKGROUP); }
        }
    }
    __syncthreads();
    if (!(dm & 1)) { const int q = tid >> 4; unsigned* bp = C.bits + (rowbase + 32 * qg + q) * 256; for (int kb = tid & 15; kb <= kb_last; kb += 16) __builtin_nontemporal_store(bitw[q * 256 + kb], bp + kb); }
    __syncthreads();
}

constexpr int MOBA_MAXL = 7936, MOBA_PARTS = 2;
__device__ __forceinline__ void moba_gate_unit(const MixCtx& C, int b, int h, int qb, LAS unsigned char* lds, const int wave0) {
    int tid_ = (wave0 << 6) | xl::fresh_lane(); asm volatile("" : "+v"(tid_));
    const int tid = tid_, lane = tid & 63, r32 = lane & 31, hh = lane >> 5, wave = __builtin_amdgcn_readfirstlane(tid >> 6);
    const size_t rowbase = (size_t)b * S; const int t = qb * 256 + 32 * wave + r32; const int hcol = h * 64;
    LAS float* km = (LAS float*)(lds + RING_OFF + AT_KM);
    for (int e = tid; e < 32 * 64; e += NTHR) { const int n = e >> 6, d = e & 63; const float* p = C.kmp + (size_t)((b * 32 + n) * 2) * 256 + hcol + d; km[e] = (p[0] + p[256]) * (1.0f / 256.0f); }
    __syncthreads();
    float qv[32];
    { const bf16* Qg = C.zt + 7 * C.zts;
#pragma unroll
      for (int ks = 0; ks < 4; ++ks) { const bf16x8 q8 = *(const bf16x8*)(Qg + (rowbase + t) * 256 + hcol + 16 * ks + 8 * hh);
#pragma unroll
          for (int j = 0; j < 8; ++j) qv[ks * 8 + j] = bf2f((unsigned short)q8[j]); } }
    float g0 = -INFINITY, g1 = -INFINITY, g2 = -INFINITY; int i0 = -1, i1 = -1, i2 = -1;
    for (int n = 0; n < qb; ++n) {
        const LAS float* kp = km + n * 64 + 8 * hh;
        float dot = 0.f;
#pragma unroll
        for (int ks = 0; ks < 4; ++ks) { const f32x4 a4 = *(const LAS f32x4*)(kp + 16 * ks), c4 = *(const LAS f32x4*)(kp + 16 * ks + 4);
            dot += qv[ks * 8 + 0] * a4[0] + qv[ks * 8 + 1] * a4[1] + qv[ks * 8 + 2] * a4[2] + qv[ks * 8 + 3] * a4[3] + qv[ks * 8 + 4] * c4[0] + qv[ks * 8 + 5] * c4[1] + qv[ks * 8 + 6] * c4[2] + qv[ks * 8 + 7] * c4[3]; }
        dot = xl::hsum(dot);
        if (dot > g0) { g2 = g1; i2 = i1; g1 = g0; i1 = i0; g0 = dot; i0 = n; }
        else if (dot > g1) { g2 = g1; i2 = i1; g1 = dot; i1 = n; }
        else if (dot > g2) { g2 = dot; i2 = n; }
    }
    if (hh == 0) {
        const int sel[3] = {i0, i1, i2};
#pragma unroll
        for (int j = 0; j < 3; ++j) {
            if (sel[j] >= 0) { unsigned* cp = C.mcnt + (b * 4 + h) * 32 + sel[j]; const unsigned pos = atomicAdd(cp, 1u);
                if (pos < (unsigned)MOBA_MAXL) C.mlist[((size_t)((b * 4 + h) * 32 + sel[j])) * MOBA_MAXL + pos] = (unsigned short)(t | (j << 13)); }
            else C.lse[(rowbase + t) * 16 + h * 4 + j] = -INFINITY;
        }
    }
    __syncthreads();
}
__device__ __forceinline__ void moba_blk_unit(const MixCtx& C, int b, int h, int n, int p, bool own, LAS unsigned char* lds, const int wave0) {
    int tid_ = (wave0 << 6) | xl::fresh_lane(); asm volatile("" : "+v"(tid_));
    const int tid = tid_, lane = tid & 63, r32 = lane & 31, hh = lane >> 5, wave = __builtin_amdgcn_readfirstlane(tid >> 6);
    const size_t rowbase = (size_t)b * S; const int hcol = h * 64;
    const int len = own ? 256 : (int)min(C.mcnt[(b * 4 + h) * 32 + n], (unsigned)MOBA_MAXL);
    if (p * 256 >= len) return;
    const bf16* Qg = C.zt + 7 * C.zts; const bf16* Kg = C.zt + 8 * C.zts; const bf16* Vg = C.zt + 9 * C.zts;
    LAS unsigned char* Kb = lds + RING_OFF; LAS unsigned char* Vb = lds + RING_OFF + 256 * KSTR64;
    const unsigned short* lp = C.mlist + ((size_t)((b * 4 + h) * 32 + n)) * MOBA_MAXL;
    unsigned ent_n = 0u; { const int e0 = p * 256 + 32 * wave + r32; if (!own && e0 < len) ent_n = (unsigned)lp[e0]; }
    { v4u kr[4], vr[4];
#pragma unroll
      for (int i = 0; i < 4; ++i) { const int e = tid + i * NTHR, row = e >> 3, ch = e & 7; kr[i] = *(const v4u*)(Kg + (rowbase + n * 256 + row) * 256 + hcol + ch * 8); vr[i] = *(const v4u*)(Vg + (rowbase + n * 256 + row) * 256 + hcol + ch * 8); }
#pragma unroll
      for (int i = 0; i < 4; ++i) { const int e = tid + i * NTHR, row = e >> 3, ch = e & 7; *(LAS v4u*)(Kb + row * KSTR64 + ch * 16) = kr[i]; *(LAS v4u*)(Vb + row * VSTR + ch * 16) = vr[i]; } }
    bf16x8 qn[4];
    { const int tq0 = own ? n * 256 + 32 * wave + r32 : (int)(ent_n & 8191u);
#pragma unroll
      for (int ks = 0; ks < 4; ++ks) qn[ks] = *(const bf16x8*)(Qg + (rowbase + tq0) * 256 + hcol + 16 * ks + 8 * hh); }
    __syncthreads();
    for (int c = p; c * 256 < len; c += MOBA_PARTS) {
        const int e = c * 256 + 32 * wave + r32; const bool valid = e < len;
        int tq, slot;
        if (own) { tq = n * 256 + e; slot = 3; } else { tq = (int)(ent_n & 8191u); slot = (int)(ent_n >> 13); }
        bf16x8 qf[4];
#pragma unroll
        for (int ks = 0; ks < 4; ++ks) qf[ks] = qn[ks];
        if ((c + MOBA_PARTS) * 256 < len) {
            const int e2 = (c + MOBA_PARTS) * 256 + 32 * wave + r32; ent_n = (e2 < len) ? (unsigned)lp[e2] : 0u;
            const int tq2 = (int)(ent_n & 8191u);
#pragma unroll
            for (int ks = 0; ks < 4; ++ks) qn[ks] = *(const bf16x8*)(Qg + (rowbase + tq2) * 256 + hcol + 16 * ks + 8 * hh);
        }
        f32x16 o0 = {}, o1 = {}, negm = {}; float mref = 0.f, l = 0.f; bool mset = false;
#pragma unroll 1
        for (int i = 0; i < 4; ++i) {
            if (own && 64 * i > 32 * wave + 31) break;
            f32x16 s0, s1;
            qk_tile<4, KSTR64>(s0, s1, Kb + i * 64 * KSTR64, qf, lane, negm);
            if (own && 64 * i + 63 > 32 * wave) {
#pragma unroll
                for (int r = 0; r < 16; ++r) { const int kk = n * 256 + 64 * i + crow(r, hh); if (kk > tq) s0[r] = -INFINITY; if (kk + 32 > tq) s1[r] = -INFINITY; }
            }
            softmax_tile(s0, s1, mref, mset, negm, l, o0, o1);
            pv_tile(o0, o1, Vb + i * 64 * VSTR, s0, s1, lane);
        }
        l = xl::hsum(l);
        if (valid) {
            const float inv = 1.0f / l;
            bf16* op = C.part + ((rowbase + tq) * 16 + h * 4 + slot) * 64;
#pragma unroll
            for (int g = 0; g < 4; ++g) {
                v2u w0, w1;
                w0.x = cvtpk(o0[4 * g] * inv, o0[4 * g + 1] * inv); w0.y = cvtpk(o0[4 * g + 2] * inv, o0[4 * g + 3] * inv);
                w1.x = cvtpk(o1[4 * g] * inv, o1[4 * g + 1] * inv); w1.y = cvtpk(o1[4 * g + 2] * inv, o1[4 * g + 3] * inv);
                *(v2u*)(op + 8 * g + 4 * hh) = w0; *(v2u*)(op + 32 + 8 * g + 4 * hh) = w1;
            }
            if (hh == 0) C.lse[(rowbase + tq) * 16 + h * 4 + slot] = mref + lg2(l);
        }
    }
    __syncthreads();
}

#ifndef MK_REPEAT_LP
#define MK_REPEAT_LP -1
#endif
#ifndef MK_REPEAT_KINDS
#define MK_REPEAT_KINDS 15
#endif
#ifndef MK_REPEAT_LAYERS
#define MK_REPEAT_LAYERS 3
#endif
#ifndef MK_REPEAT_CONV
#define MK_REPEAT_CONV 0
#endif
#ifndef MK_EXTRA_BARRIERS
#define MK_EXTRA_BARRIERS 0
#endif
#ifndef MK_ONLY
#define MK_ONLY -1
#endif
#ifndef MK_SKIPMASK
#define MK_SKIPMASK 0
#endif
#define PHON(x) ((MK_ONLY < 0 || MK_ONLY == (x)) && !((MK_SKIPMASK >> (x)) & 1))
#ifndef MK_MIXONLY
#define MK_MIXONLY -1
#endif
#define MIXON(x) (MK_MIXONLY < 0 || MK_MIXONLY == (x))
constexpr int PH_CONV0 = 0, PH_L0 = 1, PH_CONV1 = 10, PH_L1 = 11, PH_FINAL = 20, N_PHASES = 21, PH_MERGE0 = 21, PH_MERGE1 = 22;
constexpr int LP_INPROJ = 0, LP_MLA = 1, LP_MIX = 2, LP_DSA = 3, LP_PROJ = 4, LP_GATE = 5, LP_OUT = 6, LP_UP = 7, LP_DOWN = 8;


#define P_WIN ((bf16*)(wbase + (WS_WIN - WS_WIN)))
#define P_WMLA ((bf16*)(wbase + (WS_WMLA - WS_WIN)))
#define P_WB ((bf16*)(wbase + (WS_WB - WS_WIN)))
#define P_WOUT ((bf16*)(wbase + (WS_WOUT - WS_WIN)))
#define P_WUP ((bf16*)(wbase + (WS_WUP - WS_WIN)))
#define P_WDOWN ((bf16*)(wbase + (WS_WDOWN - WS_WIN)))
#define P_XB    ((bf16*)(ws + WS_XB))
#define P_ZT    ((bf16*)(ws + WS_ZT))
#define P_MLAA  ((bf16*)(ws + WS_MLAA))
#define P_MISC  ((bf16*)(ws + WS_MISC))
#define P_QM    ((bf16*)(ws + WS_QM))
#define P_KN    ((bf16*)(ws + WS_KN))
#define P_VM    ((bf16*)(ws + WS_VM))
#define P_BITS  ((unsigned*)(ws + WS_BITS))
#define P_O4    ((bf16*)(ws + WS_O4))
#define P_PROJ  ((bf16*)(ws + WS_PROJ))
#define P_DSA2  ((bf16*)(ws + WS_DSA2))
#define P_LSED  ((float*)(ws + WS_LSED))
#define P_MERGED ((bf16*)(ws + WS_MERGED))
#define P_HID   ((bf16*)(ws + WS_HID))
#define P_SSA   ((float*)(ws + WS_SSA))
#define P_SSB   ((float*)(ws + WS_SSB))
#define P_SSQ   ((float*)(ws + WS_SSQ))
#define P_SSKV  ((float*)(ws + WS_SSKV))
#define P_KMP   ((float*)(ws + WS_KMP))
#define P_TP    ((const float*)(ws + WS_TP))
#define P_TI    ((const float*)(ws + WS_TI))
#define P_TM    ((const float*)(ws + WS_TM))

__device__ __forceinline__ int next_unit(gu32* ctr, volatile LAS unsigned* aux, int tid) {
    if (tid == 0) aux[AX_UNIT] = __hip_atomic_fetch_add(ctr, 1u, RLX_AGENT);
    __syncthreads();
    const int u = (int)aux[AX_UNIT];
    __syncthreads();
    return u;
}

template <int ph> __device__ __forceinline__ void run_phase(const Ptrs& P, LAS unsigned char* lds, gu32* ctl, int G, int bx, int vcu, const int wave0) {
    volatile LAS unsigned* aux = (volatile LAS unsigned*)(lds + AUX_OFF);
    const int M = P.mrows, nb = M / S;
    const int NGW = G * NWAVES;
    {
        unsigned char* ws = P.ws;
        unsigned char* wbase = (ph >= PH_L1) ? (unsigned char*)P.out : ws + WS_WIN;
        (void)wbase;
        const size_t zts = (size_t)M * 256;
        if (ph == PH_MERGE0 || ph == PH_MERGE1) {
            int tid_ = (wave0 << 6) | xl::fresh_lane(); asm volatile("" : "+v"(tid_)); const int tid = tid_, lane = tid & 63, wave = __builtin_amdgcn_readfirstlane(tid >> 6), gw = vcu * NWAVES + wave;
            const bf16* part = (const bf16*)(ws + WS_PART); const float* lse = (const float*)(ws + WS_LSE); bf16* oc = P_O4 + 2 * zts;
            const int head = lane >> 4, d0 = (lane & 15) * 4;
            for (int m = gw; m < M; m += NGW) {
                const f32x4 L4 = *(const f32x4*)(lse + (size_t)m * 16 + head * 4);
                const float mx = fmaxf(fmaxf(L4[0], L4[1]), fmaxf(L4[2], L4[3]));
                float wsum = 0.f; f32x4 acc = {0.f, 0.f, 0.f, 0.f};
#pragma unroll
                for (int j = 0; j < 4; ++j) { const float w = __builtin_amdgcn_exp2f(L4[j] - mx);
                    if (w > 0.f) { const v2u pv = *(const v2u*)(part + ((size_t)m * 16 + head * 4 + j) * 64 + d0);
                        acc = acc + w * (f32x4){__uint_as_float(pv.x << 16), __uint_as_float(pv.x & 0xffff0000u), __uint_as_float(pv.y << 16), __uint_as_float(pv.y & 0xffff0000u)}; wsum += w; } }
                const float inv = 1.0f / wsum;
                v2u o; o.x = pk2(acc[0] * inv, acc[1] * inv); o.y = pk2(acc[2] * inv, acc[3] * inv);
                *(v2u*)(oc + (size_t)m * 256 + head * 64 + d0) = o;
                {
                    const float la = P_LSED[((size_t)m * 4 + head) * 2], lb = P_LSED[((size_t)m * 4 + head) * 2 + 1];
                    if (lb > -INFINITY) {
                        bf16* oa = P_O4 + (size_t)m * 256 + head * 64 + d0; const bf16* ob = P_DSA2 + (size_t)m * 256 + head * 64 + d0;
                        const float mm = fmaxf(la, lb), wa = __builtin_amdgcn_exp2f(la - mm), wb = __builtin_amdgcn_exp2f(lb - mm), iv = 1.0f / (wa + wb);
                        const v2u pa = *(const v2u*)oa, pb = *(const v2u*)ob;
                        const f32x4 va = {__uint_as_float(pa.x << 16), __uint_as_float(pa.x & 0xffff0000u), __uint_as_float(pa.y << 16), __uint_as_float(pa.y & 0xffff0000u)};
                        const f32x4 vb = {__uint_as_float(pb.x << 16), __uint_as_float(pb.x & 0xffff0000u), __uint_as_float(pb.y << 16), __uint_as_float(pb.y & 0xffff0000u)};
                        const f32x4 r4 = (va * wa + vb * wb) * iv;
                        v2u o2; o2.x = pk2(r4[0], r4[1]); o2.y = pk2(r4[2], r4[3]);
                        *(v2u*)oa = o2;
                    }
                }
            }
        } else if (PHON(9) && ph == PH_CONV0) {
            int tid_ = (wave0 << 6) | xl::fresh_lane(); asm volatile("" : "+v"(tid_)); const int tid = tid_, lane = tid & 63, wave = __builtin_amdgcn_readfirstlane(tid >> 6), gw = vcu * NWAVES + wave; (void)lane; (void)gw;
            p0_convert(P, lds, gw, NGW, wave, lane);
        } else if (ph == PH_CONV1) {
        } else if (PHON(10) && ph == PH_FINAL) {
            int tid_ = (wave0 << 6) | xl::fresh_lane(); asm volatile("" : "+v"(tid_)); const int tid = tid_, lane = tid & 63, wave = __builtin_amdgcn_readfirstlane(tid >> 6), gw = vcu * NWAVES + wave; (void)lane; (void)gw;
            const float* gf = P.in[13];
            for (int m = gw; m < M; m += NGW) {
                const f32x4 pa = *(const f32x4*)(P_SSA + (size_t)m * 16 + 4 * (lane & 3));
                float s = (pa[0] + pa[1]) + (pa[2] + pa[3]); s += xl::sxor<1>(s); s += xl::sxor<2>(s);
                const float rs = rsqrtf(s * (1.0f / 1024.0f) + 1e-6f);
                const bf16* xr = P_XB + (size_t)m * D; float* orow = P.out + (size_t)m * D;
#pragma unroll
                for (int j = 0; j < 2; ++j) { const int c = 512 * j + 8 * lane; const v4u w = *(const v4u*)(xr + c);
                    const f32x4 g0 = *(const f32x4*)(gf + c), g1 = *(const f32x4*)(gf + c + 4);
                    f32x4 o0 = {__uint_as_float(w.x << 16), __uint_as_float(w.x & 0xffff0000u), __uint_as_float(w.y << 16), __uint_as_float(w.y & 0xffff0000u)};
                    f32x4 o1 = {__uint_as_float(w.z << 16), __uint_as_float(w.z & 0xffff0000u), __uint_as_float(w.w << 16), __uint_as_float(w.w & 0xffff0000u)};
                    *(f32x4*)(orow + c) = o0 * rs * g0; *(f32x4*)(orow + c + 4) = o1 * rs * g1; }
            }
#ifdef MK_DIAG_FALLBACKS
            if (gw == 0 && lane == 0) { const unsigned cnt = __hip_atomic_load(ctl + 12288, RLX_AGENT); if (cnt) { asm volatile("s_waitcnt vmcnt(0)" ::: "memory"); P.out[0] = sqrtf((float)cnt * (float)M * 1024.0f * 1.0025f); } }
#endif
        } else {
            const int l = (ph >= PH_L1) ? 1 : 0, lp = ph - (l ? PH_L1 : PH_L0);
            const int nrep = (lp == MK_REPEAT_LP && ((MK_REPEAT_LAYERS >> l) & 1)) ? 2 : 1;
            for (int rep = 0; rep < nrep; ++rep) {
            if (PHON(0) && lp == LP_INPROJ) {
                pg8::Gemm g{P_XB, P_WIN, M, 3072, D}; pg8::StaticOrder so; so.init(M, 3072, G, bx);
                pg8::EpiInProj E{P_ZT, zts, P_MLAA, P_MISC, P_SSA, P_SSQ, P_SSKV, P_KMP, P_TP, P_TI, P_TM};
                pg8::gemm_phase<pg8::EpiInProj, pg8::StaticOrder, true, true>(lds + RING_OFF, g, so, E, wave0);
            } else if (PHON(1) && lp == LP_MLA) {
                pg8::Gemm g{P_MLAA, P_WMLA, M, 1024, 384}; pg8::StaticOrder so; so.init(M, 1024, G, bx);
                pg8::EpiMla E{P_QM, P_KN, P_VM, P_SSQ, P_SSKV, P_TM};
                pg8::gemm_phase<pg8::EpiMla, pg8::StaticOrder, true, true>(lds + RING_OFF, g, so, E, wave0);
            } else if (PHON(2) && lp == LP_MIX) {
                MixCtx MC; MC.zt = P_ZT; MC.zts = zts; MC.misc = P_MISC; MC.qm = P_QM; MC.kn = P_KN; MC.vm = P_VM; MC.kmp = P_KMP; MC.bits = P_BITS; MC.o4 = P_O4; MC.o4s = zts; MC.diag = (unsigned*)(ctl + 12288); MC.mlist = (unsigned short*)(ws + WS_MLIST); MC.mcnt = (unsigned*)(ctl + CW_MCNT + 256 * l); MC.part = (bf16*)(ws + WS_PART); MC.lse = (float*)(ws + WS_LSE); MC.dsa2 = (bf16*)(ws + WS_DSA2); MC.lsed = (float*)(ws + WS_LSED);
                int tid_ = (wave0 << 6) | xl::fresh_lane(); asm volatile("" : "+v"(tid_)); const int tid = tid_, lane = tid & 63, wave = __builtin_amdgcn_readfirstlane(tid >> 6), gw = vcu * NWAVES + wave; (void)lane; (void)gw;
                gu32* ctr = ctl + CW_QUEUE + 64 * (2 * l + 4 * rep);
                const int per = 20 * nb, total = 32 * per;
                for (;;) {
                    const int u = next_unit(ctr, aux, tid);
                    if (u >= total) break;
                    const int L = 31 - u / per, r = u % per;
                    const int kmask = rep ? MK_REPEAT_KINDS : 15;
                    if (r < 12 * nb) { const int kind = r / (4 * nb), rr = r % (4 * nb), b = rr >> 2, h = rr & 3;
                        if (MIXON(0) && kind == 0 && (kmask & 1)) softmax_unit<0>(MC, b, h, L, lds, wave0, rep); else if (MIXON(2) && kind == 1 && (kmask & 4)) sb_unit(MC, b, h, L, lds, wave0);
                        else if (kind == 2 && !rep) moba_gate_unit(MC, b, h, L, lds, wave0); }
                    else if (MIXON(3) && (kmask & 8)) { const int r2 = r - 12 * nb, b = r2 >> 3, qg = 8 * L + 7 - (r2 & 7); sel_unit(MC, b, qg, lds, wave0, rep); }
                }
            } else if (PHON(3) && lp == LP_DSA) {
                MixCtx MC; MC.zt = P_ZT; MC.zts = zts; MC.misc = P_MISC; MC.qm = P_QM; MC.kn = P_KN; MC.vm = P_VM; MC.kmp = P_KMP; MC.bits = P_BITS; MC.o4 = P_O4; MC.o4s = zts; MC.diag = (unsigned*)(ctl + 12288); MC.mlist = (unsigned short*)(ws + WS_MLIST); MC.mcnt = (unsigned*)(ctl + CW_MCNT + 256 * l); MC.part = (bf16*)(ws + WS_PART); MC.lse = (float*)(ws + WS_LSE); MC.dsa2 = (bf16*)(ws + WS_DSA2); MC.lsed = (float*)(ws + WS_LSED);
                int tid_ = (wave0 << 6) | xl::fresh_lane(); asm volatile("" : "+v"(tid_)); const int tid = tid_, lane = tid & 63, wave = __builtin_amdgcn_readfirstlane(tid >> 6), gw = vcu * NWAVES + wave; (void)lane; (void)gw;
                gu32* ctr = ctl + CW_QUEUE + 64 * (2 * l + 1 + 4 * rep);
                const int per = (12 + 4 * MOBA_PARTS) * nb, total = 32 * per;
                for (;;) {
                    const int u = next_unit(ctr, aux, tid);
                    if (u >= total) break;
                    const int L = 31 - u / per, r = u % per;
                    const int kmask = rep ? MK_REPEAT_KINDS : 15;
                    if (r < 8 * nb) { const int hf = r / (4 * nb), rr = r % (4 * nb); softmax_unit<1>(MC, rr >> 2, rr & 3, L, lds, wave0, 0, hf); }
                    else if (r < 12 * nb) { const int rr = r - 8 * nb; if (MIXON(1) && (kmask & 2)) moba_blk_unit(MC, rr >> 2, rr & 3, L, 0, true, lds, wave0); }
                    else { const int rr = r - 12 * nb, bh = rr / MOBA_PARTS, p = rr % MOBA_PARTS; if (MIXON(1) && (kmask & 2) && L > 0) moba_blk_unit(MC, bh >> 2, bh & 3, 31 - L, p, false, lds, wave0); }
                }
            } else if (PHON(4) && lp == LP_PROJ) {
                pg8::Gemm g{P_O4, P_WB, 4 * M, 4096, 256}; pg8::ProjOrder so{M / 256, G, bx};
                pg8::EpiProj E{P_PROJ, M / 256};
                pg8::gemm_phase<pg8::EpiProj, pg8::ProjOrder, true, true>(lds + RING_OFF, g, so, E, wave0);
            } else if (PHON(5) && lp == LP_GATE) {
                pg8::Gemm g{P_XB, P_WIN, M, 7168, D}; pg8::GateOrder so; so.so.init(M, 1024, G, bx);
                pg8::EpiGate E{P_PROJ, P_MERGED, P_SSA, P.in[3] + (size_t)l * 4 * D};
                pg8::gemm_phase<pg8::EpiGate, pg8::GateOrder, true, true>(lds + RING_OFF, g, so, E, wave0);
            } else if (PHON(6) && lp == LP_OUT) {
                pg8::Gemm g{P_MERGED, P_WOUT, M, D, D}; pg8::StaticOrder so; so.init(M, D, G, bx);
                pg8::EpiResid E{(l == 0) ? P.in[0] : nullptr, P_XB, P_SSB};
                pg8::gemm_phase<pg8::EpiResid, pg8::StaticOrder, true, true>(lds + RING_OFF, g, so, E, wave0);
            } else if (PHON(7) && lp == LP_UP) {
                pg8::Gemm g{P_XB, P_WUP, M, FF, D}; pg8::StaticOrder so; so.init(M, FF, G, bx);
                pg8::EpiUp E{P_HID, P_SSB};
                pg8::gemm_phase<pg8::EpiUp, pg8::StaticOrder, true, true>(lds + RING_OFF, g, so, E, wave0);
            } else if (PHON(8)) {
                pg8::Gemm g{P_HID, P_WDOWN, M, D, FF}; pg8::StaticOrder so; so.init(M, D, G, bx);
                pg8::EpiResid E{nullptr, P_XB, P_SSA};
                pg8::gemm_phase<pg8::EpiResid, pg8::StaticOrder, true, true>(lds + RING_OFF, g, so, E, wave0);
            }
            }
        }
    }
}

__global__ void __launch_bounds__(NTHR, 2) mk_fwd(Ptrs P) {
    extern __shared__ __attribute__((aligned(16))) unsigned char lds_raw[];
    LAS unsigned char* lds = (LAS unsigned char*)lds_raw;
    const int tid0 = threadIdx.x;
    const int wave0 = __builtin_amdgcn_readfirstlane(tid0 >> 6);
#define LEADER (wave0 == 0 && xl::fresh_lane() == 0)
    const int G = gridDim.x, bx = blockIdx.x;
    const int vcu = (G % 8 == 0) ? (bx % 8) * (G / 8) + bx / 8 : bx;
    gu32* ctl = (gu32*)(P.ws + WS_CTL);
    volatile LAS unsigned* MISCW = (volatile LAS unsigned*)(lds + MISC_OFF);
    for (int u = tid0; u < (LDS_BYTES - LDSCTL_OFF) / 4; u += NTHR) ((LAS unsigned*)(lds + LDSCTL_OFF))[u] = 0u;
    __syncthreads();
    const bool multi = (P.ph_hi - P.ph_lo) > 1;
    XcdBarrier bar; bar.bar = (unsigned*)(ctl + CW_BAR); bar.x = 0; bar.st = nullptr;
    if (multi) bar = xcd_barrier_post((unsigned*)(ctl + CW_BAR), MISCW + 8, tid0 == 0);
#define RUNPH(k) if (P.ph_lo <= (k) && (k) < P.ph_hi) { run_phase<k>(P, lds, ctl, G, bx, vcu, wave0); if ((k) + 1 < P.ph_hi && (k) != PH_CONV1) xcd_barrier(bar, LEADER); }
    RUNPH(0) RUNPH(1) RUNPH(2) RUNPH(3) RUNPH(4)
    if (P.ph_lo <= PH_L0 + LP_DSA && PH_L0 + LP_PROJ < P.ph_hi) { run_phase<PH_MERGE0>(P, lds, ctl, G, bx, vcu, wave0); xcd_barrier(bar, LEADER); }
    RUNPH(5) RUNPH(6) RUNPH(7) RUNPH(8) RUNPH(9) RUNPH(10)
#if MK_REPEAT_CONV
    RUNPH(10)
#endif
    RUNPH(11) RUNPH(12) RUNPH(13) RUNPH(14)
    if (P.ph_lo <= PH_L1 + LP_DSA && PH_L1 + LP_PROJ < P.ph_hi) { run_phase<PH_MERGE1>(P, lds, ctl, G, bx, vcu, wave0); xcd_barrier(bar, LEADER); }
    RUNPH(15) RUNPH(16) RUNPH(17) RUNPH(18) RUNPH(19) RUNPH(20)
#undef RUNPH
    if (multi) { for (int i = 0; i < MK_EXTRA_BARRIERS; ++i) xcd_barrier(bar, LEADER); }
}

static int g_grid = 0;
static int mk_setup(size_t ws_size) {
    if (g_grid != 0) return g_grid;
    if (ws_size < WS_END) { fprintf(stderr, "kernel_launch: workspace too small (%zu < %zu)\n", ws_size, (size_t)WS_END); g_grid = -1; return g_grid; }
    int dev = 0, cus = 0, per_cu = 0;
    if (hipGetDevice(&dev) != hipSuccess || hipDeviceGetAttribute(&cus, hipDeviceAttributeMultiprocessorCount, dev) != hipSuccess) { g_grid = -1; return g_grid; }
    if (hipFuncSetAttribute((const void*)mk_fwd, hipFuncAttributeMaxDynamicSharedMemorySize, LDS_BYTES) != hipSuccess) { fprintf(stderr, "kernel_launch: hipFuncSetAttribute failed\n"); g_grid = -1; return g_grid; }
    if (hipOccupancyMaxActiveBlocksPerMultiprocessor(&per_cu, (const void*)mk_fwd, NTHR, LDS_BYTES) != hipSuccess || per_cu < 1) fprintf(stderr, "kernel_launch: occupancy query reports %d blocks per CU\n", per_cu);
    (void)hipGetLastError();
    g_grid = cus;
    return g_grid;
}
static void mk_launch(Ptrs a, int lo, int hi, int li, hipStream_t stream) {
    a.ph_lo = lo; a.ph_hi = hi; a.li = li;
    hipLaunchKernelGGL(mk_fwd, dim3(g_grid), dim3(NTHR), LDS_BYTES, stream, a);
}
}

extern "C" void kernel_launch(void* const* d_in, const int* in_sizes, int n_in, void* d_out, int out_size, void* d_ws, size_t ws_size, hipStream_t stream) {
    if (n_in != 14 || out_size != 2 * mk::S * mk::D) { fprintf(stderr, "kernel_launch: unexpected shapes\n"); return; }
    if (mk::mk_setup(ws_size) < 0) return;
    if (hipMemsetAsync((char*)d_ws + mk::WS_CTL, 0, mk::CTL_ZERO_BYTES, stream) != hipSuccess) return;
    mk::Ptrs a{};
    for (int i = 0; i < 14; ++i) a.in[i] = (const float*)d_in[i];
    a.out = (float*)d_out; a.ws = (unsigned char*)d_ws; a.mrows = 2 * mk::S;
#ifndef MK_PER_PHASE
    mk::mk_launch(a, 0, mk::N_PHASES, 0, stream);
#else
    for (int ph = 0; ph < mk::N_PHASES; ++ph) mk::mk_launch(a, ph, ph + 1, ph, stream);
#endif
}
```

```cpp
#include <hip/hip_runtime.h>
#include <hip/hip_bf16.h>
#include <cstdio>
#include <cstdint>
#include <cmath>

namespace xl {
template <int K> __device__ __forceinline__ float sxor(float v) { return __int_as_float(__builtin_amdgcn_ds_swizzle(__float_as_int(v), (K << 10) | 0x1F)); }
template <int K> __device__ __forceinline__ unsigned bcast16(unsigned v) { return (unsigned)__builtin_amdgcn_ds_swizzle((int)v, (K << 5) | 0x10); }
__device__ __forceinline__ void halves(float v, float& lo, float& hi) { auto rr = __builtin_amdgcn_permlane32_swap(__float_as_uint(v), __float_as_uint(v), false, false); lo = __uint_as_float(rr[0]); hi = __uint_as_float(rr[1]); }
__device__ __forceinline__ float hsum(float v) { float lo, hi; halves(v, lo, hi); return lo + hi; }
__device__ __forceinline__ float hmax(float v) { float lo, hi; halves(v, lo, hi); return fmaxf(lo, hi); }
__device__ __forceinline__ unsigned hor(unsigned v) { auto rr = __builtin_amdgcn_permlane32_swap(v, v, false, false); return rr[0] | rr[1]; }
__device__ __forceinline__ int fresh_lane() { int z = 0; asm volatile("" : "+v"(z)); return (int)__builtin_amdgcn_mbcnt_hi(~0u, __builtin_amdgcn_mbcnt_lo(~0u, (unsigned)z)); }
}
namespace pg8 {
#define PG8_LAS __attribute__((address_space(3)))
typedef unsigned short bf16_t;
typedef short bf16x8 __attribute__((ext_vector_type(8)));
typedef float f32x4 __attribute__((ext_vector_type(4)));
typedef unsigned u32x4 __attribute__((ext_vector_type(4)));
constexpr int BM = 256, BK = 64, HALF = 128, HTB = HALF * BK * 2  , STAGE_BYTES = 8 * HTB, NXCD = 8, WGM = 8;

__host__ __device__ __forceinline__ int lds_byte(int r, int c) { const int st = (r >> 4) * 2 + (c >> 5), rr = r & 15, cc = c & 31, ob = rr * 64 + cc * 2; return st * 1024 + (ob ^ (((ob >> 9) & 1) << 5)); }
__host__ __device__ __forceinline__ void stage_rc(int b, int& R, int& C) { const int st = b / 1024, sb = b % 1024, swz = sb ^ (((sb >> 9) & 1) << 5); R = (st >> 1) * 16 + swz / 64; C = (st & 1) * 32 + (swz % 64) / 2; }
__host__ __device__ __forceinline__ int perm32(int rho) { const int n = rho >> 4, i = rho & 15; return 8 * (i >> 2) + 4 * n + (i & 3); }

struct Unit { int pm, pn; };
struct Gemm { const bf16_t* A; const bf16_t* Bt; int M, N, K; };

struct StaticOrder {
    int nM, nN, nwg, G, c;
    __host__ __device__ void init(int M, int N, int G_, int c_) { nM = M / BM; nN = N / BM; nwg = nM * nN; G = G_; c = c_; }
    __host__ __device__ bool next(int i, Unit& u) const {
        const long L = (long)i * G + c; if (L >= nwg) return false;
        int wgid = (int)L; { const int q = nwg / NXCD, r = nwg % NXCD, xcd = wgid % NXCD, off = wgid / NXCD; wgid = (xcd < r ? xcd * (q + 1) : r * (q + 1) + (xcd - r) * q) + off; }
        const int nig = WGM * nN, gid = wgid / nig, fm = gid * WGM, gsz = (nM - fm) < WGM ? (nM - fm) : WGM;
        u.pm = fm + ((wgid % nig) % gsz); u.pn = (wgid % nig) / gsz; return true;
    }
    __device__ __forceinline__ void a_ready(const Unit&) const {}
    __device__ __forceinline__ void done(const Unit&) const {}
};

__device__ __forceinline__ unsigned cvt_pk_bf16(float lo, float hi) { unsigned r; asm volatile("v_cvt_pk_bf16_f32 %0, %1, %2" : "=v"(r) : "v"(lo), "v"(hi)); return r; }
template <class Epi, class Sched, bool ALIGN_EPI = false, bool SP2 = false>
__device__ __forceinline__ void gemm_phase(PG8_LAS unsigned char* lds, const Gemm g, const Sched& S, const Epi& E, const int wave0) {
    int tid_ = (wave0 << 6) | xl::fresh_lane(); asm volatile("" : "+v"(tid_));
    const int tid = tid_, wid = __builtin_amdgcn_readfirstlane(tid >> 6), lane = tid & 63, wr = wid >> 2, wc = wid & 3, fr = lane & 15, fq = lane >> 4;
    int K_ = g.K; asm volatile("" : "+s"(K_));
    const int K = K_, nt = K / BK;
    unsigned voffA[2], voffB[2];
#pragma unroll
    for (int i = 0; i < 2; ++i) { int R, C; stage_rc(tid * 16 + i * 8192, R, C); const int Rb = Epi::PERM ? ((R & ~31) + perm32(R & 31)) : R;
        voffA[i] = (unsigned)(R * K + C) * 2u; voffB[i] = (unsigned)(Rb * K + C) * 2u; }
    const size_t kstep = (size_t)(BK * 2);
    const size_t hstep = (size_t)HALF * K * 2;
    const size_t tstep = 2 * hstep;
    const unsigned ldsw = (unsigned)wid * 1024u;
    const int aoff = lds_byte(wr * 64 + fr, fq * 8), boff = lds_byte(wc * 32 + fr, fq * 8);
#define PG8_SA(b, h) (((b) * 2 + (h)) * HTB)
#define PG8_SB(b, h) ((4 + (b) * 2 + (h)) * HTB)
#define PG8_STAGE(bufoff, gbase, voff) do { _Pragma("unroll") for (int _i = 0; _i < 2; ++_i) \
        __builtin_amdgcn_global_load_lds((const unsigned*)((const char*)(gbase) + (voff)[_i]), (PG8_LAS unsigned*)(lds + (bufoff) + ldsw + _i * 8192), 16, 0, 0); } while (0)
#define PG8_LDA(dst, b, h) do { _Pragma("unroll") for (int m = 0; m < 4; ++m) _Pragma("unroll") for (int k = 0; k < 2; ++k) dst[m][k] = *(const PG8_LAS bf16x8*)(lds + PG8_SA(b, h) + aoff + m * 2048 + k * 1024); } while (0)
#define PG8_LDB(dst, b, h) do { _Pragma("unroll") for (int n = 0; n < 2; ++n) _Pragma("unroll") for (int k = 0; k < 2; ++k) dst[n][k] = *(const PG8_LAS bf16x8*)(lds + PG8_SB(b, h) + boff + n * 2048 + k * 1024); } while (0)
#define PG8_MMA(ai, bj, At, Bt) do { __builtin_amdgcn_s_setprio(1); _Pragma("unroll") for (int m = 0; m < 4; ++m) _Pragma("unroll") for (int n = 0; n < 2; ++n) _Pragma("unroll") for (int k = 0; k < 2; ++k) \
        acc[ai][bj][m][n] = __builtin_amdgcn_mfma_f32_16x16x32_bf16(Bt[n][k], At[m][k], acc[ai][bj][m][n], 0, 0, 0); __builtin_amdgcn_s_setprio(0); } while (0)
#define PG8_WAIT_V(n) asm volatile("s_waitcnt vmcnt(" #n ")" ::: "memory")
#define PG8_WAIT_L(n) asm volatile("s_waitcnt lgkmcnt(" #n ")" ::: "memory")
#define PG8_BAR __builtin_amdgcn_s_barrier()
#define PG8_SCHED __builtin_amdgcn_sched_barrier(0)
    Unit cur, nxt; int ui = 0;
    if (!S.next(0, cur)) return;
    f32x4 acc[2][2][4][2];
#pragma unroll
    for (int a = 0; a < 2; ++a)
#pragma unroll
        for (int b = 0; b < 2; ++b)
#pragma unroll
            for (int m = 0; m < 4; ++m)
#pragma unroll
                for (int n = 0; n < 2; ++n) acc[a][b][m][n] = (f32x4){0.f, 0.f, 0.f, 0.f};
    bf16x8 At[4][2], B0[2][2], B1[2][2];
    const char* cA = (const char*)g.A + (size_t)cur.pm * tstep; const char* cB = (const char*)g.Bt + (size_t)cur.pn * tstep;
    S.a_ready(cur);
    if constexpr (SP2) {
        PG8_STAGE(PG8_SB(0, 0), cB, voffB); PG8_STAGE(PG8_SB(0, 1), cB + hstep, voffB); PG8_STAGE(PG8_SA(0, 0), cA, voffA); PG8_STAGE(PG8_SA(0, 1), cA + hstep, voffA);
        if (wr == 1) PG8_BAR;
        PG8_WAIT_V(2); PG8_BAR;
        PG8_STAGE(PG8_SB(1, 0), cB + kstep, voffB); PG8_STAGE(PG8_SA(1, 0), cA + kstep, voffA); PG8_STAGE(PG8_SB(1, 1), cB + hstep + kstep, voffB);
        PG8_WAIT_V(6); PG8_BAR;
    } else {
        PG8_STAGE(PG8_SB(0, 0), cB, voffB); PG8_STAGE(PG8_SA(0, 0), cA, voffA); PG8_STAGE(PG8_SB(0, 1), cB + hstep, voffB); PG8_STAGE(PG8_SA(0, 1), cA + hstep, voffA);
        if (wr == 1) PG8_BAR;
        PG8_WAIT_V(4); PG8_BAR;
        PG8_STAGE(PG8_SB(1, 0), cB + kstep, voffB); PG8_STAGE(PG8_SA(1, 0), cA + kstep, voffA); PG8_STAGE(PG8_SB(1, 1), cB + hstep + kstep, voffB);
        PG8_WAIT_V(6); PG8_BAR;
    }
    for (;;) {
        const bool has_next = S.next(ui + 1, nxt);
        const char* nA = has_next ? (const char*)g.A + (size_t)nxt.pm * tstep : cA; const char* nB = has_next ? (const char*)g.Bt + (size_t)nxt.pn * tstep : cB;
        for (int t = 0; t < nt; t += 2) {
            const bool last = (t == nt - 2);
            const char* a1 = cA + (size_t)(t + 1) * kstep;
            const char* a2 = last ? nA : cA + (size_t)(t + 2) * kstep; const char* b2 = last ? nB : cB + (size_t)(t + 2) * kstep;
            const char* a3 = a2 + kstep; const char* b3 = b2 + kstep;
            if (last && has_next) S.a_ready(nxt);
            if constexpr (SP2) {
            PG8_LDB(B0, 0, 0); PG8_LDB(B1, 0, 1); PG8_SCHED; PG8_LDA(At, 0, 0); PG8_STAGE(PG8_SA(1, 1), a1 + hstep, voffA);
            PG8_WAIT_V(8); PG8_WAIT_L(0); PG8_BAR; PG8_MMA(0, 0, At, B0); PG8_MMA(0, 1, At, B1); PG8_BAR; PG8_SCHED;
            PG8_LDA(At, 0, 1); PG8_STAGE(PG8_SB(0, 0), b2, voffB); PG8_STAGE(PG8_SB(0, 1), b2 + hstep, voffB); PG8_STAGE(PG8_SA(0, 0), a2, voffA);
            PG8_WAIT_V(8); PG8_WAIT_L(0); PG8_BAR; PG8_MMA(1, 0, At, B0); PG8_MMA(1, 1, At, B1); PG8_BAR; PG8_SCHED;
            PG8_LDB(B0, 1, 0); PG8_LDB(B1, 1, 1); PG8_SCHED; PG8_LDA(At, 1, 0); PG8_STAGE(PG8_SA(0, 1), a2 + hstep, voffA);
            PG8_WAIT_V(8); PG8_WAIT_L(0); PG8_BAR; PG8_MMA(0, 0, At, B0); PG8_MMA(0, 1, At, B1); PG8_BAR; PG8_SCHED;
            PG8_LDA(At, 1, 1); PG8_STAGE(PG8_SB(1, 0), b3, voffB); PG8_STAGE(PG8_SB(1, 1), b3 + hstep, voffB); PG8_STAGE(PG8_SA(1, 0), a3, voffA);
            PG8_WAIT_V(8); PG8_WAIT_L(0); PG8_BAR; PG8_MMA(1, 0, At, B0); PG8_MMA(1, 1, At, B1); PG8_BAR; PG8_SCHED;
            } else {
            PG8_LDB(B0, 0, 0); PG8_SCHED; PG8_LDA(At, 0, 0); PG8_STAGE(PG8_SA(1, 1), a1 + hstep, voffA);
            PG8_WAIT_L(8); PG8_BAR; PG8_WAIT_L(0); PG8_MMA(0, 0, At, B0); PG8_BAR; PG8_SCHED;
            PG8_LDB(B1, 0, 1); PG8_STAGE(PG8_SB(0, 0), b2, voffB);
            PG8_BAR; PG8_WAIT_L(0); PG8_MMA(0, 1, At, B1); PG8_BAR;
            PG8_LDA(At, 0, 1); PG8_STAGE(PG8_SA(0, 0), a2, voffA);
            PG8_BAR; PG8_WAIT_L(0); PG8_MMA(1, 0, At, B0); PG8_BAR; PG8_SCHED;
            PG8_STAGE(PG8_SB(0, 1), b2 + hstep, voffB);
            PG8_WAIT_V(6); PG8_BAR; PG8_MMA(1, 1, At, B1); PG8_BAR;
            PG8_LDB(B0, 1, 0); PG8_SCHED; PG8_LDA(At, 1, 0); PG8_STAGE(PG8_SA(0, 1), a2 + hstep, voffA);
            PG8_WAIT_L(8); PG8_BAR; PG8_WAIT_L(0); PG8_MMA(0, 0, At, B0); PG8_BAR; PG8_SCHED;
            PG8_LDB(B1, 1, 1); PG8_STAGE(PG8_SB(1, 0), b3, voffB);
            PG8_BAR; PG8_WAIT_L(0); PG8_MMA(0, 1, At, B1); PG8_BAR;
            PG8_LDA(At, 1, 1); PG8_STAGE(PG8_SA(1, 0), a3, voffA);
            PG8_BAR; PG8_WAIT_L(0); PG8_MMA(1, 0, At, B0); PG8_BAR; PG8_SCHED;
            PG8_STAGE(PG8_SB(1, 1), b3 + hstep, voffB);
            PG8_WAIT_V(6); PG8_BAR; PG8_MMA(1, 1, At, B1); PG8_BAR;
            }
        }
        if constexpr (ALIGN_EPI) { if (wr == 0) PG8_BAR; }
        if constexpr (!Epi::AFTER_DRAIN) { E(acc, cur, wr, wc, fr, fq); S.done(cur); }
        if (!has_next) break;
#pragma unroll
        for (int a = 0; a < 2; ++a)
#pragma unroll
            for (int b = 0; b < 2; ++b)
#pragma unroll
                for (int m = 0; m < 4; ++m)
#pragma unroll
                    for (int n = 0; n < 2; ++n) acc[a][b][m][n] = (f32x4){0.f, 0.f, 0.f, 0.f};
        cur = nxt; cA = nA; cB = nB; ++ui;
        if constexpr (ALIGN_EPI) { if (wr == 1) PG8_BAR; }
    }
    PG8_WAIT_V(0);
    if constexpr (!ALIGN_EPI) { if (wr == 0) PG8_BAR; }
    PG8_BAR;
    if constexpr (Epi::AFTER_DRAIN) { E.fused(acc, cur, wr, wc, fr, fq, lds, wid, lane); S.done(cur); }
#undef PG8_SA
#undef PG8_SB
#undef PG8_STAGE
#undef PG8_LDA
#undef PG8_LDB
#undef PG8_MMA
#undef PG8_WAIT_V
#undef PG8_WAIT_L
#undef PG8_BAR
#undef PG8_SCHED
}

constexpr float NORM_EPS = 1e-6f;
constexpr float LOG2E = 1.4426950408889634f;
__device__ __forceinline__ u32x4 pack8(const f32x4 a, const f32x4 b) { u32x4 w; w.x = cvt_pk_bf16(a[0], a[1]); w.y = cvt_pk_bf16(a[2], a[3]); w.z = cvt_pk_bf16(b[0], b[1]); w.w = cvt_pk_bf16(b[2], b[3]); return w; }
__device__ __forceinline__ float bf_lo(unsigned w) { return __uint_as_float(w << 16); }
__device__ __forceinline__ float bf_hi(unsigned w) { return __uint_as_float(w & 0xffff0000u); }
__device__ __forceinline__ float row_total16(const float* ss, int row, int fq) {
    const f32x4 p = *(const f32x4*)(ss + (size_t)row * 16 + 4 * fq);
    float s = (p[0] + p[1]) + (p[2] + p[3]);
    s += xl::sxor<16>(s); s = xl::hsum(s);
    return s;
}
__device__ __forceinline__ void rot4(f32x4& v0, f32x4& v1, const f32x4 c4, const f32x4 s4) {
    const float a0 = v0[0] * c4[0] - v0[1] * s4[0], b0 = v0[1] * c4[0] + v0[0] * s4[0];
    const float a1 = v0[2] * c4[1] - v0[3] * s4[1], b1 = v0[3] * c4[1] + v0[2] * s4[1];
    const float a2 = v1[0] * c4[2] - v1[1] * s4[2], b2 = v1[1] * c4[2] + v1[0] * s4[2];
    const float a3 = v1[2] * c4[3] - v1[3] * s4[3], b3 = v1[3] * c4[3] + v1[2] * s4[3];
    v0 = (f32x4){a0, b0, a1, b1}; v1 = (f32x4){a2, b2, a3, b3};
}

struct EpiInProj {
    static constexpr bool PERM = true, AFTER_DRAIN = false;
    bf16_t* zt; size_t zt_stride; bf16_t* mla_a; bf16_t* misc; const float* ss; float* ssq; float* sskv; float* kmp; const float* tp; const float* ti; const float* tm;
    __device__ __forceinline__ void operator()(const f32x4 (&acc)[2][2][4][2], const Unit& u, int wr, int wc, int fr, int fq) const {
        const int tile = u.pn;
        const int row0 = u.pm * BM + wr * 64 + fr;
        const bool rot64 = (tile == 0) | (tile == 1) | (tile == 7) | (tile == 8);
        const float scl = (tile == 0 || tile == 7) ? 0.125f * LOG2E : (tile == 4 ? 0.125f : 1.0f);
        float ksum[2][8];
#pragma unroll
        for (int bj = 0; bj < 2; ++bj)
#pragma unroll
            for (int e = 0; e < 8; ++e) ksum[bj][e] = 0.f;
        float rsv[2][4];
#pragma unroll
        for (int ai = 0; ai < 2; ++ai)
#pragma unroll
            for (int m = 0; m < 4; ++m) rsv[ai][m] = rsqrtf(row_total16(ss, row0 + ai * HALF + m * 16, fq) * (1.0f / 1024.0f) + NORM_EPS);
        const int ct0 = wc * 32 + 8 * fq;
        const float* rtab = nullptr; int rstride = 0, coff = 0, soff = 0, rbj = 3;
        if (rot64) { if ((ct0 & 63) < 16) { rtab = tp; rstride = 16; coff = (ct0 & 63) >> 1; soff = coff + 8; } }
        else if (tile == 3) { if ((ct0 & 31) == 0) { rtab = ti; rstride = 8; coff = 0; soff = 4; } }
        else if (tile == 11) { rbj = 2; if (wc == 0) { rtab = tm; rstride = 32; coff = ct0 >> 1; soff = coff + 16; } else if (wc == 1 && fq == 0) { rtab = ti; rstride = 8; coff = 0; soff = 4; } }
#pragma unroll
        for (int am = 0; am < 4; ++am) {
            const int ai = am >> 1;
            f32x4 c4[2], s4[2];
            if (rtab) {
#pragma unroll
                for (int mm = 0; mm < 2; ++mm) { const int t = (row0 + ai * HALF + (2 * (am & 1) + mm) * 16) & 8191; c4[mm] = *(const f32x4*)(rtab + t * rstride + coff); s4[mm] = *(const f32x4*)(rtab + t * rstride + soff); }
            }
#pragma unroll
            for (int mm = 0; mm < 2; ++mm) {
                const int m = 2 * (am & 1) + mm;
                const int row = row0 + ai * HALF + m * 16;
                const float rs = rsv[ai][m];
                float sq0 = 0.f, sq1 = 0.f;
#pragma unroll
                for (int bj = 0; bj < 2; ++bj) {
                    const int ct = bj * HALF + ct0;
                    f32x4 v0 = acc[ai][bj][m][0] * rs, v1 = acc[ai][bj][m][1] * rs;
                    if (rtab && ((rbj >> bj) & 1)) rot4(v0, v1, c4[mm], s4[mm]);
                    if (tile <= 9) {
                        if (tile == 8) {
#pragma unroll
                            for (int e = 0; e < 4; ++e) { ksum[bj][e] += v0[e]; ksum[bj][4 + e] += v1[e]; }
                        }
                        v0 = v0 * scl; v1 = v1 * scl;
                        *(u32x4*)(zt + (size_t)tile * zt_stride + (size_t)row * 256 + ct) = pack8(v0, v1);
                    } else if (tile == 10) {
                        sq0 += (v0[0] * v0[0] + v0[1] * v0[1]) + (v0[2] * v0[2] + v0[3] * v0[3]) + (v1[0] * v1[0] + v1[1] * v1[1]) + (v1[2] * v1[2] + v1[3] * v1[3]);
                        *(u32x4*)(mla_a + (size_t)row * 384 + ct) = pack8(v0, v1);
                    } else {
                        if (bj == 0) {
                            sq1 += (v0[0] * v0[0] + v0[1] * v0[1]) + (v0[2] * v0[2] + v0[3] * v0[3]) + (v1[0] * v1[0] + v1[1] * v1[1]) + (v1[2] * v1[2] + v1[3] * v1[3]);
                            *(u32x4*)(mla_a + (size_t)row * 384 + 256 + ct) = pack8(v0, v1);
                        } else {
                            if (wc == 2) { v0 = v0 * 0.0625f; v1 = v1 * 0.0625f; }
                            *(u32x4*)(misc + (size_t)row * 128 + ct0) = pack8(v0, v1);
                        }
                    }
                }
                if (tile == 10) { sq0 += xl::sxor<16>(sq0); sq0 = xl::hsum(sq0); if (fq == 0) ssq[(size_t)row * 4 + wc] = sq0; }
                if (tile == 11) { sq1 += xl::sxor<16>(sq1); sq1 = xl::hsum(sq1); if (fq == 0) sskv[(size_t)row * 4 + wc] = sq1; }
            }
        }
        if (tile == 8) {
#pragma unroll
            for (int bj = 0; bj < 2; ++bj)
#pragma unroll
                for (int e = 0; e < 8; ++e) { float s = ksum[bj][e]; s += xl::sxor<1>(s); s += xl::sxor<2>(s); s += xl::sxor<4>(s); s += xl::sxor<8>(s); ksum[bj][e] = s; }
            if (fr == 0) {
#pragma unroll
                for (int bj = 0; bj < 2; ++bj) { float* kp = kmp + (size_t)(u.pm * 2 + wr) * 256 + bj * HALF + wc * 32 + 8 * fq;
                    *(f32x4*)kp = (f32x4){ksum[bj][0], ksum[bj][1], ksum[bj][2], ksum[bj][3]}; *(f32x4*)(kp + 4) = (f32x4){ksum[bj][4], ksum[bj][5], ksum[bj][6], ksum[bj][7]}; }
            }
        }
    }
};

struct EpiMla {
    static constexpr bool PERM = true, AFTER_DRAIN = false;
    bf16_t* qm; bf16_t* kn; bf16_t* vm; const float* ssq; const float* sskv; const float* tm;
    __device__ __forceinline__ void operator()(const f32x4 (&acc)[2][2][4][2], const Unit& u, int wr, int wc, int fr, int fq) const {
        const int tile = u.pn;
        const int row0 = u.pm * BM + wr * 64 + fr;
        const float QS = 0.10206207261596575f * LOG2E;
        float rsv[2][4];
        { f32x4 pp[2][4];
          const float* ssp = (tile < 2) ? ssq : sskv;
#pragma unroll
          for (int ai = 0; ai < 2; ++ai)
#pragma unroll
              for (int m = 0; m < 4; ++m) pp[ai][m] = *(const f32x4*)(ssp + (size_t)(row0 + ai * HALF + m * 16) * 4);
#pragma unroll
          for (int ai = 0; ai < 2; ++ai)
#pragma unroll
              for (int m = 0; m < 4; ++m) { const f32x4 p = pp[ai][m]; const float sum = (p[0] + p[1]) + (p[2] + p[3]);
                  rsv[ai][m] = (tile < 2) ? rsqrtf(sum * (1.0f / 256.0f) + NORM_EPS) * QS : rsqrtf(sum * (1.0f / 128.0f) + NORM_EPS); } }
#pragma unroll
        for (int ai = 0; ai < 2; ++ai) {
            f32x4 tc[4], ts[4];
            if (tile == 1) { const int j0 = ((wc * 32 + 8 * fq) & 31) >> 1;
#pragma unroll
                for (int m = 0; m < 4; ++m) { const int t = (row0 + ai * HALF + m * 16) & 8191; tc[m] = *(const f32x4*)(tm + t * 32 + j0); ts[m] = *(const f32x4*)(tm + t * 32 + 16 + j0); } }
#pragma unroll
            for (int m = 0; m < 4; ++m) {
                const int row = row0 + ai * HALF + m * 16;
                const float rs = rsv[ai][m];
#pragma unroll
                for (int bj = 0; bj < 2; ++bj) {
                    const int ct = bj * HALF + wc * 32 + 8 * fq;
                    f32x4 v0 = acc[ai][bj][m][0] * rs, v1 = acc[ai][bj][m][1] * rs;
                    if (tile == 0) { *(u32x4*)(qm + (size_t)row * 384 + (ct >> 6) * 96 + (ct & 63)) = pack8(v0, v1); }
                    else if (tile == 1) {
                        if (bj == 0) { rot4(v0, v1, tc[m], ts[m]);
                            *(u32x4*)(qm + (size_t)row * 384 + (ct >> 5) * 96 + 64 + (ct & 31)) = pack8(v0, v1); }
                    }
                    else if (tile == 2) { *(u32x4*)(kn + (size_t)row * 256 + ct) = pack8(v0, v1); }
                    else { *(u32x4*)(vm + (size_t)row * 256 + ct) = pack8(v0, v1); }
                }
            }
        }
    }
};

struct EpiProj {
    static constexpr bool PERM = true, AFTER_DRAIN = false;
    bf16_t* proj; int nM;
    __device__ __forceinline__ void operator()(const f32x4 (&acc)[2][2][4][2], const Unit& u, int wr, int wc, int fr, int fq) const {
        const int n = u.pn >> 2, pn = u.pn & 3, pm = u.pm - n * nM;
        const int row0 = pm * BM + wr * 64 + fr;
#pragma unroll
        for (int ai = 0; ai < 2; ++ai)
#pragma unroll
            for (int m = 0; m < 4; ++m) {
                const int row = row0 + ai * HALF + m * 16;
#pragma unroll
                for (int bj = 0; bj < 2; ++bj) { const int ct = bj * HALF + wc * 32 + 8 * fq;
                    *(u32x4*)(proj + (size_t)row * 4096 + n * 1024 + pn * 256 + ct) = pack8(acc[ai][bj][m][0], acc[ai][bj][m][1]); }
            }
    }
};

struct EpiGate {
    static constexpr bool PERM = true, AFTER_DRAIN = false;
    const bf16_t* proj; bf16_t* merged; const float* ss; const float* bgate;
    __device__ __forceinline__ void operator()(const f32x4 (&acc)[2][2][4][2], const Unit& u, int wr, int wc, int fr, int fq) const {
        const int n = (u.pn - 12) >> 2, pd = (u.pn - 12) & 3;
        const int row0 = u.pm * BM + wr * 64 + fr;
        const int d0 = pd * 256 + wc * 32 + 8 * fq;
        f32x4 bg[2][2];
#pragma unroll
        for (int bj = 0; bj < 2; ++bj) { bg[bj][0] = -LOG2E * *(const f32x4*)(bgate + n * 1024 + d0 + bj * HALF); bg[bj][1] = -LOG2E * *(const f32x4*)(bgate + n * 1024 + d0 + bj * HALF + 4); }
#pragma unroll
        for (int ai = 0; ai < 2; ++ai)
#pragma unroll
            for (int mp = 0; mp < 2; ++mp) {
                u32x4 pr[2][2], mo[2][2]; float rs[2];
#pragma unroll
                for (int mm = 0; mm < 2; ++mm) {
                    const int row = row0 + ai * HALF + (2 * mp + mm) * 16;
#pragma unroll
                    for (int bj = 0; bj < 2; ++bj) {
                        pr[mm][bj] = *(const u32x4*)(proj + (size_t)row * 4096 + n * 1024 + d0 + bj * HALF);
                        if (n > 0) mo[mm][bj] = *(const u32x4*)(merged + (size_t)row * 1024 + d0 + bj * HALF); else mo[mm][bj] = (u32x4){0u, 0u, 0u, 0u};
                    }
                    rs[mm] = rsqrtf(row_total16(ss, row, fq) * (1.0f / 1024.0f) + NORM_EPS);
                }
#pragma unroll
                for (int mm = 0; mm < 2; ++mm) {
                    const int m = 2 * mp + mm; const int row = row0 + ai * HALF + m * 16;
#pragma unroll
                    for (int bj = 0; bj < 2; ++bj) {
                        const float nrs = -LOG2E * rs[mm];
                        f32x4 g0, g1;
#pragma unroll
                        for (int e = 0; e < 4; ++e) { g0[e] = __builtin_amdgcn_rcpf(1.0f + __builtin_amdgcn_exp2f(__builtin_fmaf(acc[ai][bj][m][0][e], nrs, bg[bj][0][e]))); g1[e] = __builtin_amdgcn_rcpf(1.0f + __builtin_amdgcn_exp2f(__builtin_fmaf(acc[ai][bj][m][1][e], nrs, bg[bj][1][e]))); }
                        const u32x4 p = pr[mm][bj], q = mo[mm][bj];
                        const f32x4 p0 = {bf_lo(p.x), bf_hi(p.x), bf_lo(p.y), bf_hi(p.y)}, p1 = {bf_lo(p.z), bf_hi(p.z), bf_lo(p.w), bf_hi(p.w)};
                        const f32x4 q0 = {bf_lo(q.x), bf_hi(q.x), bf_lo(q.y), bf_hi(q.y)}, q1 = {bf_lo(q.z), bf_hi(q.z), bf_lo(q.w), bf_hi(q.w)};
                        f32x4 v0, v1;
#pragma unroll
                        for (int e = 0; e < 4; ++e) { v0[e] = __builtin_fmaf(g0[e], p0[e], q0[e]); v1[e] = __builtin_fmaf(g1[e], p1[e], q1[e]); }
                        *(u32x4*)(merged + (size_t)row * 1024 + d0 + bj * HALF) = pack8(v0, v1);
                    }
                }
            }
    }
};

struct EpiResid {
    static constexpr bool PERM = true, AFTER_DRAIN = false;
    const float* basef; bf16_t* xb; float* ss;
    __device__ __forceinline__ void operator()(const f32x4 (&acc)[2][2][4][2], const Unit& u, int wr, int wc, int fr, int fq) const {
        const int row0 = u.pm * BM + wr * 64 + fr, col0 = u.pn * BM + wc * 32 + 8 * fq;
#pragma unroll
        for (int ai = 0; ai < 2; ++ai) {
            u32x4 wb[4][2];
            if (!basef) {
#pragma unroll
                for (int m = 0; m < 4; ++m)
#pragma unroll
                    for (int bj = 0; bj < 2; ++bj) wb[m][bj] = *(const u32x4*)(xb + (size_t)(row0 + ai * HALF + m * 16) * 1024 + col0 + bj * HALF);
            }
#pragma unroll
            for (int m = 0; m < 4; ++m) {
                const int row = row0 + ai * HALF + m * 16;
                const size_t off = (size_t)row * 1024 + col0;
                float sq = 0.f;
#pragma unroll
                for (int bj = 0; bj < 2; ++bj) {
                    f32x4 b0, b1;
                    if (basef) { b0 = *(const f32x4*)(basef + off + bj * HALF); b1 = *(const f32x4*)(basef + off + bj * HALF + 4); }
                    else { const u32x4 w = wb[m][bj]; b0 = (f32x4){bf_lo(w.x), bf_hi(w.x), bf_lo(w.y), bf_hi(w.y)}; b1 = (f32x4){bf_lo(w.z), bf_hi(w.z), bf_lo(w.w), bf_hi(w.w)}; }
                    const f32x4 v0 = b0 + acc[ai][bj][m][0], v1 = b1 + acc[ai][bj][m][1];
                    sq += ((v0[0] * v0[0] + v0[1] * v0[1]) + (v0[2] * v0[2] + v0[3] * v0[3])) + ((v1[0] * v1[0] + v1[1] * v1[1]) + (v1[2] * v1[2] + v1[3] * v1[3]));
                    *(u32x4*)(xb + off + bj * HALF) = pack8(v0, v1);
                }
                sq += xl::sxor<16>(sq); sq = xl::hsum(sq);
                if (fq == 0) ss[(size_t)row * 16 + u.pn * 4 + wc] = sq;
            }
        }
    }
};

struct EpiUp {
    static constexpr bool PERM = true, AFTER_DRAIN = false;
    bf16_t* hid; const float* ss;
    __device__ __forceinline__ void operator()(const f32x4 (&acc)[2][2][4][2], const Unit& u, int wr, int wc, int fr, int fq) const {
        const int row0 = u.pm * BM + wr * 64 + fr;
        float rsv[2][4];
#pragma unroll
        for (int ai = 0; ai < 2; ++ai)
#pragma unroll
            for (int m = 0; m < 4; ++m) rsv[ai][m] = rsqrtf(row_total16(ss, row0 + ai * HALF + m * 16, fq) * (1.0f / 1024.0f) + NORM_EPS);
#pragma unroll
        for (int ai = 0; ai < 2; ++ai)
#pragma unroll
            for (int m = 0; m < 4; ++m) {
                const int row = row0 + ai * HALF + m * 16;
                const float rs = rsv[ai][m];
#pragma unroll
                for (int bj = 0; bj < 2; ++bj) { const int ct = bj * HALF + wc * 32 + 8 * fq;
                    f32x4 v0 = acc[ai][bj][m][0] * rs, v1 = acc[ai][bj][m][1] * rs;
#pragma unroll
                    for (int e = 0; e < 4; ++e) { const float a = fmaxf(v0[e], 0.f), b = fmaxf(v1[e], 0.f); v0[e] = a * a; v1[e] = b * b; }
                    *(u32x4*)(hid + (size_t)row * 4096 + u.pn * 256 + ct) = pack8(v0, v1); }
            }
    }
};

struct ProjOrder {
    int nM, G, c;
    __device__ bool next(int i, Unit& u) const { const long L = (long)i * G + c; if (L >= 16L * nM) return false; const int n = (int)(L / (4 * nM)), r = (int)(L % (4 * nM)); u.pm = n * nM + (r >> 2); u.pn = n * 4 + (r & 3); return true; }
    __device__ __forceinline__ void a_ready(const Unit&) const {}
    __device__ __forceinline__ void done(const Unit&) const {}
};
struct GateOrder {
    StaticOrder so;
    __device__ bool next(int i, Unit& u) const { Unit p; if (!so.next(i >> 2, p)) return false; u.pm = p.pm; u.pn = 12 + 4 * (i & 3) + p.pn; return true; }
    __device__ __forceinline__ void a_ready(const Unit&) const {}
    __device__ __forceinline__ void done(const Unit&) const {}
};
}

namespace mk {
#define GAS __attribute__((address_space(1)))
#define LAS __attribute__((address_space(3)))
typedef unsigned short bf16;
typedef unsigned v4u __attribute__((ext_vector_type(4)));
typedef unsigned v2u __attribute__((ext_vector_type(2)));
typedef float f32x4 __attribute__((ext_vector_type(4)));
typedef float f32x16 __attribute__((ext_vector_type(16)));
typedef short bf16x8 __attribute__((ext_vector_type(8)));
typedef short s16x4 __attribute__((ext_vector_type(4)));
typedef GAS unsigned gu32;
#define RLX_AGENT __ATOMIC_RELAXED, __HIP_MEMORY_SCOPE_AGENT
#define LDS_WAIT() asm volatile("s_waitcnt lgkmcnt(0)" ::: "memory")
#define VM_WAIT() asm volatile("s_waitcnt vmcnt(0)" ::: "memory")

constexpr int NWAVES = 8, NTHR = 512;
constexpr int S = 8192, D = 1024, FF = 4096, NIN = 7112, DEPTH = 2;
constexpr int C_DQ = 0, C_DK = 256, C_DV = 512, C_IQ = 768, C_IK = 1024, C_IW = 1056, C_SQ = 1064, C_SK = 1320, C_SV = 1576,
              C_MQ = 1832, C_MK = 2088, C_MV = 2344, C_CQ = 2600, C_CKV = 2856, C_KR = 2984, C_GATE = 3016;
constexpr float LOG2E = 1.4426950408889634f, LN2 = 0.6931471805599453f;

constexpr size_t MiB = 1u << 20;
constexpr size_t WS_CTL = 0, CTL_ZERO_BYTES = 256 * 1024;
constexpr size_t WS_TP = 1 * MiB, WS_TI = WS_TP + 512 * 1024, WS_TM = 2 * MiB;
constexpr size_t WS_SSA = 3 * MiB, WS_SSB = 4 * MiB, WS_SSQ = 5 * MiB, WS_SSKV = WS_SSQ + 256 * 1024, WS_KMP = WS_SSKV + 256 * 1024;
constexpr size_t WS_WIN = 6 * MiB, WS_WMLA = 20 * MiB, WS_WB = 21 * MiB, WS_WOUT = 23 * MiB, WS_WUP = 25 * MiB, WS_WDOWN = 33 * MiB;
constexpr size_t WS_XB = 41 * MiB;
constexpr size_t WS_ZT = 73 * MiB;
constexpr size_t WS_MLAA = 153 * MiB, WS_MISC = 165 * MiB, WS_QM = 169 * MiB, WS_KN = 181 * MiB, WS_VM = 189 * MiB;
constexpr size_t WS_BITS = 197 * MiB;
constexpr size_t WS_O4 = 213 * MiB;
constexpr size_t WS_PROJ = 73 * MiB;
constexpr size_t WS_MERGED = 213 * MiB;
constexpr size_t WS_HID = 73 * MiB;
constexpr size_t WS_PART = 153 * MiB, WS_LSE = 250 * MiB;
constexpr size_t WS_MLIST = 245 * MiB;
constexpr size_t WS_DSA2 = 185 * MiB, WS_LSED = 251 * MiB;
constexpr size_t WS_END = 252 * MiB;
constexpr int CW_TMO = 0, CW_BAR = 4096, CW_QUEUE = 8192, CW_MCNT = 13312;

constexpr int RING_OFF = 0, RING_BYTES = 131072;
constexpr int LDSCTL_OFF = RING_BYTES, MISC_OFF = LDSCTL_OFF + 320;
constexpr int AUX_OFF = LDSCTL_OFF + 1024;
constexpr int LDS_BYTES = 147456;

__device__ __forceinline__ unsigned f2bf(float f) { unsigned u = __builtin_bit_cast(unsigned, f); return (u + 0x7fffu + ((u >> 16) & 1u)) >> 16; }
__device__ __forceinline__ unsigned pk2(float lo, float hi) { return f2bf(lo) | (f2bf(hi) << 16); }
__device__ __forceinline__ float bf2f(unsigned short b) { return __uint_as_float((unsigned)b << 16); }

#define XB_TMO      128
#define XB_XCNT(j)  (256  + 64 * (j))
#define XB_XSUB(j)  (1280 + 64 * (j))
#define XB_XGEN(j)  (2304 + 64 * (j))
#define XB_TOP      3328
#define XB_TOPGEN   3392
#define XCD_BAR_WORDS 3456
#define XB_SPIN_CAP (1u << 18)
__device__ __forceinline__ unsigned xb_ld(unsigned* p)              { return __hip_atomic_load(p, __ATOMIC_RELAXED, __HIP_MEMORY_SCOPE_AGENT); }
__device__ __forceinline__ unsigned xb_add(unsigned* p, unsigned v) { return __hip_atomic_fetch_add(p, v, __ATOMIC_RELAXED, __HIP_MEMORY_SCOPE_AGENT); }
__device__ __forceinline__ unsigned xb_xcc_id() { return (unsigned)__builtin_amdgcn_s_getreg((3 << 11) | 20) & 0xFu; }
#define XB_SPIN(cond, bar) do { unsigned _sp = 0; while (cond) { __builtin_amdgcn_s_sleep(1); \
    if ((++_sp & 255u) == 0u) { if (xb_ld(&(bar)[XB_TMO])) break; if (_sp > XB_SPIN_CAP) { atomicAdd(&(bar)[XB_TMO], 1u); break; } } } } while (0)
struct XcdBarrier { unsigned* bar; unsigned x; volatile LAS unsigned* st; };
__device__ __forceinline__ XcdBarrier xcd_barrier_post(unsigned* bar, volatile LAS unsigned* st, bool leader) {
    XcdBarrier b; b.bar = bar; b.x = xb_xcc_id(); b.st = st;
    if (leader) (void)xb_add(&bar[XB_XCNT(b.x)], 1u);
    return b;
}
__device__ __forceinline__ void xcd_barrier_complete(unsigned* bar, unsigned x, unsigned& nloc, unsigned& nx) {
    const unsigned G = gridDim.x * gridDim.y * gridDim.z;
    unsigned sum, cnt, mine, sp = 0u;
    for (;;) {
        sum = 0u; cnt = 0u; mine = 0u;
#pragma unroll
        for (unsigned j = 0; j < 16; ++j) { const unsigned c = xb_ld(&bar[XB_XCNT(j)]); sum += c; cnt += (c > 0u) ? 1u : 0u; mine = (j == x) ? c : mine; }
        if (sum == G) break;
        __builtin_amdgcn_s_sleep(1);
        if ((++sp & 255u) == 0u) { if (xb_ld(&bar[XB_TMO])) break; if (sp > XB_SPIN_CAP) { atomicAdd(&bar[XB_TMO], 1u); break; } }
    }
    nloc = mine > 0u ? mine : 1u; nx = cnt > 0u ? cnt : 1u;
}
__device__ __forceinline__ void xcd_barrier(const XcdBarrier& b, bool leader) {
    asm volatile("s_waitcnt vmcnt(0)" ::: "memory");
    __syncthreads();
    if (leader) {
        unsigned* bar = b.bar;
        __builtin_amdgcn_s_waitcnt(0);
        unsigned nloc = b.st[0], nx = b.st[1];
        if (nloc == 0u) { xcd_barrier_complete(bar, b.x, nloc, nx); b.st[0] = nloc; b.st[1] = nx; }
        const unsigned old = xb_add(&bar[XB_XSUB(b.x)], 1u);
        const unsigned gen = old / nloc;
        if (old + 1u == (gen + 1u) * nloc) {
            __builtin_amdgcn_fence(__ATOMIC_RELEASE, "agent");
            asm volatile("s_waitcnt vmcnt(0)" ::: "memory");
            const unsigned og = xb_add(&bar[XB_TOP], 1u);
            const unsigned tg = og / nx;
            if (og + 1u == (tg + 1u) * nx) xb_add(&bar[XB_TOPGEN], 1u);
            else XB_SPIN(xb_ld(&bar[XB_TOPGEN]) == tg, bar);
            __builtin_amdgcn_fence(__ATOMIC_ACQUIRE, "agent");
            xb_add(&bar[XB_XGEN(b.x)], 1u);
            asm volatile("s_waitcnt vmcnt(0)" ::: "memory");
        } else {
            XB_SPIN(xb_ld(&bar[XB_XGEN(b.x)]) == gen, bar);
            __builtin_amdgcn_fence(__ATOMIC_ACQUIRE, "agent");
            asm volatile("s_waitcnt vmcnt(0)" ::: "memory");
        }
    }
    __syncthreads();
}

struct Ptrs {
    const float* in[14]; float* out; unsigned char* ws;
    int ph_lo, ph_hi, li, mrows;
};

__device__ __forceinline__ int unperm(int p, int R) { return p < R ? ((p & 1) ? (p >> 1) + (R >> 1) : (p >> 1)) : p; }
__device__ __forceinline__ int win_src(int n) {
    if (n >= 3072) return C_GATE + (n - 3072);
    const int tile = n >> 8, p = n & 255;
    switch (tile) {
        case 0: return C_DQ + (p & ~63) + unperm(p & 63, 16);
        case 1: return C_DK + (p & ~63) + unperm(p & 63, 16);
        case 2: return C_DV + p;
        case 3: return C_IQ + (p & ~31) + unperm(p & 31, 8);
        case 4: return C_SQ + p;
        case 5: return C_SK + p;
        case 6: return C_SV + p;
        case 7: return C_MQ + (p & ~63) + unperm(p & 63, 16);
        case 8: return C_MK + (p & ~63) + unperm(p & 63, 16);
        case 9: return C_MV + p;
        case 10: return C_CQ + p;
        default:
            if (p < 128) return C_CKV + p;
            if (p < 160) return C_KR + unperm(p - 128, 32);
            if (p < 192) return C_IK + unperm(p - 160, 8);
            if (p < 200) return C_IW + (p - 192);
            return -1;
    }
}
__device__ __forceinline__ void conv_item(const float* W, int ldw, int srccol, int k0, const float* gsc, bf16* WT, int ldk, int kout0, int n0, LAS float* scr, int lane) {
    const int sc = srccol >= 0 ? srccol : 0; const float zs = srccol >= 0 ? 1.f : 0.f;
    float v[32];
#pragma unroll
    for (int i = 0; i < 32; ++i) v[i] = W[(size_t)(k0 + 2 * i + (lane >> 5)) * ldw + sc];
    if (gsc) {
#pragma unroll
        for (int i = 0; i < 32; ++i) v[i] *= gsc[k0 + 2 * i + (lane >> 5)];
    }
#pragma unroll
    for (int i = 0; i < 32; ++i) scr[(2 * i + (lane >> 5)) * 33 + (lane & 31)] = v[i] * zs;
    LDS_WAIT(); asm volatile("" ::: "memory");
    const int c = lane & 7;
#pragma unroll
    for (int j = 0; j < 4; ++j) { const int n = (lane >> 3) + 8 * j; const LAS float* s = scr + (8 * c) * 33 + n;
        v4u o; o.x = pk2(s[0 * 33], s[1 * 33]); o.y = pk2(s[2 * 33], s[3 * 33]); o.z = pk2(s[4 * 33], s[5 * 33]); o.w = pk2(s[6 * 33], s[7 * 33]);
        *(GAS v4u*)(WT + (size_t)(n0 + n) * ldk + kout0 + 8 * c) = o; }
    LDS_WAIT(); asm volatile("" ::: "memory");
}
__device__ __forceinline__ void conv_item_wide(const float* W, int ldw, int src0, int k0, const float* gsc, bf16* WT, int ldk, int kout0, int n0, LAS float* scr, int lane) {
    const int rr = lane >> 4, c4 = (lane & 15) * 4;
    f32x4 v[16];
#pragma unroll
    for (int i = 0; i < 16; ++i) v[i] = *(const GAS f32x4*)(W + (size_t)(k0 + 4 * i + rr) * ldw + src0 + c4);
    float gs[16];
#pragma unroll
    for (int i = 0; i < 16; ++i) gs[i] = gsc ? gsc[k0 + 4 * i + rr] : 1.0f;
#pragma unroll
    for (int i = 0; i < 16; ++i) { f32x4 t = v[i] * gs[i]; const int row = 4 * i + rr; *(LAS f32x4*)(scr + row * 64 + (c4 ^ (8 * ((row >> 3) & 7)))) = t; }
    LDS_WAIT(); asm volatile("" ::: "memory");
    const int c = lane & 7;
#pragma unroll
    for (int j = 0; j < 8; ++j) { const int n = (lane >> 3) + 8 * j; const LAS float* s = scr + (8 * c) * 64 + (n ^ (8 * c));
        v4u o; o.x = pk2(s[0 * 64], s[1 * 64]); o.y = pk2(s[2 * 64], s[3 * 64]); o.z = pk2(s[4 * 64], s[5 * 64]); o.w = pk2(s[6 * 64], s[7 * 64]);
        *(GAS v4u*)(WT + (size_t)(n0 + n) * ldk + kout0 + 8 * c) = o; }
    LDS_WAIT(); asm volatile("" ::: "memory");
}
__device__ __forceinline__ float wave_sum(float v) {
    v += xl::sxor<1>(v); v += xl::sxor<2>(v); v += xl::sxor<4>(v); v += xl::sxor<8>(v); v += xl::sxor<16>(v); v = xl::hsum(v);
    return v;
}
constexpr int CV_I_IN = (D / 64) * (3072 / 32), CV_I_MLA = (384 / 64) * (1024 / 32), CV_FIRST = CV_I_IN + CV_I_MLA;
constexpr int CV_NITEMS = CV_FIRST + (D / 64) * (4096 / 64) + (256 / 64) * (4096 / 64) + (D / 64) * (D / 64) + (D / 64) * (FF / 64) + (FF / 64) * (D / 64);
constexpr int CV_D0 = CV_NITEMS - CV_FIRST, CV_ND = CV_D0 + CV_NITEMS, CV_CHUNK = 32, CV_UNITS = (CV_ND + CV_CHUNK - 1) / CV_CHUNK, CV_PER_LEVEL = (CV_UNITS + 31) / 32;
__device__ __forceinline__ void conv_item_at(const Ptrs& P, const int l, const int it, LAS float* scr, int lane) {
    unsigned char* ws = P.ws;
    {
    unsigned char* wb = (l == 0) ? ws + WS_WIN : (unsigned char*)P.out;
    const float* w_in = P.in[2] + (size_t)l * D * NIN; const float* norm_mix = P.in[1] + l * D;
    const float* qn = P.in[4] + l * 256; const float* kvn = P.in[5] + l * 128;
    const float* w_uq = P.in[6] + (size_t)l * 256 * 384; const float* w_ukv = P.in[7] + (size_t)l * 128 * 512;
    const float* w_br = P.in[8] + (size_t)l * 4 * 256 * D; const float* w_out = P.in[9] + (size_t)l * D * D;
    const float* norm_mlp = P.in[10] + l * D; const float* w_up = P.in[11] + (size_t)l * D * FF; const float* w_down = P.in[12] + (size_t)l * FF * D;
    bf16* Win = (bf16*)wb; bf16* Wmla = (bf16*)(wb + (WS_WMLA - WS_WIN)); bf16* Wb = (bf16*)(wb + (WS_WB - WS_WIN)); bf16* Wout = (bf16*)(wb + (WS_WOUT - WS_WIN)); bf16* Wup = (bf16*)(wb + (WS_WUP - WS_WIN)); bf16* Wdown = (bf16*)(wb + (WS_WDOWN - WS_WIN));
    constexpr int I_IN = (D / 64) * (3072 / 32), I_MLA = (384 / 64) * (1024 / 32);
    constexpr int J_G = (D / 64) * (4096 / 64), J_B = (256 / 64) * (4096 / 64), J_OUT = (D / 64) * (D / 64), J_UP = (D / 64) * (FF / 64), J_DOWN = (FF / 64) * (D / 64);
    static_assert(I_IN + I_MLA + J_G + J_B + J_OUT + J_UP + J_DOWN == CV_NITEMS && I_IN == CV_I_IN && I_MLA == CV_I_MLA, "item counts");
    do {
        int r = it;
        if (r < I_IN) { const int nb_ = 3072 / 32, kb = r / nb_, nblk = r % nb_; conv_item(w_in, NIN, win_src(nblk * 32 + (lane & 31)), kb * 64, norm_mix, Win, D, kb * 64, nblk * 32, scr, lane); continue; } r -= I_IN;
        if (r < I_MLA) { const int nb_ = 1024 / 32, kb = r / nb_, nblk = r % nb_; const int n = nblk * 32 + (lane & 31);
            int sc = -1; const float* W = w_uq; int ldw = 384; const float* g = qn; int ks = kb * 64;
            if (kb < 4) { if (n < 256) sc = (n >> 6) * 96 + (n & 63); else if (n < 384) sc = ((n - 256) >> 5) * 96 + 64 + unperm((n - 256) & 31, 32); }
            else { W = w_ukv; ldw = 512; g = kvn; ks = kb * 64 - 256; if (n >= 512 && n < 768) sc = ((n - 512) >> 6) * 128 + ((n - 512) & 63); else if (n >= 768) sc = ((n - 768) >> 6) * 128 + 64 + ((n - 768) & 63); }
            conv_item(W, ldw, sc, ks, g, Wmla, 384, kb * 64, nblk * 32, scr, lane); continue; } r -= I_MLA;
        if (r < J_G) { const int nb_ = 4096 / 64, kb = r / nb_, nblk = r % nb_; conv_item_wide(w_in, NIN, C_GATE + nblk * 64, kb * 64, norm_mix, Win, D, kb * 64, 3072 + nblk * 64, scr, lane); continue; } r -= J_G;
        if (r < J_B) { const int nb_ = 4096 / 64, kb = r / nb_, nblk = r % nb_; const int n = nblk * 64;
            conv_item_wide(w_br + (size_t)(n >> 10) * 256 * D, D, n & 1023, kb * 64, nullptr, Wb, 256, kb * 64, n, scr, lane); continue; } r -= J_B;
        if (r < J_OUT) { const int nb_ = D / 64, kb = r / nb_, nblk = r % nb_; conv_item_wide(w_out, D, nblk * 64, kb * 64, nullptr, Wout, D, kb * 64, nblk * 64, scr, lane); continue; } r -= J_OUT;
        if (r < J_UP) { const int nb_ = FF / 64, kb = r / nb_, nblk = r % nb_; conv_item_wide(w_up, FF, nblk * 64, kb * 64, norm_mlp, Wup, D, kb * 64, nblk * 64, scr, lane); continue; } r -= J_UP;
        { const int nb_ = D / 64, kb = r / nb_, nblk = r % nb_; conv_item_wide(w_down, D, nblk * 64, kb * 64, nullptr, Wdown, FF, kb * 64, nblk * 64, scr, lane); }
    } while (false);
    }
}
__device__ __forceinline__ void conv_unit(const Ptrs& P, LAS unsigned char* lds, int c, const int wave0) {
    int tid_ = (wave0 << 6) | xl::fresh_lane(); asm volatile("" : "+v"(tid_));
    const int lane = tid_ & 63, wave = __builtin_amdgcn_readfirstlane(tid_ >> 6);
    LAS float* scr = (LAS float*)(lds + RING_OFF + wave * 16384);
    for (int k = 0; k < CV_CHUNK / NWAVES; ++k) { const int d = c * CV_CHUNK + wave + NWAVES * k;
        if (d < CV_ND) { if (d < CV_D0) conv_item_at(P, 0, CV_FIRST + d, scr, lane); else conv_item_at(P, 1, d - CV_D0, scr, lane); } }
    __syncthreads();
}
__device__ __forceinline__ void p0_convert(const Ptrs& P, LAS unsigned char* lds, int gw, int NGW, int wave, int lane) {
    unsigned char* ws = P.ws;
    {
        LAS float* scr = (LAS float*)(lds + RING_OFF + wave * 16384);
        const int hi = (P.li < 0) ? CV_NITEMS : CV_FIRST;
        for (int it = gw; it < hi; it += NGW) conv_item_at(P, 0, it, scr, lane);
    }
    {
        const int M = P.mrows;
        const float* x = P.in[0]; bf16* xb = (bf16*)(ws + WS_XB); float* ssa = (float*)(ws + WS_SSA);
        for (int m = gw; m < M; m += NGW) {
            const GAS f32x4* xr = (const GAS f32x4*)(x + (size_t)m * D) + lane;
            f32x4 v[4]; float s = 0.f;
#pragma unroll
            for (int j = 0; j < 4; ++j) { v[j] = xr[64 * j]; s += (v[j].x * v[j].x + v[j].y * v[j].y) + (v[j].z * v[j].z + v[j].w * v[j].w); }
            s = wave_sum(s);
            GAS unsigned long long* o8 = (GAS unsigned long long*)(xb + (size_t)m * D) + lane;
#pragma unroll
            for (int j = 0; j < 4; ++j) o8[64 * j] = (unsigned long long)pk2(v[j].x, v[j].y) | ((unsigned long long)pk2(v[j].z, v[j].w) << 32);
            if (lane < 16) ssa[(size_t)m * 16 + lane] = (lane == 0) ? s : 0.f;
        }
        float* tp = (float*)(ws + WS_TP); float* ti = (float*)(ws + WS_TI); float* tm = (float*)(ws + WS_TM);
        const int gt = gw * 64 + lane, NGT = NGW * 64;
        for (int e = gt; e < S * 28; e += NGT) {
            const int t = e / 28, j = e % 28;
            int nrot, jj; float* dst; int nh;
            if (j < 8) { nrot = 16; jj = j; dst = tp + t * 16; nh = 8; } else if (j < 12) { nrot = 8; jj = j - 8; dst = ti + t * 8; nh = 4; } else { nrot = 32; jj = j - 12; dst = tm + t * 32; nh = 16; }
            const float inv_freq = 1.0f / powf(500000.0f, (float)(2 * jj) / (float)nrot);
            const float ang = (float)t * inv_freq;
            dst[jj] = cosf(ang); dst[nh + jj] = sinf(ang);
        }
    }
}

__device__ __forceinline__ int crow(int r, int hh) { return (r & 3) + 8 * (r >> 2) + 4 * hh; }
typedef float f32x2_t __attribute__((ext_vector_type(2))); typedef __bf16 bf16x2_t __attribute__((ext_vector_type(2)));
__device__ __forceinline__ unsigned cvtpk(float lo, float hi) { f32x2_t v = {lo, hi}; bf16x2_t b = __builtin_convertvector(v, bf16x2_t); return __builtin_bit_cast(unsigned, b); }
typedef short v4i16_t __attribute__((ext_vector_type(4)));
__device__ __forceinline__ s16x4 vtr(const LAS unsigned char* p) { return __builtin_bit_cast(s16x4, __builtin_amdgcn_ds_read_tr16_b64_v4i16((LAS v4i16_t*)p)); }
__device__ __forceinline__ float ex2(float x) { return __builtin_amdgcn_exp2f(x); }
__device__ __forceinline__ float lg2(float x) { return __builtin_amdgcn_logf(x); }
#define MFMA32(a, b, c) __builtin_amdgcn_mfma_f32_32x32x16_bf16((a), (b), (c), 0, 0, 0)

constexpr int VSTR = 144;
constexpr int KSTR64 = 144, KSTR96 = 208;
constexpr int AT_KBUF = 0, AT_VBUF = 2 * 64 * KSTR96, AT_END = AT_VBUF + 3 * 64 * VSTR;
constexpr int AT_KM = AT_END;
constexpr int AX_UNIT = 0, AX_FLAG = 1, AX_SBF = 8  , AX_SPRE = 32, AX_SREM = 64, AX_SCNT = 96, AX_THR = 128, AX_TB = 160, AX_TREM = 192;

struct MixCtx {
    const bf16* zt; size_t zts;
    const bf16* misc; const bf16* qm; const bf16* kn; const bf16* vm; const float* kmp;
    unsigned* bits; bf16* o4; size_t o4s;
    unsigned* diag;
    unsigned short* mlist; unsigned* mcnt; bf16* part; float* lse; bf16* dsa2; float* lsed;
};
struct TileRegs { v4u k, kx, v; };
template <bool MLA> __device__ __forceinline__ void tile_load(TileRegs& tr, const bf16* Kg, const bf16* Xg, const bf16* Vg, size_t rowbase, int key0, int hcol, int tid) {
    const int row = tid >> 3, ch = tid & 7;
    tr.k = *(const v4u*)(Kg + (rowbase + key0 + row) * 256 + hcol + ch * 8);
    tr.v = *(const v4u*)(Vg + (rowbase + key0 + row) * 256 + hcol + ch * 8);
    if (MLA) { if (tid < 256) { const int r2 = tid >> 2, c2 = tid & 3; tr.kx = *(const v4u*)(Xg + (rowbase + key0 + r2) * 128 + c2 * 8); } }
}
template <bool MLA, int KSTR> __device__ __forceinline__ void tile_store(const TileRegs& tr, LAS unsigned char* Kb, LAS unsigned char* Vb, int tid) {
    const int row = tid >> 3, ch = tid & 7;
    *(LAS v4u*)(Kb + row * KSTR + ch * 16) = tr.k;
    *(LAS v4u*)(Vb + row * VSTR + ch * 16) = tr.v;
    if (MLA) { if (tid < 256) { const int r2 = tid >> 2, c2 = tid & 3; *(LAS v4u*)(Kb + r2 * KSTR + 128 + c2 * 16) = tr.kx; } }
}
template <int NKS, int KSTR> __device__ __forceinline__ void qk_tile(f32x16& s0, f32x16& s1, const LAS unsigned char* Kb, const bf16x8 (&qf)[NKS], int lane, const f32x16 cinit = (f32x16){}) {
    const LAS unsigned char* kp = Kb + (lane & 31) * KSTR + (lane >> 5) * 16;
    s0 = cinit; s1 = cinit;
    bf16x8 a0 = *(const LAS bf16x8*)(kp), a1 = *(const LAS bf16x8*)(kp + 32 * KSTR);
    __builtin_amdgcn_sched_group_barrier(0x100, 2, 0);
#pragma unroll
    for (int ks = 0; ks < NKS; ++ks) {
        bf16x8 n0 = a0, n1 = a1;
        if (ks + 1 < NKS) { n0 = *(const LAS bf16x8*)(kp + (ks + 1) * 32); n1 = *(const LAS bf16x8*)(kp + 32 * KSTR + (ks + 1) * 32); }
        s0 = MFMA32(a0, qf[ks], s0); s1 = MFMA32(a1, qf[ks], s1);
        a0 = n0; a1 = n1;
        if (ks + 1 < NKS) { __builtin_amdgcn_sched_group_barrier(0x100, 2, 0); __builtin_amdgcn_sched_group_barrier(0x008, 2, 0); }
        else __builtin_amdgcn_sched_group_barrier(0x008, 2, 0);
    }
}
__device__ __forceinline__ bf16x8 packp(const f32x16& p, int b) {
    v4u w; w.x = cvtpk(p[b], p[b + 1]); w.y = cvtpk(p[b + 2], p[b + 3]); w.z = cvtpk(p[b + 4], p[b + 5]); w.w = cvtpk(p[b + 6], p[b + 7]);
    return __builtin_bit_cast(bf16x8, w);
}
__device__ __forceinline__ void pv_tile(f32x16& o0, f32x16& o1, const LAS unsigned char* Vb, const f32x16& p0, const f32x16& p1, int lane) {
    bf16x8 pb[4]; pb[0] = packp(p0, 0); pb[1] = packp(p0, 8); pb[2] = packp(p1, 0); pb[3] = packp(p1, 8);
    const int i = lane & 15, G = lane >> 4, hh = G >> 1;
    const LAS unsigned char* vp = Vb + (4 * hh + (i >> 2)) * VSTR + (16 * (G & 1) + 4 * (i & 3)) * 2;
    s16x4 l0 = vtr(vp), h0 = vtr(vp + 8 * VSTR), l1 = vtr(vp + 64), h1 = vtr(vp + 8 * VSTR + 64);
    __builtin_amdgcn_sched_group_barrier(0x100, 4, 0);
#pragma unroll
    for (int st = 0; st < 4; ++st) {
        s16x4 nl0 = l0, nh0 = h0, nl1 = l1, nh1 = h1;
        if (st + 1 < 4) { const LAS unsigned char* vq = vp + ((st + 1) * 16) * VSTR; nl0 = vtr(vq); nh0 = vtr(vq + 8 * VSTR); nl1 = vtr(vq + 64); nh1 = vtr(vq + 8 * VSTR + 64); }
        const bf16x8 f0 = (bf16x8){l0[0], l0[1], l0[2], l0[3], h0[0], h0[1], h0[2], h0[3]};
        const bf16x8 f1 = (bf16x8){l1[0], l1[1], l1[2], l1[3], h1[0], h1[1], h1[2], h1[3]};
        o0 = MFMA32(f0, pb[st], o0); o1 = MFMA32(f1, pb[st], o1);
        l0 = nl0; h0 = nh0; l1 = nl1; h1 = nh1;
        if (st + 1 < 4) { __builtin_amdgcn_sched_group_barrier(0x100, 4, 0); __builtin_amdgcn_sched_group_barrier(0x008, 2, 0); }
        else __builtin_amdgcn_sched_group_barrier(0x008, 2, 0);
    }
}
typedef float f32x2s __attribute__((ext_vector_type(2)));
constexpr float SM_THR = 6.0f;
__device__ __forceinline__ void softmax_tile(f32x16& s0, f32x16& s1, float& mref, bool& mset, f32x16& negm, float& l, f32x16& o0, f32x16& o1) {
    float mx = fmaxf(fmaxf(s0[0], s0[1]), s1[0]);
#pragma unroll
    for (int r = 1; r < 16; ++r) { mx = fmaxf(mx, s0[r]); if (r > 1) mx = fmaxf(mx, s1[r - 1]); }
    mx = fmaxf(mx, s1[15]); mx = fmaxf(mx, s1[0]);
    mx = xl::hmax(mx);
    float dl; const bool was_set = mset;
    if (!mset) { dl = (mx > -INFINITY) ? mx : 0.f; mset = mx > -INFINITY; } else dl = (mx > SM_THR) ? mx : 0.f;
    if (__any(dl != 0.f)) {
        const float alpha = was_set ? ex2(-dl) : 1.0f;
#pragma unroll
        for (int r = 0; r < 16; ++r) { s0[r] -= dl; s1[r] -= dl; o0[r] *= alpha; o1[r] *= alpha; }
        l *= alpha; mref += dl;
#pragma unroll
        for (int r = 0; r < 16; ++r) negm[r] = -mref;
    }
    float pa = 0.f, pb = 0.f;
#pragma unroll
    for (int r = 0; r < 16; ++r) { s0[r] = ex2(s0[r]); s1[r] = ex2(s1[r]);
        pa += s0[r]; asm("" : "+v"(pa)); pb += s1[r]; asm("" : "+v"(pb)); }
    l += pa + pb;
}
__device__ __forceinline__ void store_row64(bf16* dst, const f32x16& o0, const f32x16& o1, float inv, int hh, bool pred = true) {
#pragma unroll
    for (int k = 0; k < 4; k += 2) {
#pragma unroll
        for (int hf = 0; hf < 2; ++hf) {
            const f32x16& o = hf ? o1 : o0;
            const unsigned ax = cvtpk(o[4 * k] * inv, o[4 * k + 1] * inv), ay = cvtpk(o[4 * k + 2] * inv, o[4 * k + 3] * inv);
            const unsigned bx = cvtpk(o[4 * k + 4] * inv, o[4 * k + 5] * inv), by = cvtpk(o[4 * k + 6] * inv, o[4 * k + 7] * inv);
            const auto rx = __builtin_amdgcn_permlane32_swap(ax, bx, false, false); const auto ry = __builtin_amdgcn_permlane32_swap(ay, by, false, false);
            const v4u w = {rx[0], ry[0], rx[1], ry[1]};
            if (pred) *(v4u*)(dst + 32 * hf + 8 * k + 8 * hh) = w;
        }
    }
}
__device__ __forceinline__ void store_ot(bf16* O, size_t row, int hcol, const f32x16& o0, const f32x16& o1, float inv, int hh) { store_row64(O + row * 256 + hcol, o0, o1, inv, hh); }

#ifndef MK_ATTDRY
#define MK_ATTDRY 0
#endif
template <int KIND> __device__ __forceinline__ void softmax_unit(const MixCtx& C, int b, int h, int qb, LAS unsigned char* lds, const int wave0, const int dry = 0, const int half = -1) {
    const int dm = dry ? MK_ATTDRY : 0;
    constexpr bool MLA = (KIND == 0);
    constexpr int NKS = MLA ? 6 : 4, KSTR = MLA ? KSTR96 : KSTR64;
    int tid_ = (wave0 << 6) | xl::fresh_lane(); asm volatile("" : "+v"(tid_));
    const int tid = tid_, lane = tid & 63, r32 = lane & 31, hh = lane >> 5, wave = __builtin_amdgcn_readfirstlane(tid >> 6);
    const size_t rowbase = (size_t)b * S; const int q0 = qb * 256, qw = q0 + 32 * wave, t = qw + r32; const int hcol = h * 64;
    const bf16* Kg = MLA ? C.kn : (KIND == 1 ? C.zt + 1 * C.zts : C.zt + 8 * C.zts);
    const bf16* Vg = MLA ? C.vm : (KIND == 1 ? C.zt + 2 * C.zts : C.zt + 9 * C.zts);
    LAS unsigned char* Kb0 = lds + RING_OFF + AT_KBUF; LAS unsigned char* Vb0 = lds + RING_OFF + AT_VBUF;
    bf16x8 qf[NKS];
    if (MLA) {
#pragma unroll
        for (int ks = 0; ks < NKS; ++ks) qf[ks] = *(const bf16x8*)(C.qm + (rowbase + t) * 384 + h * 96 + 16 * ks + 8 * hh);
    } else {
        const bf16* Qg = (KIND == 1) ? C.zt : C.zt + 7 * C.zts;
#pragma unroll
        for (int ks = 0; ks < NKS; ++ks) qf[ks] = *(const bf16x8*)(Qg + (rowbase + t) * 256 + hcol + 16 * ks + 8 * hh);
    }
    const int NTall = 4 * qb + 4;
    const int jlo = (half == 1) ? NTall / 2 : 0, NT = (half == 0) ? NTall / 2 : NTall;
    TileRegs tr;
    tile_load<MLA>(tr, Kg, C.misc, Vg, rowbase, 64 * jlo, hcol, tid);
    unsigned selmask = 0u;
    if (KIND == 2) {
        LAS float* km = (LAS float*)(lds + RING_OFF + AT_KM);
        for (int e = tid; e < 32 * 64; e += NTHR) { const int n = e >> 6, d = e & 63; const float* p = C.kmp + (size_t)((b * 32 + n) * 2) * 256 + hcol + d; km[e] = (p[0] + p[256]) * (1.0f / 256.0f); }
        __syncthreads();
        float qv[32];
#pragma unroll
        for (int ks = 0; ks < 4; ++ks)
#pragma unroll
            for (int j = 0; j < 8; ++j) qv[ks * 8 + j] = bf2f((unsigned short)qf[ks][j]);
        float g0 = -INFINITY, g1 = -INFINITY, g2 = -INFINITY; int i0 = -1, i1 = -1, i2 = -1;
        for (int n = 0; n < qb; ++n) {
            const LAS float* kp = km + n * 64 + 8 * hh;
            float dot = 0.f;
#pragma unroll
            for (int ks = 0; ks < 4; ++ks) { const f32x4 a = *(const LAS f32x4*)(kp + 16 * ks), c = *(const LAS f32x4*)(kp + 16 * ks + 4);
                dot += qv[ks * 8 + 0] * a[0] + qv[ks * 8 + 1] * a[1] + qv[ks * 8 + 2] * a[2] + qv[ks * 8 + 3] * a[3] + qv[ks * 8 + 4] * c[0] + qv[ks * 8 + 5] * c[1] + qv[ks * 8 + 6] * c[2] + qv[ks * 8 + 7] * c[3]; }
            dot = xl::hsum(dot);
            if (dot > g0) { g2 = g1; i2 = i1; g1 = g0; i1 = i0; g0 = dot; i0 = n; }
            else if (dot > g1) { g2 = g1; i2 = i1; g1 = dot; i1 = n; }
            else if (dot > g2) { g2 = dot; i2 = n; }
        }
        if (i0 >= 0) selmask |= 1u << i0; if (i1 >= 0) selmask |= 1u << i1; if (i2 >= 0) selmask |= 1u << i2;
    }
    tile_store<MLA, KSTR>(tr, Kb0, Vb0, tid);
    __syncthreads();
    f32x16 o0 = {}, o1 = {}, negm = {}; float mref = 0.f, l = 0.f; bool mset = false;
    v2u wv_next = (v2u){0u, 0u};
    if (KIND == 1) wv_next = *(const v2u*)(C.bits + (rowbase + t) * 256 + 2 * jlo);
    const bool late = false;
    f32x16 c0 = {}, c1 = {}; bool cact = false;
    auto do_qk = [&](int j, const v2u wv, f32x16& s0, f32x16& s1) {
        qk_tile<NKS, KSTR>(s0, s1, Kb0 + ((j - jlo) & 1) * 64 * KSTR, qf, lane, negm);
        if (KIND == 1) {
            const unsigned w0 = wv.x >> (4 * hh), w1 = wv.y >> (4 * hh);
#pragma unroll
            for (int r = 0; r < 16; ++r) { const unsigned pos = (unsigned)((r & 3) + 8 * (r >> 2));
                const unsigned m0 = (unsigned)__builtin_amdgcn_sbfe((int)w0, pos, 1u), m1 = (unsigned)__builtin_amdgcn_sbfe((int)w1, pos, 1u);
                s0[r] = __uint_as_float((m0 & __float_as_uint(s0[r])) | (~m0 & 0xff800000u)); s1[r] = __uint_as_float((m1 & __float_as_uint(s1[r])) | (~m1 & 0xff800000u)); }
        } else {
            const bool past_blk = (KIND == 2) && ((j >> 2) < qb);
            if (past_blk) { if (!((selmask >> (j >> 2)) & 1u)) { s0 = s0 - INFINITY; s1 = s1 - INFINITY; } }
            else if (64 * j + 63 > qw) {
#pragma unroll
                for (int r = 0; r < 16; ++r) { const int kk = 64 * j + crow(r, hh); if (kk > t) s0[r] = -INFINITY; if (kk + 32 > t) s1[r] = -INFINITY; }
            }
        }
    };
    int vprev = 2 * 64 * VSTR, vcur = 0, vnext = 64 * VSTR;
    for (int j = jlo; j < NT; ++j) {
        v2u wv = wv_next;
        bool act = 64 * j <= qw + 31;
        if (KIND == 1) {
            unsigned long long bal = __ballot((wv.x | wv.y) != 0u); asm volatile("" : "+s"(bal) :: "memory");
            if (act) act = bal != 0ull; }
        if (j + 1 < NT && !(dm & 16)) tile_load<MLA>(tr, Kg, C.misc, Vg, rowbase, 64 * (j + 1), hcol, tid);
        if (KIND == 1) { if (64 * (j + 1) <= qw + 31) wv_next = *(const v2u*)(C.bits + (rowbase + t) * 256 + 2 * (j + 1)); }
        if (KIND == 2) { const int n = j >> 2; if (n < qb) act = __any((selmask >> n) & 1u); }
        if (!late) {
            if (act) { f32x16 s0, s1; if (dm & 8) { s0 = negm; s1 = negm; } else do_qk(j, wv, s0, s1); if (!(dm & 2)) softmax_tile(s0, s1, mref, mset, negm, l, o0, o1); if (!(dm & 4)) pv_tile(o0, o1, Vb0 + vcur, s0, s1, lane); else { o0 += s0; o1 += s1; } }
        } else {
            if (cact) { softmax_tile(c0, c1, mref, mset, negm, l, o0, o1); pv_tile(o0, o1, Vb0 + vprev, c0, c1, lane); }
            cact = act;
            if (act) do_qk(j, wv, c0, c1);
        }
        if (j + 1 < NT && !(dm & 16)) tile_store<MLA, KSTR>(tr, Kb0 + ((j + 1 - jlo) & 1) * 64 * KSTR, Vb0 + vnext, tid);
        __syncthreads();
        { const int tmp = vprev; vprev = vcur; vcur = vnext; vnext = tmp; }
    }
    if (late && cact) { softmax_tile(c0, c1, mref, mset, negm, l, o0, o1); pv_tile(o0, o1, Vb0 + vprev, c0, c1, lane); }
    __syncthreads();
    l = xl::hsum(l);
    const int branch = MLA ? 3 : (KIND == 1 ? 0 : 2);
    if (KIND == 1 && half >= 0) {
        const float inv = (l > 0.f) ? 1.0f / l : 0.f;
        store_ot(half == 0 ? C.o4 : C.dsa2, rowbase + t, hcol, o0, o1, inv, hh);
        if (hh == 0) C.lsed[((rowbase + t) * 4 + h) * 2 + half] = (l > 0.f) ? mref + lg2(l) : -INFINITY;
    } else
    if (!(dm & 1)) store_ot(C.o4 + branch * C.o4s, rowbase + t, hcol, o0, o1, 1.0f / l, hh);
    else { float x = l; for (int r = 0; r < 16; ++r) x += o0[r] + o1[r]; asm volatile("" :: "v"(x)); }
}

__device__ __forceinline__ float sb_block(f32x16& z, int kbase, int t, int hh, float cin) {
    float lf[16];
#pragma unroll
    for (int r = 0; r < 16; ++r) {
        const float zz = z[r]; const float e = ex2(-fabsf(zz) * LOG2E);
        const float sp = fmaxf(zz, 0.f) + lg2(1.0f + e) * LN2;
        lf[r] = (kbase + crow(r, hh) < t) ? -sp : 0.f;
    }
    float gs[4], pg[4];
#pragma unroll
    for (int g = 0; g < 4; ++g) { gs[g] = (lf[4 * g] + lf[4 * g + 1]) + (lf[4 * g + 2] + lf[4 * g + 3]); float lo_, hi_; xl::halves(gs[g], lo_, hi_); pg[g] = hh ? lo_ : hi_; }
    float run = 0.f;
#pragma unroll
    for (int g = 3; g >= 0; --g) {
        const float base = cin + run + (hh == 0 ? pg[g] : 0.f);
        const float l3 = base, l2 = l3 + lf[4 * g + 3], l1 = l2 + lf[4 * g + 2], l0 = l1 + lf[4 * g + 1];
        const float la[4] = {l0, l1, l2, l3};
#pragma unroll
        for (int e = 0; e < 4; ++e) { const int r = 4 * g + e; const bool past = kbase + crow(r, hh) < t; z[r] = past ? ex2((z[r] + lf[r] + la[e]) * LOG2E) : 0.f; }
        run += gs[g] + pg[g];
    }
    return run;
}
__device__ __forceinline__ void sb_unit(const MixCtx& C, int b, int h, int qb, LAS unsigned char* lds, const int wave0) {
    int tid_ = (wave0 << 6) | xl::fresh_lane(); asm volatile("" : "+v"(tid_));
    const int tid = tid_, lane = tid & 63, r32 = lane & 31, hh = lane >> 5, wave = __builtin_amdgcn_readfirstlane(tid >> 6);
    const size_t rowbase = (size_t)b * S; const int q0 = qb * 256, qw = q0 + 32 * wave, t = qw + r32; const int hcol = h * 64;
    const bf16* Qg = C.zt + 4 * C.zts; const bf16* Kg = C.zt + 5 * C.zts; const bf16* Vg = C.zt + 6 * C.zts;
    LAS unsigned char* Kb0 = lds + RING_OFF + AT_KBUF; LAS unsigned char* Vb0 = lds + RING_OFF + AT_VBUF;
    volatile LAS unsigned* aux = (volatile LAS unsigned*)(lds + AUX_OFF);
    bf16x8 qf[4];
#pragma unroll
    for (int ks = 0; ks < 4; ++ks) qf[ks] = *(const bf16x8*)(Qg + (rowbase + t) * 256 + hcol + 16 * ks + 8 * hh);
    const int NT = 4 * qb + 4;
    TileRegs tr;
    tile_load<false>(tr, Kg, nullptr, Vg, rowbase, 64 * (NT - 1), hcol, tid);
    tile_store<false, KSTR64>(tr, Kb0, Vb0, tid);
    __syncthreads();
    f32x16 o0 = {}, o1 = {}; float carry = 0.f;
    for (int it = 0; it < NT; ++it) {
        const int j = NT - 1 - it, cur = it & 1;
        if (j > 0) tile_load<false>(tr, Kg, nullptr, Vg, rowbase, 64 * (j - 1), hcol, tid);
        if (64 * j < qw + 31) {
            f32x16 s0, s1;
            qk_tile<4, KSTR64>(s0, s1, Kb0 + cur * 64 * KSTR64, qf, lane);
            const float b1 = sb_block(s1, 64 * j + 32, t, hh, carry);
            const float b0 = sb_block(s0, 64 * j, t, hh, carry + b1);
            carry += b1 + b0;
            pv_tile(o0, o1, Vb0 + cur * 64 * VSTR, s0, s1, lane);
        }
        const bool wdone = __all(carry < -110.0f);
        if (lane == 0) aux[AX_SBF + cur * 8 + wave] = wdone ? 1u : 0u;
        if (j > 0) tile_store<false, KSTR64>(tr, Kb0 + (cur ^ 1) * 64 * KSTR64, Vb0 + (cur ^ 1) * 64 * VSTR, tid);
        __syncthreads();
        const LAS v4u* fl = (const LAS v4u*)(lds + AUX_OFF + 4 * (AX_SBF + cur * 8));
        const v4u f0 = fl[0], f1 = fl[1];
        if ((f0.x & f0.y & f0.z & f0.w) & (f1.x & f1.y & f1.z & f1.w)) break;
    }
    __syncthreads();
    store_ot(C.o4 + 1 * C.o4s, rowbase + t, hcol, o0, o1, 1.0f, hh);
}

__device__ __forceinline__ unsigned fkey(float f) { const int u = (int)__float_as_uint(f + 0.0f); return (unsigned)u ^ ((unsigned)(u >> 31) | 0x80000000u); }
__device__ __forceinline__ void idx_keys(unsigned (&key)[16], const bf16* misc, size_t rowbase, int kb, const bf16x8 (&qf)[16], const float (&w)[8], int r32, int hh) {
    const bf16* kr = misc + (rowbase + kb * 32 + r32) * 128 + 32 + 8 * hh;
    const bf16x8 k0 = *(const bf16x8*)kr, k1 = *(const bf16x8*)(kr + 16);
    float sc[16];
#pragma unroll
    for (int hd = 0; hd < 8; ++hd) {
        f32x16 s = MFMA32(k0, qf[2 * hd], (f32x16){});
        s = MFMA32(k1, qf[2 * hd + 1], s);
#pragma unroll
        for (int r = 0; r < 16; ++r) { const float v = fmaxf(s[r], 0.f); sc[r] = (hd == 0) ? w[0] * v : __builtin_fmaf(w[hd], v, sc[r]); }
        if (hd & 1) {
#pragma unroll
            for (int r = 0; r < 16; ++r) asm volatile("" : "+v"(sc[r]));
            __builtin_amdgcn_sched_barrier(0);
        }
    }
#pragma unroll
    for (int r = 0; r < 16; ++r) key[r] = fkey(sc[r]);
}
template <bool DESC, bool PEEK = false, bool RAW = false> __device__ __forceinline__ void hist_scan(volatile LAS unsigned* hist, int rowstride, int nbins, bool swz, int preshift, volatile LAS unsigned* aux, int tid) {
    const int q = tid >> 4, c = tid & 15, lane = tid & 63, wpc = nbins >> 5, sx = swz ? q : 0;
    unsigned csum = 0u;
    for (int i = 0; i < wpc; ++i) { const unsigned w = hist[q * rowstride + ((c * wpc + ((i + c) & (wpc - 1))) ^ sx)]; csum += (w & 0xffffu) + (w >> 16); }
    unsigned other = 0u;
#pragma unroll
    for (int k = 0; k < 16; ++k) { unsigned v; switch (k) { case 0: v = xl::bcast16<0>(csum); break; case 1: v = xl::bcast16<1>(csum); break; case 2: v = xl::bcast16<2>(csum); break; case 3: v = xl::bcast16<3>(csum); break; case 4: v = xl::bcast16<4>(csum); break; case 5: v = xl::bcast16<5>(csum); break; case 6: v = xl::bcast16<6>(csum); break; case 7: v = xl::bcast16<7>(csum); break; case 8: v = xl::bcast16<8>(csum); break; case 9: v = xl::bcast16<9>(csum); break; case 10: v = xl::bcast16<10>(csum); break; case 11: v = xl::bcast16<11>(csum); break; case 12: v = xl::bcast16<12>(csum); break; case 13: v = xl::bcast16<13>(csum); break; case 14: v = xl::bcast16<14>(csum); break; default: v = xl::bcast16<15>(csum); break; }
        if (RAW ? (c < 8 ? (k > c && k < 8) : (k < c)) : (DESC ? (k > c) : (k < c))) other += v; }
    const unsigned rem = aux[AX_SREM + q];
    if (other < rem && other + csum >= rem) {
        unsigned cum = other; bool found = false; unsigned bin = 0u, cnt = 0u;
        const bool dsc = RAW ? (c < 8) : DESC;
        for (int ii = 0; ii < wpc; ++ii) {
            const int i = dsc ? (wpc - 1 - ii) : ii;
            const unsigned w = hist[q * rowstride + ((c * wpc + i) ^ sx)];
            const unsigned first = dsc ? (w >> 16) : (w & 0xffffu), second = dsc ? (w & 0xffffu) : (w >> 16);
            if (!found) { if (cum + first >= rem) { found = true; bin = 2u * (unsigned)(c * wpc + i) + (dsc ? 1u : 0u); cnt = first; } else cum += first; }
            if (!found) { if (cum + second >= rem) { found = true; bin = 2u * (unsigned)(c * wpc + i) + (dsc ? 0u : 1u); cnt = second; } else cum += second; }
        }
        if (PEEK) { aux[AX_TB + q] = bin; }
        else {
        aux[AX_SPRE + q] = (aux[AX_SPRE + q] << preshift) | bin;
        aux[AX_SREM + q] = rem - cum; aux[AX_SCNT + q] = cnt;
        if (!DESC) { aux[AX_TB + q] = bin; aux[AX_TREM + q] = rem - cum; }
        }
    }
}
__device__ __forceinline__ void hist_zero(LAS unsigned char* lds, int tid) {
    LAS v4u* h4 = (LAS v4u*)(lds + RING_OFF);
    for (int i = tid; i < 8192; i += NTHR) h4[i] = (v4u){0u, 0u, 0u, 0u};
}
__device__ __forceinline__ void sel_unit_slow(const MixCtx& C, int b, int qg, LAS unsigned char* lds, const int wave0) {
    int tid_ = (wave0 << 6) | xl::fresh_lane(); asm volatile("" : "+v"(tid_));
    const int tid = tid_, lane = tid & 63, r32 = lane & 31, hh = lane >> 5, wave = __builtin_amdgcn_readfirstlane(tid >> 6);
    const size_t rowbase = (size_t)b * S; const int t = 32 * qg + r32;
    volatile LAS unsigned* hist = (volatile LAS unsigned*)(lds + RING_OFF);
    LAS unsigned* histw = (LAS unsigned*)(lds + RING_OFF);
    volatile LAS unsigned* aux = (volatile LAS unsigned*)(lds + AUX_OFF);
    bf16x8 qf[16]; float w[8];
    { const bf16* qp = C.zt + 3 * C.zts + (rowbase + t) * 256 + 8 * hh;
#pragma unroll
      for (int i = 0; i < 16; ++i) qf[i] = *(const bf16x8*)(qp + 16 * i);
      const v4u wr = *(const v4u*)(C.misc + (rowbase + t) * 128 + 64);
      w[0] = __uint_as_float(wr.x << 16); w[1] = __uint_as_float(wr.x & 0xffff0000u); w[2] = __uint_as_float(wr.y << 16); w[3] = __uint_as_float(wr.y & 0xffff0000u);
      w[4] = __uint_as_float(wr.z << 16); w[5] = __uint_as_float(wr.z & 0xffff0000u); w[6] = __uint_as_float(wr.w << 16); w[7] = __uint_as_float(wr.w & 0xffff0000u); }
    const int kb_last = 8 * (qg >> 3) + 7;
    if (tid < 32) { aux[AX_SPRE + tid] = 0u; aux[AX_SREM + tid] = 256u; aux[AX_SCNT + tid] = 0u; aux[AX_THR + tid] = 0u; aux[AX_TB + tid] = 0x7fffffffu; aux[AX_TREM + tid] = 0u; }
    if (tid == 0) aux[AX_FLAG] = 0u;
    if (qg >= 8) {
        for (int pass = 0; pass < 3; ++pass) {
            hist_zero(lds, tid);
            __syncthreads();
            const unsigned pre = aux[AX_SPRE + r32];
            for (int kb = wave; kb <= qg; kb += 8) {
                unsigned key[16];
                idx_keys(key, C.misc, rowbase, kb, qf, w, r32, hh);
#pragma unroll
                for (int r = 0; r < 16; ++r) {
                    const bool valid = kb * 32 + crow(r, hh) <= t;
                    const unsigned k = key[r];
                    bool match; unsigned bin;
                    if (pass == 0) { match = true; bin = k >> 21; } else if (pass == 1) { match = (k >> 21) == pre; bin = (k >> 10) & 2047u; } else { match = (k >> 10) == pre; bin = k & 1023u; }
                    if (valid && match) __hip_atomic_fetch_add(histw + r32 * 1024 + ((bin >> 1) ^ (unsigned)r32), 1u << (16 * (bin & 1u)), __ATOMIC_RELAXED, __HIP_MEMORY_SCOPE_WORKGROUP);
                }
            }
            __syncthreads();
            hist_scan<true>(hist, 1024, pass == 2 ? 1024 : 2048, true, pass == 2 ? 10 : 11, aux, tid);
            __syncthreads();
        }
        if (tid < 32) { aux[AX_THR + tid] = aux[AX_SPRE + tid]; if (aux[AX_SREM + tid] < aux[AX_SCNT + tid]) aux[AX_FLAG] = 1u; }
        __syncthreads();
        if (aux[AX_FLAG] != 0u) {
            hist_zero(lds, tid);
            __syncthreads();
            const unsigned thr = aux[AX_THR + r32];
            for (int kb = wave; kb <= qg; kb += 8) {
                unsigned key[16];
                idx_keys(key, C.misc, rowbase, kb, qf, w, r32, hh);
#pragma unroll
                for (int r = 0; r < 16; ++r) {
                    const int s = kb * 32 + crow(r, hh);
                    if (s <= t && key[r] == thr) { const unsigned bin = (unsigned)s >> 2; __hip_atomic_fetch_add(histw + r32 * 1024 + ((bin >> 1) ^ (unsigned)r32), 1u << (16 * (bin & 1u)), __ATOMIC_RELAXED, __HIP_MEMORY_SCOPE_WORKGROUP); }
                }
            }
            __syncthreads();
            hist_scan<false>(hist, 1024, 2048, true, 11, aux, tid);
            __syncthreads();
        }
    }
    __syncthreads();
    {
        const unsigned thr = aux[AX_THR + r32]; const unsigned tb = aux[AX_TB + r32], trem = aux[AX_TREM + r32];
        for (int kb = wave; kb <= kb_last; kb += 8) {
            unsigned word = 0u;
            if (kb <= qg) {
                unsigned key[16];
                idx_keys(key, C.misc, rowbase, kb, qf, w, r32, hh);
#pragma unroll
                for (int g = 0; g < 4; ++g) {
                    unsigned rank = 0u; const unsigned s4 = (unsigned)(kb * 8 + 2 * g + hh);
#pragma unroll
                    for (int e = 0; e < 4; ++e) {
                        const int r = 4 * g + e; const int s = kb * 32 + crow(r, hh);
                        const bool valid = s <= t; const unsigned k = key[r];
                        bool sel = valid && (k > thr);
                        if (valid && k == thr) { ++rank; sel = (s4 < tb) || (s4 == tb && rank <= trem); }
                        word |= (sel ? 1u : 0u) << crow(r, hh);
                    }
                }
            }
            word = xl::hor(word);
            if (hh == 0) C.bits[(rowbase + t) * 256 + kb] = word;
        }
    }
    __syncthreads();
}

constexpr int SL_CKEY = 0, SL_CIDX = 65536, SL_BITW = 98304;
constexpr int SL_SHIST = AUX_OFF + 2048;
constexpr int AX_CCNT = 224;
constexpr int SL_SAMP = SL_SHIST + 8192;
constexpr int SEL_RANK_MAX = 64;
__device__ __forceinline__ void idx_load(bf16x8& k0, bf16x8& k1, const bf16* misc, size_t rowbase, int kb, int r32, int hh) {
    const bf16* kr = misc + (rowbase + kb * 32 + r32) * 128 + 32 + 8 * hh; k0 = *(const bf16x8*)kr; k1 = *(const bf16x8*)(kr + 16);
}
typedef float f32x2v __attribute__((ext_vector_type(2)));
__device__ __forceinline__ float relu1(float x) { const int b = __float_as_int(x); return __int_as_float(b > 0 ? b : 0); }
__device__ __forceinline__ void idx_keys2(unsigned (&key)[16], const bf16x8 k0, const bf16x8 k1, const bf16x8 (&qf)[16], const float (&w)[8]) {
    f32x2v sc[8];
#pragma unroll
    for (int hd = 0; hd < 8; ++hd) {
        f32x16 s = MFMA32(k0, qf[2 * hd], (f32x16){});
        s = MFMA32(k1, qf[2 * hd + 1], s);
        const f32x2v w2 = {w[hd], w[hd]};
#pragma unroll
        for (int j = 0; j < 8; ++j) { const f32x2v v = {relu1(s[2 * j]), relu1(s[2 * j + 1])}; sc[j] = (hd == 0) ? v * w2 : __builtin_elementwise_fma(v, w2, sc[j]); }
        if (hd & 1) {
#pragma unroll
            for (int j = 0; j < 8; ++j) asm volatile("" : "+v"(sc[j]));
            __builtin_amdgcn_sched_barrier(0);
        }
    }
#pragma unroll
    for (int j = 0; j < 8; ++j) { key[2 * j] = fkey(sc[j].x); key[2 * j + 1] = fkey(sc[j].y); }
}
__device__ __forceinline__ void idx_keys3(unsigned (&key)[16], const bf16x8 k0, const bf16x8 k1, const bf16x8 (&qf)[16], const float (&w2)[8], const bf16x8 ql0, const bf16x8 ql1) {
    float sc[16];
    { f32x16 lin = MFMA32(k0, ql0, (f32x16){}); lin = MFMA32(k1, ql1, lin);
#pragma unroll
      for (int r = 0; r < 16; ++r) sc[r] = lin[r]; }
#pragma unroll
    for (int hd = 0; hd < 8; ++hd) {
        f32x16 s = MFMA32(k0, qf[2 * hd], (f32x16){});
        s = MFMA32(k1, qf[2 * hd + 1], s);
#pragma unroll
        for (int r = 0; r < 16; ++r) sc[r] = __builtin_fmaf(__builtin_fabsf(s[r]), w2[hd], sc[r]);
        if (hd & 1) {
#pragma unroll
            for (int r = 0; r < 16; ++r) asm volatile("" : "+v"(sc[r]));
            __builtin_amdgcn_sched_barrier(0);
        }
    }
#pragma unroll
    for (int r = 0; r < 16; ++r) key[r] = __float_as_uint(sc[r]);
}
__device__ __forceinline__ void idx_scores(float (&y)[16], bf16x8 k0, bf16x8 k1, const bf16x8 (&qf)[16], const float (&ws)[8], const bf16x8 ql0, const bf16x8 ql1, const float scale, const float off) {
    __builtin_amdgcn_sched_barrier(0);
    asm volatile("" : "+v"(k0), "+v"(k1));
    f32x16 a = MFMA32(k0, ql0, (f32x16){}); a = MFMA32(k1, ql1, a);
    f32x16 c = MFMA32(k0, qf[0], (f32x16){}); c = MFMA32(k1, qf[1], c);
#pragma unroll
    for (int r = 0; r < 16; ++r) y[r] = __builtin_fmaf(a[r], scale, off);
#pragma unroll
    for (int hd = 0; hd < 8; ++hd) {
        if (hd & 1) {
            if (hd + 1 < 8) { c = MFMA32(k0, qf[2 * hd + 2], (f32x16){}); c = MFMA32(k1, qf[2 * hd + 3], c); }
#pragma unroll
            for (int r = 0; r < 16; ++r) y[r] = __builtin_fmaf(__builtin_fabsf(a[r]), ws[hd], y[r]);
        } else {
            if (hd + 1 < 8) { a = MFMA32(k0, qf[2 * hd + 2], (f32x16){}); a = MFMA32(k1, qf[2 * hd + 3], a); }
#pragma unroll
            for (int r = 0; r < 16; ++r) y[r] = __builtin_fmaf(__builtin_fabsf(c[r]), ws[hd], y[r]);
        }
    }
    __builtin_amdgcn_sched_group_barrier(0x008, 4, 0); __builtin_amdgcn_sched_group_barrier(0x002, 16, 0);
    __builtin_amdgcn_sched_group_barrier(0x008, 2, 0); __builtin_amdgcn_sched_group_barrier(0x002, 16, 0);
    __builtin_amdgcn_sched_group_barrier(0x008, 2, 0); __builtin_amdgcn_sched_group_barrier(0x002, 16, 0);
    __builtin_amdgcn_sched_group_barrier(0x008, 2, 0); __builtin_amdgcn_sched_group_barrier(0x002, 16, 0);
    __builtin_amdgcn_sched_group_barrier(0x008, 2, 0); __builtin_amdgcn_sched_group_barrier(0x002, 16, 0);
    __builtin_amdgcn_sched_group_barrier(0x008, 2, 0); __builtin_amdgcn_sched_group_barrier(0x002, 16, 0);
    __builtin_amdgcn_sched_group_barrier(0x008, 2, 0); __builtin_amdgcn_sched_group_barrier(0x002, 16, 0);
    __builtin_amdgcn_sched_group_barrier(0x008, 2, 0); __builtin_amdgcn_sched_group_barrier(0x002, 16, 0);
    __builtin_amdgcn_sched_group_barrier(0x002, 16, 0);
#pragma unroll
    for (int r = 0; r < 16; ++r) asm volatile("" : "+v"(y[r]));
    __builtin_amdgcn_sched_barrier(0);
}
__device__ __forceinline__ void hist_scan32(const LAS unsigned* hist, volatile LAS unsigned* aux, int tid) {
    const int q = tid >> 4, c = tid & 15;
    const LAS v4u* h4 = (const LAS v4u*)(hist + q * 1024 + c * 64);
    unsigned csum = 0u;
#pragma unroll
    for (int j = 0; j < 16; ++j) { const v4u w = h4[(j + c + q) & 15]; csum += (w.x + w.y) + (w.z + w.w); }
    unsigned other = 0u;
#pragma unroll
    for (int k = 0; k < 16; ++k) { unsigned v; switch (k) { case 0: v = xl::bcast16<0>(csum); break; case 1: v = xl::bcast16<1>(csum); break; case 2: v = xl::bcast16<2>(csum); break; case 3: v = xl::bcast16<3>(csum); break; case 4: v = xl::bcast16<4>(csum); break; case 5: v = xl::bcast16<5>(csum); break; case 6: v = xl::bcast16<6>(csum); break; case 7: v = xl::bcast16<7>(csum); break; case 8: v = xl::bcast16<8>(csum); break; case 9: v = xl::bcast16<9>(csum); break; case 10: v = xl::bcast16<10>(csum); break; case 11: v = xl::bcast16<11>(csum); break; case 12: v = xl::bcast16<12>(csum); break; case 13: v = xl::bcast16<13>(csum); break; case 14: v = xl::bcast16<14>(csum); break; default: v = xl::bcast16<15>(csum); break; }
        if (k > c) other += v; }
    const unsigned rem = aux[AX_SREM + q];
    if (other < rem && other + csum >= rem) {
        unsigned cum = other; bool found = false; unsigned bin = 0u, cnt = 0u;
#pragma unroll 4
        for (int jj = 15; jj >= 0; --jj) {
            const v4u w = h4[jj]; const unsigned hv[4] = {w.w, w.z, w.y, w.x};
#pragma unroll
            for (int e = 0; e < 4; ++e) { if (!found) { if (cum + hv[e] >= rem) { found = true; bin = (unsigned)(c * 64 + 4 * jj + 3 - e); cnt = hv[e]; } else cum += hv[e]; } }
        }
        aux[AX_SPRE + q] = bin; aux[AX_SREM + q] = rem - cum; aux[AX_SCNT + q] = cnt;
    }
}
#ifndef MK_SELDRY
#define MK_SELDRY 0
#endif
__device__ __forceinline__ void sel_unit(const MixCtx& C, int b, int qg, LAS unsigned char* lds, const int wave0, const int dry = 0) {
    const int dm = dry ? MK_SELDRY : 0;
    int tid_ = (wave0 << 6) | xl::fresh_lane(); asm volatile("" : "+v"(tid_));
    const int tid = tid_, lane = tid & 63, r32 = lane & 31, hh = lane >> 5, wave = __builtin_amdgcn_readfirstlane(tid >> 6);
    const size_t rowbase = (size_t)b * S; const int t = 32 * qg + r32;
    const int kb_last = 8 * (qg >> 3) + 7;
    LAS unsigned* histw = (LAS unsigned*)(lds + RING_OFF);
    volatile LAS unsigned* hist = (volatile LAS unsigned*)(lds + RING_OFF);
    volatile LAS unsigned* aux = (volatile LAS unsigned*)(lds + AUX_OFF);
    LAS unsigned* ckey = (LAS unsigned*)(lds + RING_OFF + SL_CKEY); LAS unsigned short* cidx = (LAS unsigned short*)(lds + RING_OFF + SL_CIDX);
    LAS unsigned* bitw = (LAS unsigned*)(lds + RING_OFF + SL_BITW); LAS unsigned* shist = (LAS unsigned*)(lds + SL_SHIST);
    LAS unsigned* auxw = (LAS unsigned*)(lds + AUX_OFF);
    if (qg < 8) {
        { const int q = tid >> 4, tq = 32 * qg + q;
          for (int kb = tid & 15; kb <= kb_last; kb += 16) { const int nbit = tq + 1 - 32 * kb; const unsigned word = nbit <= 0 ? 0u : (nbit >= 32 ? 0xffffffffu : ((1u << nbit) - 1u));
            if (!(dm & 1)) C.bits[(rowbase + tq) * 256 + kb] = word; } }
        return;
    }
    bf16x8 qf[16]; float w[8];
    { const bf16* qp = C.zt + 3 * C.zts + (rowbase + t) * 256 + 8 * hh;
#pragma unroll
      for (int i = 0; i < 16; ++i) qf[i] = *(const bf16x8*)(qp + 16 * i);
      const v4u wr = *(const v4u*)(C.misc + (rowbase + t) * 128 + 64);
      w[0] = __uint_as_float(wr.x << 16); w[1] = __uint_as_float(wr.x & 0xffff0000u); w[2] = __uint_as_float(wr.y << 16); w[3] = __uint_as_float(wr.y & 0xffff0000u);
      w[4] = __uint_as_float(wr.z << 16); w[5] = __uint_as_float(wr.z & 0xffff0000u); w[6] = __uint_as_float(wr.w << 16); w[7] = __uint_as_float(wr.w & 0xffff0000u); }
    float w2[8]; bf16x8 ql0, ql1;
    {
#pragma unroll
        for (int hd = 0; hd < 8; ++hd) w2[hd] = 0.5f * w[hd];
        float a0[8], a1[8];
#pragma unroll
        for (int j = 0; j < 8; ++j) { a0[j] = 0.f; a1[j] = 0.f; }
#pragma unroll
        for (int hd = 0; hd < 8; ++hd)
#pragma unroll
            for (int j = 0; j < 8; ++j) { a0[j] = __builtin_fmaf(w2[hd], bf2f((unsigned short)qf[2 * hd][j]), a0[j]); a1[j] = __builtin_fmaf(w2[hd], bf2f((unsigned short)qf[2 * hd + 1][j]), a1[j]); }
        v4u p0, p1; p0.x = cvtpk(a0[0], a0[1]); p0.y = cvtpk(a0[2], a0[3]); p0.z = cvtpk(a0[4], a0[5]); p0.w = cvtpk(a0[6], a0[7]);
        p1.x = cvtpk(a1[0], a1[1]); p1.y = cvtpk(a1[2], a1[3]); p1.z = cvtpk(a1[4], a1[5]); p1.w = cvtpk(a1[6], a1[7]);
        ql0 = __builtin_bit_cast(bf16x8, p0); ql1 = __builtin_bit_cast(bf16x8, p1);
    }
    if (tid < 32) { aux[AX_SPRE + tid] = 0u; aux[AX_SREM + tid] = 256u; aux[AX_SCNT + tid] = 0u; aux[AX_CCNT + tid] = 0u; aux[AX_TB + tid] = 0u; }
    if (tid == 0) aux[AX_FLAG] = 0u;
    hist_zero(lds, tid);
    {
        LAS float* samp = (LAS float*)(lds + SL_SAMP);
        bf16x8 k0, k1; idx_load(k0, k1, C.misc, rowbase, (wave * qg) >> 3, r32, hh);
        float y[16]; idx_scores(y, k0, k1, qf, w2, ql0, ql1, 1.0f, 0.0f);
        float mx = y[0], mn = mx;
#pragma unroll
        for (int r = 1; r < 16; ++r) { mx = fmaxf(mx, y[r]); mn = fminf(mn, y[r]); }
        mx = xl::hmax(mx); mn = -xl::hmax(-mn);
        if (hh == 0) { samp[wave * 32 + r32] = mx; samp[256 + wave * 32 + r32] = mn; }
    }
    __syncthreads();
    float scale, off;
    { const LAS float* samp = (const LAS float*)(lds + SL_SAMP);
      float hi = samp[r32], lo = samp[256 + r32];
#pragma unroll
      for (int wv = 1; wv < 8; ++wv) { hi = fmaxf(hi, samp[wv * 32 + r32]); lo = fminf(lo, samp[256 + wv * 32 + r32]); }
      const float range = hi - lo; const bool ok = range > 1e-30f && range < 1e30f;
      scale = ok ? 1023.0f / (1.28f * range) : 0.f; off = ok ? (0.03f * range - lo) * scale : 0.f;
#pragma unroll
      for (int hd = 0; hd < 8; ++hd) w2[hd] *= scale; }
    __builtin_amdgcn_sched_barrier(0);
    {
        bf16x8 k0, k1, n0 = {}, n1 = {};
        int kb = wave;
        LAS unsigned* hrow = histw + r32 * 1024;
        if (kb <= qg) idx_load(k0, k1, C.misc, rowbase, kb, r32, hh);
#pragma unroll 1
        for (; kb <= qg && !(dm & 16); kb += 8) {
            idx_load(n0, n1, C.misc, rowbase, min(kb + 8, qg), r32, hh);
            float y[16];
            idx_scores(y, k0, k1, qf, w2, ql0, ql1, scale, off);
            if (dm & 2) { float x = 0.f;
#pragma unroll
                for (int r = 0; r < 16; ++r) x += y[r];
                asm volatile("" :: "v"(x)); }
            else if (kb < qg) {
#pragma unroll
                for (int r = 0; r < 16; ++r) { const unsigned bin = (unsigned)__builtin_amdgcn_fmed3f(y[r], 0.f, 1023.f); __hip_atomic_fetch_add(hrow + bin, 1u, __ATOMIC_RELAXED, __HIP_MEMORY_SCOPE_WORKGROUP); }
            } else {
#pragma unroll
                for (int r = 0; r < 16; ++r) {
                    if (crow(r, hh) <= r32) { const unsigned bin = (unsigned)__builtin_amdgcn_fmed3f(y[r], 0.f, 1023.f); __hip_atomic_fetch_add(hrow + bin, 1u, __ATOMIC_RELAXED, __HIP_MEMORY_SCOPE_WORKGROUP); }
                }
            }
            k0 = n0; k1 = n1;
        }
    }
    __syncthreads();
    hist_scan32(histw, aux, tid);
    __syncthreads();
    if (tid < 32) { if (aux[AX_SCNT + tid] > 512u) aux[AX_FLAG] = 1u; }
    __syncthreads();
    if (aux[AX_FLAG] != 0u && !dm) {
#if defined(MK_DIAG_FALLBACKS) && MK_DIAG_FALLBACKS == 1
        if (tid == 0) atomicAdd((unsigned*)C.diag, 1u);
#endif
        __syncthreads(); sel_unit_slow(C, b, qg, lds, wave0); return; }
    const unsigned b1 = aux[AX_SPRE + r32];
    const float Ef = b1 < 1023u ? (float)(b1 + 1u) : INFINITY, Lf = b1 > 0u ? (float)b1 : -INFINITY;
    unsigned vmr = 0u;
#pragma unroll
    for (int r = 0; r < 16; ++r) vmr |= (crow(r, hh) <= r32 ? 1u : 0u) << r;
    __syncthreads();
    if (tid < 32) { aux[AX_SPRE + tid] = 0u; }
    {
        bf16x8 k0, k1, n0 = {}, n1 = {};
        int kb = wave;
        if (kb <= qg) idx_load(k0, k1, C.misc, rowbase, kb, r32, hh);
#pragma unroll 1
        for (; kb <= kb_last && !(dm & 4); kb += 8) {
            unsigned word = 0u;
            if (kb <= qg) {
                idx_load(n0, n1, C.misc, rowbase, min(kb + 8, qg), r32, hh);
                float y[16];
                idx_scores(y, k0, k1, qf, w2, ql0, ql1, scale, off);
                const bool diag = (kb == qg);
                unsigned def = 0u, cd = 0u;
                { unsigned long long t0, t1, t2;
                  asm volatile("v_cmp_ge_f32_e64 %[s0], %[y15], %[ef]\n\tv_cmp_ge_f32_e64 %[s1], %[y15], %[lf]\n\tv_cmp_ge_f32_e64 %[s2], %[y14], %[ef]\n\tv_addc_co_u32_e64 %[d], vcc, %[d], %[d], %[s0]\n\tv_cmp_ge_f32_e64 %[s0], %[y14], %[lf]\n\tv_addc_co_u32_e64 %[c], vcc, %[c], %[c], %[s1]\n\tv_cmp_ge_f32_e64 %[s1], %[y13], %[ef]\n\tv_addc_co_u32_e64 %[d], vcc, %[d], %[d], %[s2]\n\tv_cmp_ge_f32_e64 %[s2], %[y13], %[lf]\n\tv_addc_co_u32_e64 %[c], vcc, %[c], %[c], %[s0]\n\tv_cmp_ge_f32_e64 %[s0], %[y12], %[ef]\n\tv_addc_co_u32_e64 %[d], vcc, %[d], %[d], %[s1]\n\tv_cmp_ge_f32_e64 %[s1], %[y12], %[lf]\n\tv_addc_co_u32_e64 %[c], vcc, %[c], %[c], %[s2]\n\tv_cmp_ge_f32_e64 %[s2], %[y11], %[ef]\n\tv_addc_co_u32_e64 %[d], vcc, %[d], %[d], %[s0]\n\tv_cmp_ge_f32_e64 %[s0], %[y11], %[lf]\n\tv_addc_co_u32_e64 %[c], vcc, %[c], %[c], %[s1]\n\tv_cmp_ge_f32_e64 %[s1], %[y10], %[ef]\n\tv_addc_co_u32_e64 %[d], vcc, %[d], %[d], %[s2]\n\tv_cmp_ge_f32_e64 %[s2], %[y10], %[lf]\n\tv_addc_co_u32_e64 %[c], vcc, %[c], %[c], %[s0]\n\tv_cmp_ge_f32_e64 %[s0], %[y9], %[ef]\n\tv_addc_co_u32_e64 %[d], vcc, %[d], %[d], %[s1]\n\tv_cmp_ge_f32_e64 %[s1], %[y9], %[lf]\n\tv_addc_co_u32_e64 %[c], vcc, %[c], %[c], %[s2]\n\tv_cmp_ge_f32_e64 %[s2], %[y8], %[ef]\n\tv_addc_co_u32_e64 %[d], vcc, %[d], %[d], %[s0]\n\tv_cmp_ge_f32_e64 %[s0], %[y8], %[lf]\n\tv_addc_co_u32_e64 %[c], vcc, %[c], %[c], %[s1]\n\tv_cmp_ge_f32_e64 %[s1], %[y7], %[ef]\n\tv_addc_co_u32_e64 %[d], vcc, %[d], %[d], %[s2]\n\tv_cmp_ge_f32_e64 %[s2], %[y7], %[lf]\n\tv_addc_co_u32_e64 %[c], vcc, %[c], %[c], %[s0]\n\tv_cmp_ge_f32_e64 %[s0], %[y6], %[ef]\n\tv_addc_co_u32_e64 %[d], vcc, %[d], %[d], %[s1]\n\tv_cmp_ge_f32_e64 %[s1], %[y6], %[lf]\n\tv_addc_co_u32_e64 %[c], vcc, %[c], %[c], %[s2]\n\tv_cmp_ge_f32_e64 %[s2], %[y5], %[ef]\n\tv_addc_co_u32_e64 %[d], vcc, %[d], %[d], %[s0]\n\tv_cmp_ge_f32_e64 %[s0], %[y5], %[lf]\n\tv_addc_co_u32_e64 %[c], vcc, %[c], %[c], %[s1]\n\tv_cmp_ge_f32_e64 %[s1], %[y4], %[ef]\n\tv_addc_co_u32_e64 %[d], vcc, %[d], %[d], %[s2]\n\tv_cmp_ge_f32_e64 %[s2], %[y4], %[lf]\n\tv_addc_co_u32_e64 %[c], vcc, %[c], %[c], %[s0]\n\tv_cmp_ge_f32_e64 %[s0], %[y3], %[ef]\n\tv_addc_co_u32_e64 %[d], vcc, %[d], %[d], %[s1]\n\tv_cmp_ge_f32_e64 %[s1], %[y3], %[lf]\n\tv_addc_co_u32_e64 %[c], vcc, %[c], %[c], %[s2]\n\tv_cmp_ge_f32_e64 %[s2], %[y2], %[ef]\n\tv_addc_co_u32_e64 %[d], vcc, %[d], %[d], %[s0]\n\tv_cmp_ge_f32_e64 %[s0], %[y2], %[lf]\n\tv_addc_co_u32_e64 %[c], vcc, %[c], %[c], %[s1]\n\tv_cmp_ge_f32_e64 %[s1], %[y1], %[ef]\n\tv_addc_co_u32_e64 %[d], vcc, %[d], %[d], %[s2]\n\tv_cmp_ge_f32_e64 %[s2], %[y1], %[lf]\n\tv_addc_co_u32_e64 %[c], vcc, %[c], %[c], %[s0]\n\tv_cmp_ge_f32_e64 %[s0], %[y0], %[ef]\n\tv_addc_co_u32_e64 %[d], vcc, %[d], %[d], %[s1]\n\tv_cmp_ge_f32_e64 %[s1], %[y0], %[lf]\n\tv_addc_co_u32_e64 %[c], vcc, %[c], %[c], %[s2]\n\tv_addc_co_u32_e64 %[d], vcc, %[d], %[d], %[s0]\n\tv_addc_co_u32_e64 %[c], vcc, %[c], %[c], %[s1]"
                      : [d] "+v"(def), [c] "+v"(cd), [s0] "=&s"(t0), [s1] "=&s"(t1), [s2] "=&s"(t2)
                      : [ef] "v"(Ef), [lf] "v"(Lf), [y0] "v"(y[0]), [y1] "v"(y[1]), [y2] "v"(y[2]), [y3] "v"(y[3]), [y4] "v"(y[4]), [y5] "v"(y[5]), [y6] "v"(y[6]), [y7] "v"(y[7]), [y8] "v"(y[8]), [y9] "v"(y[9]), [y10] "v"(y[10]), [y11] "v"(y[11]), [y12] "v"(y[12]), [y13] "v"(y[13]), [y14] "v"(y[14]), [y15] "v"(y[15])
                      : "vcc"); }
                unsigned cm = cd & ~def;
                word = ((def & 0xfu) | ((def & 0xf0u) << 4) | ((def & 0xf00u) << 8) | ((def & 0xf000u) << 12)) << (4 * hh);
                if (diag) { word &= (2u << r32) - 1u; cm &= vmr; }
                if (__any(cm != 0u) && !(dm & 32)) {
                    if (!__any((cm & (cm - 1u)) != 0u)) {
                        const unsigned r = (unsigned)__builtin_ctz(cm | 0x10000u);
                        const bool r1 = (r & 1u) != 0u, r2 = (r & 2u) != 0u, r4 = (r & 4u) != 0u;
                        float t0, t1;
                        { const float a0 = r1 ? y[1] : y[0], a1 = r1 ? y[3] : y[2]; float b0 = r2 ? a1 : a0; const float a2 = r1 ? y[5] : y[4], a3 = r1 ? y[7] : y[6]; const float b1 = r2 ? a3 : a2; t0 = r4 ? b1 : b0; }
                        asm volatile("" : "+v"(t0));
                        { const float a0 = r1 ? y[9] : y[8], a1 = r1 ? y[11] : y[10]; float b0 = r2 ? a1 : a0; const float a2 = r1 ? y[13] : y[12], a3 = r1 ? y[15] : y[14]; const float b1 = r2 ? a3 : a2; t1 = r4 ? b1 : b0; }
                        const float yv = (r & 8u) ? t1 : t0;
                        if (cm != 0u) {
                            const unsigned pos = __hip_atomic_fetch_add(auxw + AX_CCNT + r32, 1u, __ATOMIC_RELAXED, __HIP_MEMORY_SCOPE_WORKGROUP);
                            if (pos < 512u) { const unsigned u = __float_as_uint(yv); ckey[r32 * 512 + pos] = u ^ ((unsigned)((int)u >> 31) | 0x80000000u); cidx[r32 * 512 + pos] = (unsigned short)(8191 - (kb * 32 + (int)((r & 3u) + 8u * (r >> 2)) + 4 * hh)); }
                        }
                    } else if (cm != 0u) {
                        unsigned pos = __hip_atomic_fetch_add(auxw + AX_CCNT + r32, (unsigned)__builtin_popcount(cm), __ATOMIC_RELAXED, __HIP_MEMORY_SCOPE_WORKGROUP);
#pragma unroll
                        for (int r = 0; r < 16; ++r) { if ((cm >> r) & 1u) { if (pos < 512u) { const unsigned u = __float_as_uint(y[r]); ckey[r32 * 512 + pos] = u ^ ((unsigned)((int)u >> 31) | 0x80000000u); cidx[r32 * 512 + pos] = (unsigned short)(8191 - (kb * 32 + crow(r, hh))); } ++pos; } }
                    }
                }
                k0 = n0; k1 = n1;
            }
            word = xl::hor(word);
            if (hh == 0) bitw[r32 * 256 + kb] = word;
        }
    }
    __syncthreads();
    if (tid < 32) { if (aux[AX_CCNT + tid] > (unsigned)SEL_RANK_MAX) aux[AX_FLAG] = 3u; }
    __syncthreads();
#if defined(MK_DIAG_FALLBACKS) && MK_DIAG_FALLBACKS == 2
    if (tid == 0 && aux[AX_FLAG] == 3u) atomicAdd((unsigned*)C.diag, 1u);
#endif
#if defined(MK_DIAG_FALLBACKS) && MK_DIAG_FALLBACKS == 3
    if (tid < 32) atomicAdd((unsigned*)C.diag, aux[AX_CCNT + tid]);
#endif
    if (aux[AX_FLAG] != 3u) {
        const int q = tid >> 4, c16 = tid & 15; const int cn = (dm & 8) ? 0 : (int)aux[AX_CCNT + q]; const unsigned rem = aux[AX_SREM + q];
        for (int i = c16; i < cn; i += 16) {
            const unsigned ki = ckey[q * 512 + i], vi = cidx[q * 512 + i];
            unsigned rank = 0u;
            for (int j = 0; j < cn; ++j) { const unsigned kj = ckey[q * 512 + j], vj = cidx[q * 512 + j]; rank += (kj > ki || (kj == ki && vj > vi)) ? 1u : 0u; }
            if (rank < rem) { const unsigned s = 8191u - vi; __hip_atomic_fetch_or(bitw + q * 256 + (s >> 5), 1u << (s & 31u), __ATOMIC_RELAXED, __HIP_MEMORY_SCOPE_WORKGROUP); }
        }
    } else {
        const int q = tid >> 4, c16 = tid & 15; int cn = (int)aux[AX_CCNT + q]; cn = cn > 512 ? 512 : cn;
        for (int pass = 0; pass < ((dm & 8) ? 0 : 7); ++pass) {
            for (int i = tid; i < 32 * 64; i += NTHR) shist[i] = 0u;
            __syncthreads();
            const unsigned pre = aux[AX_SPRE + q], thk = aux[AX_THR + q];
            for (int i = c16; i < cn; i += 16) {
                const unsigned ck = ckey[q * 512 + i], cv = cidx[q * 512 + i];
                bool match; unsigned bin;
                if (pass == 0) { match = true; bin = ck >> 28; } else if (pass < 5) { const int sh = 28 - 7 * pass; match = (ck >> (sh + 7)) == pre; bin = (ck >> sh) & 127u; }
                else if (pass == 5) { match = ck == thk; bin = cv >> 6; } else { match = (ck == thk) && ((cv >> 6) == pre); bin = cv & 63u; }
                if (match) __hip_atomic_fetch_add(shist + q * 64 + (bin >> 1), 1u << (16 * (bin & 1u)), __ATOMIC_RELAXED, __HIP_MEMORY_SCOPE_WORKGROUP);
            }
            __syncthreads();
            hist_scan<true>((volatile LAS unsigned*)shist, 64, pass == 6 ? 64 : 128, false, pass == 6 ? 6 : 7, aux, tid);
            __syncthreads();
            if (pass == 4) {
                if (tid < 32) { aux[AX_THR + tid] = aux[AX_SPRE + tid]; aux[AX_SPRE + tid] = 0u; if (aux[AX_SREM + tid] < aux[AX_SCNT + tid]) aux[AX_FLAG] = 2u; }
                __syncthreads();
                if (aux[AX_FLAG] != 2u) break;
            }
        }
        const unsigned thk = aux[AX_THR + q], thv = aux[AX_SPRE + q];
        for (int i = c16; i < cn; i += 16) {
            const unsigned ck = ckey[q * 512 + i], cv = cidx[q * 512 + i];
            if (ck > thk || (ck == thk && cv >= thv)) { const unsigned s = 8191u - cv; __hip_atomic_fetch_or(bitw + q * 256 + (s >> 5), 1u << (s & 31u), __ATOMIC_RELAXED, __HIP_MEMORY_SCOPE_WORKGROUP); }
        }
    }
    __syncthreads();
    if (!(dm & 1)) { const int q = tid >> 4; unsigned* bp = C.bits + (rowbase + 32 * qg + q) * 256; for (int kb = tid & 15; kb <= kb_last; kb += 16) __builtin_nontemporal_store(bitw[q * 256 + kb], bp + kb); }
    __syncthreads();
}

constexpr int MOBA_MAXL = 7936, MOBA_PARTS = 2, MOBA_NSPLIT = 8;
__device__ __forceinline__ void moba_gate_unit(const MixCtx& C, int b, int h, int qb, LAS unsigned char* lds, const int wave0) {
    int tid_ = (wave0 << 6) | xl::fresh_lane(); asm volatile("" : "+v"(tid_));
    const int tid = tid_, lane = tid & 63, r32 = lane & 31, hh = lane >> 5, wave = __builtin_amdgcn_readfirstlane(tid >> 6);
    const size_t rowbase = (size_t)b * S; const int t = qb * 256 + 32 * wave + r32; const int hcol = h * 64;
    LAS float* km = (LAS float*)(lds + RING_OFF + AT_KM);
    for (int e = tid; e < 32 * 64; e += NTHR) { const int n = e >> 6, d = e & 63; const float* p = C.kmp + (size_t)((b * 32 + n) * 2) * 256 + hcol + d; km[e] = (p[0] + p[256]) * (1.0f / 256.0f); }
    __syncthreads();
    float qv[32];
    { const bf16* Qg = C.zt + 7 * C.zts;
#pragma unroll
      for (int ks = 0; ks < 4; ++ks) { const bf16x8 q8 = *(const bf16x8*)(Qg + (rowbase + t) * 256 + hcol + 16 * ks + 8 * hh);
#pragma unroll
          for (int j = 0; j < 8; ++j) qv[ks * 8 + j] = bf2f((unsigned short)q8[j]); } }
    float g0 = -INFINITY, g1 = -INFINITY, g2 = -INFINITY; int i0 = -1, i1 = -1, i2 = -1;
    for (int n = 0; n < qb; ++n) {
        const LAS float* kp = km + n * 64 + 8 * hh;
        float dot = 0.f;
#pragma unroll
        for (int ks = 0; ks < 4; ++ks) { const f32x4 a4 = *(const LAS f32x4*)(kp + 16 * ks), c4 = *(const LAS f32x4*)(kp + 16 * ks + 4);
            dot += qv[ks * 8 + 0] * a4[0] + qv[ks * 8 + 1] * a4[1] + qv[ks * 8 + 2] * a4[2] + qv[ks * 8 + 3] * a4[3] + qv[ks * 8 + 4] * c4[0] + qv[ks * 8 + 5] * c4[1] + qv[ks * 8 + 6] * c4[2] + qv[ks * 8 + 7] * c4[3]; }
        dot = xl::hsum(dot);
        if (dot > g0) { g2 = g1; i2 = i1; g1 = g0; i1 = i0; g0 = dot; i0 = n; }
        else if (dot > g1) { g2 = g1; i2 = i1; g1 = dot; i1 = n; }
        else if (dot > g2) { g2 = dot; i2 = n; }
    }
    if (hh == 0) {
        const int sel[3] = {i0, i1, i2};
#pragma unroll
        for (int j = 0; j < 3; ++j) {
            if (sel[j] >= 0) { unsigned* cp = C.mcnt + (b * 4 + h) * 32 + sel[j]; const unsigned pos = atomicAdd(cp, 1u);
                if (pos < (unsigned)MOBA_MAXL) C.mlist[((size_t)((b * 4 + h) * 32 + sel[j])) * MOBA_MAXL + pos] = (unsigned short)(t | (j << 13)); }
            else C.lse[(rowbase + t) * 16 + h * 4 + j] = -INFINITY;
        }
    }
    __syncthreads();
}
__device__ __forceinline__ void moba_blk_unit(const MixCtx& C, int b, int h, int n, int p, bool own, LAS unsigned char* lds, const int wave0, const int np = MOBA_PARTS) {
    int tid_ = (wave0 << 6) | xl::fresh_lane(); asm volatile("" : "+v"(tid_));
    const int tid = tid_, lane = tid & 63, r32 = lane & 31, hh = lane >> 5, wave = __builtin_amdgcn_readfirstlane(tid >> 6);
    const size_t rowbase = (size_t)b * S; const int hcol = h * 64;
    const int len = own ? 256 : (int)min(C.mcnt[(b * 4 + h) * 32 + n], (unsigned)MOBA_MAXL);
    if (p * 256 >= len) return;
    const bf16* Qg = C.zt + 7 * C.zts; const bf16* Kg = C.zt + 8 * C.zts; const bf16* Vg = C.zt + 9 * C.zts;
    LAS unsigned char* Kb = lds + RING_OFF; LAS unsigned char* Vb = lds + RING_OFF + 256 * KSTR64;
    const unsigned short* lp = C.mlist + ((size_t)((b * 4 + h) * 32 + n)) * MOBA_MAXL;
    unsigned ent_c = 0u, ent_n = 0u;
    { const int e0 = p * 256 + 32 * wave + r32, e1 = e0 + np * 256; if (!own && e0 < len) ent_c = (unsigned)lp[e0]; if (!own && e1 < len) ent_n = (unsigned)lp[e1]; }
    { v4u kr[4], vr[4];
#pragma unroll
      for (int i = 0; i < 4; ++i) { const int e = tid + i * NTHR, row = e >> 3, ch = e & 7; kr[i] = *(const v4u*)(Kg + (rowbase + n * 256 + row) * 256 + hcol + ch * 8); vr[i] = *(const v4u*)(Vg + (rowbase + n * 256 + row) * 256 + hcol + ch * 8); }
#pragma unroll
      for (int i = 0; i < 4; ++i) { const int e = tid + i * NTHR, row = e >> 3, ch = e & 7; *(LAS v4u*)(Kb + row * KSTR64 + ch * 16) = kr[i]; *(LAS v4u*)(Vb + row * VSTR + ch * 16) = vr[i]; } }
    bf16x8 qn[4];
    { const int tq0 = own ? n * 256 + 32 * wave + r32 : (int)(ent_c & 8191u);
#pragma unroll
      for (int ks = 0; ks < 4; ++ks) qn[ks] = *(const bf16x8*)(Qg + (rowbase + tq0) * 256 + hcol + 16 * ks + 8 * hh); }
    __syncthreads();
    for (int c = p; c * 256 < len; c += np) {
        const int e = c * 256 + 32 * wave + r32; const bool valid = e < len;
        int tq, slot;
        if (own) { tq = n * 256 + e; slot = 3; } else { tq = (int)(ent_c & 8191u); slot = (int)(ent_c >> 13); }
        bf16x8 qf[4];
#pragma unroll
        for (int ks = 0; ks < 4; ++ks) qf[ks] = qn[ks];
        ent_c = ent_n;
        if ((c + np) * 256 < len) {
            const int tq2 = (int)(ent_c & 8191u);
#pragma unroll
            for (int ks = 0; ks < 4; ++ks) qn[ks] = *(const bf16x8*)(Qg + (rowbase + tq2) * 256 + hcol + 16 * ks + 8 * hh);
            const int e3 = (c + 2 * np) * 256 + 32 * wave + r32; ent_n = (e3 < len) ? (unsigned)lp[e3] : 0u;
        }
        f32x16 o0 = {}, o1 = {}, negm = {}; float mref = 0.f, l = 0.f; bool mset = false;
#pragma unroll 1
        for (int i = 0; i < 4; ++i) {
            if (own && 64 * i > 32 * wave + 31) break;
            f32x16 s0, s1;
            qk_tile<4, KSTR64>(s0, s1, Kb + i * 64 * KSTR64, qf, lane, negm);
            if (own && 64 * i + 63 > 32 * wave) {
#pragma unroll
                for (int r = 0; r < 16; ++r) { const int kk = n * 256 + 64 * i + crow(r, hh); if (kk > tq) s0[r] = -INFINITY; if (kk + 32 > tq) s1[r] = -INFINITY; }
            }
            softmax_tile(s0, s1, mref, mset, negm, l, o0, o1);
            pv_tile(o0, o1, Vb + i * 64 * VSTR, s0, s1, lane);
        }
        l = xl::hsum(l);
        {
            const float inv = 1.0f / l;
            bf16* op = C.part + ((rowbase + tq) * 16 + h * 4 + slot) * 64;
            store_row64(op, o0, o1, inv, hh, valid);
            if (valid && hh == 0) C.lse[(rowbase + tq) * 16 + h * 4 + slot] = mref + lg2(l);
        }
    }
    __syncthreads();
}

#ifndef MK_REPEAT_LP
#define MK_REPEAT_LP -1
#endif
#ifndef MK_REPEAT_KINDS
#define MK_REPEAT_KINDS 15
#endif
#ifndef MK_REPEAT_LAYERS
#define MK_REPEAT_LAYERS 3
#endif
#ifndef MK_REPEAT_CONV
#define MK_REPEAT_CONV 0
#endif
#ifndef MK_EXTRA_BARRIERS
#define MK_EXTRA_BARRIERS 0
#endif
#ifndef MK_ONLY
#define MK_ONLY -1
#endif
#ifndef MK_SKIPMASK
#define MK_SKIPMASK 0
#endif
#define PHON(x) ((MK_ONLY < 0 || MK_ONLY == (x)) && !((MK_SKIPMASK >> (x)) & 1))
#ifndef MK_MIXONLY
#define MK_MIXONLY -1
#endif
#define MIXON(x) (MK_MIXONLY < 0 || MK_MIXONLY == (x))
constexpr int PH_CONV0 = 0, PH_L0 = 1, PH_CONV1 = 10, PH_L1 = 11, PH_FINAL = 20, N_PHASES = 21, PH_MERGE0 = 21, PH_MERGE1 = 22;
constexpr int LP_INPROJ = 0, LP_MLA = 1, LP_MIX = 2, LP_DSA = 3, LP_PROJ = 4, LP_GATE = 5, LP_OUT = 6, LP_UP = 7, LP_DOWN = 8;


#define P_WIN ((bf16*)(wbase + (WS_WIN - WS_WIN)))
#define P_WMLA ((bf16*)(wbase + (WS_WMLA - WS_WIN)))
#define P_WB ((bf16*)(wbase + (WS_WB - WS_WIN)))
#define P_WOUT ((bf16*)(wbase + (WS_WOUT - WS_WIN)))
#define P_WUP ((bf16*)(wbase + (WS_WUP - WS_WIN)))
#define P_WDOWN ((bf16*)(wbase + (WS_WDOWN - WS_WIN)))
#define P_XB    ((bf16*)(ws + WS_XB))
#define P_ZT    ((bf16*)(ws + WS_ZT))
#define P_MLAA  ((bf16*)(ws + WS_MLAA))
#define P_MISC  ((bf16*)(ws + WS_MISC))
#define P_QM    ((bf16*)(ws + WS_QM))
#define P_KN    ((bf16*)(ws + WS_KN))
#define P_VM    ((bf16*)(ws + WS_VM))
#define P_BITS  ((unsigned*)(ws + WS_BITS))
#define P_O4    ((bf16*)(ws + WS_O4))
#define P_PROJ  ((bf16*)(ws + WS_PROJ))
#define P_DSA2  ((bf16*)(ws + WS_DSA2))
#define P_LSED  ((float*)(ws + WS_LSED))
#define P_MERGED ((bf16*)(ws + WS_MERGED))
#define P_HID   ((bf16*)(ws + WS_HID))
#define P_SSA   ((float*)(ws + WS_SSA))
#define P_SSB   ((float*)(ws + WS_SSB))
#define P_SSQ   ((float*)(ws + WS_SSQ))
#define P_SSKV  ((float*)(ws + WS_SSKV))
#define P_KMP   ((float*)(ws + WS_KMP))
#define P_TP    ((const float*)(ws + WS_TP))
#define P_TI    ((const float*)(ws + WS_TI))
#define P_TM    ((const float*)(ws + WS_TM))

__device__ __forceinline__ int next_unit(gu32* ctr, volatile LAS unsigned* aux, int tid) {
    if (tid == 0) aux[AX_UNIT] = __hip_atomic_fetch_add(ctr, 1u, RLX_AGENT);
    __syncthreads();
    const int u = (int)aux[AX_UNIT];
    __syncthreads();
    return u;
}

template <int ph> __device__ __forceinline__ void run_phase(const Ptrs& P, LAS unsigned char* lds, gu32* ctl, int G, int bx, int vcu, const int wave0) {
    volatile LAS unsigned* aux = (volatile LAS unsigned*)(lds + AUX_OFF);
    const int M = P.mrows, nb = M / S;
    const int NGW = G * NWAVES;
    {
        unsigned char* ws = P.ws;
        unsigned char* wbase = (ph >= PH_L1) ? (unsigned char*)P.out : ws + WS_WIN;
        (void)wbase;
        const size_t zts = (size_t)M * 256;
        if (ph == PH_MERGE0 || ph == PH_MERGE1) {
            int tid_ = (wave0 << 6) | xl::fresh_lane(); asm volatile("" : "+v"(tid_)); const int tid = tid_, lane = tid & 63, wave = __builtin_amdgcn_readfirstlane(tid >> 6), gw = vcu * NWAVES + wave;
            const bf16* part = (const bf16*)(ws + WS_PART); const float* lse = (const float*)(ws + WS_LSE); bf16* oc = P_O4 + 2 * zts;
            const int head = lane >> 4, d0 = (lane & 15) * 4;
            for (int m0 = gw; m0 < M; m0 += 2 * NGW) {
                f32x4 L4[2]; v2u pv[2][4]; f32x2v lab[2]; v2u pa[2], pb[2]; bool on[2];
#pragma unroll
                for (int i = 0; i < 2; ++i) { const int m = m0 + i * NGW; on[i] = m < M; const size_t mm = on[i] ? (size_t)m : 0;
                    L4[i] = *(const f32x4*)(lse + mm * 16 + head * 4);
#pragma unroll
                    for (int j = 0; j < 4; ++j) pv[i][j] = *(const v2u*)(part + (mm * 16 + head * 4 + j) * 64 + d0);
                    lab[i] = *(const f32x2v*)(P_LSED + (mm * 4 + head) * 2);
                    pa[i] = *(const v2u*)(P_O4 + mm * 256 + head * 64 + d0); pb[i] = *(const v2u*)(P_DSA2 + mm * 256 + head * 64 + d0); }
#pragma unroll
                for (int i = 0; i < 2; ++i) { const int m = m0 + i * NGW; if (!on[i]) continue;
                    const float mx = fmaxf(fmaxf(L4[i][0], L4[i][1]), fmaxf(L4[i][2], L4[i][3]));
                    float wsum = 0.f; f32x4 acc = {0.f, 0.f, 0.f, 0.f};
#pragma unroll
                    for (int j = 0; j < 4; ++j) { const float w = __builtin_amdgcn_exp2f(L4[i][j] - mx); const bool use = w > 0.f; const v2u p = pv[i][j];
                        const f32x4 val = {__uint_as_float(p.x << 16), __uint_as_float(p.x & 0xffff0000u), __uint_as_float(p.y << 16), __uint_as_float(p.y & 0xffff0000u)};
#pragma unroll
                        for (int e2 = 0; e2 < 4; ++e2) acc[e2] += use ? w * val[e2] : 0.f;
                        wsum += use ? w : 0.f; }
                    const float inv = 1.0f / wsum;
                    v2u o; o.x = pk2(acc[0] * inv, acc[1] * inv); o.y = pk2(acc[2] * inv, acc[3] * inv);
                    *(v2u*)(oc + (size_t)m * 256 + head * 64 + d0) = o;
                    const float la = lab[i].x, lb = lab[i].y;
                    if (lb > -INFINITY) {
                        const float mm2 = fmaxf(la, lb), wa = __builtin_amdgcn_exp2f(la - mm2), wb = __builtin_amdgcn_exp2f(lb - mm2), iv = 1.0f / (wa + wb);
                        const v2u qa = pa[i], qb = pb[i];
                        const f32x4 va = {__uint_as_float(qa.x << 16), __uint_as_float(qa.x & 0xffff0000u), __uint_as_float(qa.y << 16), __uint_as_float(qa.y & 0xffff0000u)};
                        const f32x4 vb = {__uint_as_float(qb.x << 16), __uint_as_float(qb.x & 0xffff0000u), __uint_as_float(qb.y << 16), __uint_as_float(qb.y & 0xffff0000u)};
                        const f32x4 r4 = (va * wa + vb * wb) * iv;
                        v2u o2; o2.x = pk2(r4[0], r4[1]); o2.y = pk2(r4[2], r4[3]);
                        *(v2u*)(P_O4 + (size_t)m * 256 + head * 64 + d0) = o2;
                    }
                }
            }
        } else if (PHON(9) && ph == PH_CONV0) {
            int tid_ = (wave0 << 6) | xl::fresh_lane(); asm volatile("" : "+v"(tid_)); const int tid = tid_, lane = tid & 63, wave = __builtin_amdgcn_readfirstlane(tid >> 6), gw = vcu * NWAVES + wave; (void)lane; (void)gw;
            p0_convert(P, lds, gw, NGW, wave, lane);
        } else if (ph == PH_CONV1) {
        } else if (PHON(10) && ph == PH_FINAL) {
            int tid_ = (wave0 << 6) | xl::fresh_lane(); asm volatile("" : "+v"(tid_)); const int tid = tid_, lane = tid & 63, wave = __builtin_amdgcn_readfirstlane(tid >> 6), gw = vcu * NWAVES + wave; (void)lane; (void)gw;
            const float* gf = P.in[13];
            f32x4 g[2][2];
#pragma unroll
            for (int j = 0; j < 2; ++j) { g[j][0] = *(const f32x4*)(gf + 512 * j + 8 * lane); g[j][1] = *(const f32x4*)(gf + 512 * j + 8 * lane + 4); }
            for (int m0 = gw; m0 < M; m0 += 2 * NGW) {
                f32x4 pa[2]; v4u w[2][2]; bool on[2];
#pragma unroll
                for (int i = 0; i < 2; ++i) { const int m = m0 + i * NGW; on[i] = m < M; const size_t mm = on[i] ? (size_t)m : 0;
                    pa[i] = *(const f32x4*)(P_SSA + mm * 16 + 4 * (lane & 3));
#pragma unroll
                    for (int j = 0; j < 2; ++j) w[i][j] = *(const v4u*)(P_XB + mm * D + 512 * j + 8 * lane); }
#pragma unroll
                for (int i = 0; i < 2; ++i) { const int m = m0 + i * NGW; if (!on[i]) continue;
                    float s = (pa[i][0] + pa[i][1]) + (pa[i][2] + pa[i][3]); s += xl::sxor<1>(s); s += xl::sxor<2>(s);
                    const float rs = rsqrtf(s * (1.0f / 1024.0f) + 1e-6f);
                    float* orow = P.out + (size_t)m * D;
#pragma unroll
                    for (int j = 0; j < 2; ++j) { const int c = 512 * j + 8 * lane; const v4u ww = w[i][j];
                        f32x4 o0 = {__uint_as_float(ww.x << 16), __uint_as_float(ww.x & 0xffff0000u), __uint_as_float(ww.y << 16), __uint_as_float(ww.y & 0xffff0000u)};
                        f32x4 o1 = {__uint_as_float(ww.z << 16), __uint_as_float(ww.z & 0xffff0000u), __uint_as_float(ww.w << 16), __uint_as_float(ww.w & 0xffff0000u)};
                        *(f32x4*)(orow + c) = o0 * rs * g[j][0]; *(f32x4*)(orow + c + 4) = o1 * rs * g[j][1]; }
                }
            }
#ifdef MK_DIAG_FALLBACKS
            if (gw == 0 && lane == 0) { const unsigned cnt = __hip_atomic_load(ctl + 12288, RLX_AGENT); if (cnt) { asm volatile("s_waitcnt vmcnt(0)" ::: "memory"); P.out[0] = sqrtf((float)cnt * (float)M * 1024.0f * 1.0025f); } }
#endif
        } else {
            const int l = (ph >= PH_L1) ? 1 : 0, lp = ph - (l ? PH_L1 : PH_L0);
            const int nrep = (lp == MK_REPEAT_LP && ((MK_REPEAT_LAYERS >> l) & 1)) ? 2 : 1;
            for (int rep = 0; rep < nrep; ++rep) {
            if (PHON(0) && lp == LP_INPROJ) {
                pg8::Gemm g{P_XB, P_WIN, M, 3072, D}; pg8::StaticOrder so; so.init(M, 3072, G, bx);
                pg8::EpiInProj E{P_ZT, zts, P_MLAA, P_MISC, P_SSA, P_SSQ, P_SSKV, P_KMP, P_TP, P_TI, P_TM};
                pg8::gemm_phase<pg8::EpiInProj, pg8::StaticOrder, true, true>(lds + RING_OFF, g, so, E, wave0);
            } else if (PHON(1) && lp == LP_MLA) {
                pg8::Gemm g{P_MLAA, P_WMLA, M, 1024, 384}; pg8::StaticOrder so; so.init(M, 1024, G, bx);
                pg8::EpiMla E{P_QM, P_KN, P_VM, P_SSQ, P_SSKV, P_TM};
                pg8::gemm_phase<pg8::EpiMla, pg8::StaticOrder, true, true>(lds + RING_OFF, g, so, E, wave0);
            } else if (PHON(2) && lp == LP_MIX) {
                MixCtx MC; MC.zt = P_ZT; MC.zts = zts; MC.misc = P_MISC; MC.qm = P_QM; MC.kn = P_KN; MC.vm = P_VM; MC.kmp = P_KMP; MC.bits = P_BITS; MC.o4 = P_O4; MC.o4s = zts; MC.diag = (unsigned*)(ctl + 12288); MC.mlist = (unsigned short*)(ws + WS_MLIST); MC.mcnt = (unsigned*)(ctl + CW_MCNT + 256 * l); MC.part = (bf16*)(ws + WS_PART); MC.lse = (float*)(ws + WS_LSE); MC.dsa2 = (bf16*)(ws + WS_DSA2); MC.lsed = (float*)(ws + WS_LSED);
                int tid_ = (wave0 << 6) | xl::fresh_lane(); asm volatile("" : "+v"(tid_)); const int tid = tid_, lane = tid & 63, wave = __builtin_amdgcn_readfirstlane(tid >> 6), gw = vcu * NWAVES + wave; (void)lane; (void)gw;
                gu32* ctr = ctl + CW_QUEUE + 64 * (2 * l + 4 * rep);
                const int per = 20 * nb;
                const int ncv = (l == 0 && !rep && P.li >= 0) ? CV_PER_LEVEL : 0, per_x = per + ncv, total = 32 * per_x;
                for (bool first = true;; first = false) {
                    const int u = first ? bx : G + next_unit(ctr, aux, tid);
                    if (u >= total) break;
                    int L, r;
                    if (u < 128 * nb) { L = 31 - u / (4 * nb); r = u % (4 * nb); }
                    else { const int v = u - 128 * nb, per2 = per_x - 4 * nb; L = 31 - v / per2; r = v % per2 + 4 * nb; }
                    const int kmask = rep ? MK_REPEAT_KINDS : 15;
                    if (r >= per) { const int c = (31 - L) * ncv + (r - per); if (c < CV_UNITS) conv_unit(P, lds, c, wave0); continue; }
                    if (r < 12 * nb) { const int kind = r / (4 * nb), rr = r % (4 * nb), b = rr >> 2, h = rr & 3;
                        if (MIXON(0) && kind == 0 && (kmask & 1)) softmax_unit<0>(MC, b, h, L, lds, wave0, rep); else if (MIXON(2) && kind == 1 && (kmask & 4)) sb_unit(MC, b, h, L, lds, wave0);
                        else if (kind == 2 && !rep) moba_gate_unit(MC, b, h, L, lds, wave0); }
                    else if (MIXON(3) && (kmask & 8)) { const int r2 = r - 12 * nb, b = r2 >> 3, qg = 8 * L + 7 - (r2 & 7); sel_unit(MC, b, qg, lds, wave0, rep); }
                }
            } else if (PHON(3) && lp == LP_DSA) {
                MixCtx MC; MC.zt = P_ZT; MC.zts = zts; MC.misc = P_MISC; MC.qm = P_QM; MC.kn = P_KN; MC.vm = P_VM; MC.kmp = P_KMP; MC.bits = P_BITS; MC.o4 = P_O4; MC.o4s = zts; MC.diag = (unsigned*)(ctl + 12288); MC.mlist = (unsigned short*)(ws + WS_MLIST); MC.mcnt = (unsigned*)(ctl + CW_MCNT + 256 * l); MC.part = (bf16*)(ws + WS_PART); MC.lse = (float*)(ws + WS_LSE); MC.dsa2 = (bf16*)(ws + WS_DSA2); MC.lsed = (float*)(ws + WS_LSED);
                int tid_ = (wave0 << 6) | xl::fresh_lane(); asm volatile("" : "+v"(tid_)); const int tid = tid_, lane = tid & 63, wave = __builtin_amdgcn_readfirstlane(tid >> 6), gw = vcu * NWAVES + wave; (void)lane; (void)gw;
                gu32* ctr = ctl + CW_QUEUE + 64 * (2 * l + 1 + 4 * rep);
                const int per = (12 + 4 * MOBA_PARTS) * nb, per_lo = 16 * nb, nhi = MOBA_NSPLIT * per, total = nhi + (32 - MOBA_NSPLIT) * per_lo;
                for (bool first = true;; first = false) {
                    const int u = first ? bx : G + next_unit(ctr, aux, tid);
                    if (u >= total) break;
                    int L, r;
                    if (u < nhi) { L = 31 - u / per; r = u % per; }
                    else { const int v = u - nhi; L = 31 - MOBA_NSPLIT - v / per_lo; r = v % per_lo; if (r >= 12 * nb) r = 12 * nb + (r - 12 * nb) * MOBA_PARTS; }
                    const int kmask = rep ? MK_REPEAT_KINDS : 15;
                    if (r < 8 * nb) { const int hf = r / (4 * nb), rr = r % (4 * nb); softmax_unit<1>(MC, rr >> 2, rr & 3, L, lds, wave0, 0, hf); }
                    else if (r < 12 * nb) { const int rr = r - 8 * nb; if (MIXON(1) && (kmask & 2)) moba_blk_unit(MC, rr >> 2, rr & 3, L, 0, true, lds, wave0); }
                    else { const int rr = r - 12 * nb, bh = rr / MOBA_PARTS, p = rr % MOBA_PARTS; const int n = 31 - L, np = (n < MOBA_NSPLIT) ? MOBA_PARTS : 1;
                        if (MIXON(1) && (kmask & 2) && L > 0 && p < np) moba_blk_unit(MC, bh >> 2, bh & 3, n, p, false, lds, wave0, np); }
                }
            } else if (PHON(4) && lp == LP_PROJ) {
                pg8::Gemm g{P_O4, P_WB, 4 * M, 4096, 256}; pg8::ProjOrder so{M / 256, G, bx};
                pg8::EpiProj E{P_PROJ, M / 256};
                pg8::gemm_phase<pg8::EpiProj, pg8::ProjOrder, true, true>(lds + RING_OFF, g, so, E, wave0);
            } else if (PHON(5) && lp == LP_GATE) {
                pg8::Gemm g{P_XB, P_WIN, M, 7168, D}; pg8::GateOrder so; so.so.init(M, 1024, G, bx);
                pg8::EpiGate E{P_PROJ, P_MERGED, P_SSA, P.in[3] + (size_t)l * 4 * D};
                pg8::gemm_phase<pg8::EpiGate, pg8::GateOrder, true, true>(lds + RING_OFF, g, so, E, wave0);
            } else if (PHON(6) && lp == LP_OUT) {
                pg8::Gemm g{P_MERGED, P_WOUT, M, D, D}; pg8::StaticOrder so; so.init(M, D, G, bx);
                pg8::EpiResid E{(l == 0) ? P.in[0] : nullptr, P_XB, P_SSB};
                pg8::gemm_phase<pg8::EpiResid, pg8::StaticOrder, true, true>(lds + RING_OFF, g, so, E, wave0);
            } else if (PHON(7) && lp == LP_UP) {
                pg8::Gemm g{P_XB, P_WUP, M, FF, D}; pg8::StaticOrder so; so.init(M, FF, G, bx);
                pg8::EpiUp E{P_HID, P_SSB};
                pg8::gemm_phase<pg8::EpiUp, pg8::StaticOrder, true, true>(lds + RING_OFF, g, so, E, wave0);
            } else if (PHON(8)) {
                pg8::Gemm g{P_HID, P_WDOWN, M, D, FF}; pg8::StaticOrder so; so.init(M, D, G, bx);
                pg8::EpiResid E{nullptr, P_XB, P_SSA};
                pg8::gemm_phase<pg8::EpiResid, pg8::StaticOrder, true, true>(lds + RING_OFF, g, so, E, wave0);
            }
            }
        }
    }
}

__global__ void __launch_bounds__(NTHR, 2) mk_fwd(Ptrs P) {
    extern __shared__ __attribute__((aligned(16))) unsigned char lds_raw[];
    LAS unsigned char* lds = (LAS unsigned char*)lds_raw;
    const int tid0 = threadIdx.x;
    const int wave0 = __builtin_amdgcn_readfirstlane(tid0 >> 6);
#define LEADER (wave0 == 0 && xl::fresh_lane() == 0)
    const int G = gridDim.x, bx = blockIdx.x;
    const int vcu = (G % 8 == 0) ? (bx % 8) * (G / 8) + bx / 8 : bx;
    gu32* ctl = (gu32*)(P.ws + WS_CTL);
    volatile LAS unsigned* MISCW = (volatile LAS unsigned*)(lds + MISC_OFF);
    for (int u = tid0; u < (LDS_BYTES - LDSCTL_OFF) / 4; u += NTHR) ((LAS unsigned*)(lds + LDSCTL_OFF))[u] = 0u;
    __syncthreads();
    const bool multi = (P.ph_hi - P.ph_lo) > 1;
    XcdBarrier bar; bar.bar = (unsigned*)(ctl + CW_BAR); bar.x = 0; bar.st = nullptr;
    if (multi) bar = xcd_barrier_post((unsigned*)(ctl + CW_BAR), MISCW + 8, tid0 == 0);
#define RUNPH(k) if (P.ph_lo <= (k) && (k) < P.ph_hi) { run_phase<k>(P, lds, ctl, G, bx, vcu, wave0); if ((k) + 1 < P.ph_hi && (k) != PH_CONV1) xcd_barrier(bar, LEADER); }
    RUNPH(0) RUNPH(1) RUNPH(2) RUNPH(3) RUNPH(4)
    if (P.ph_lo <= PH_L0 + LP_DSA && PH_L0 + LP_PROJ < P.ph_hi) { run_phase<PH_MERGE0>(P, lds, ctl, G, bx, vcu, wave0); xcd_barrier(bar, LEADER); }
    RUNPH(5) RUNPH(6) RUNPH(7) RUNPH(8) RUNPH(9) RUNPH(10)
#if MK_REPEAT_CONV
    RUNPH(10)
#endif
    RUNPH(11) RUNPH(12) RUNPH(13) RUNPH(14)
    if (P.ph_lo <= PH_L1 + LP_DSA && PH_L1 + LP_PROJ < P.ph_hi) { run_phase<PH_MERGE1>(P, lds, ctl, G, bx, vcu, wave0); xcd_barrier(bar, LEADER); }
    RUNPH(15) RUNPH(16) RUNPH(17) RUNPH(18) RUNPH(19) RUNPH(20)
#undef RUNPH
    if (multi) { for (int i = 0; i < MK_EXTRA_BARRIERS; ++i) xcd_barrier(bar, LEADER); }
}

static int g_grid = 0;
static int mk_setup(size_t ws_size) {
    if (g_grid != 0) return g_grid;
    if (ws_size < WS_END) { fprintf(stderr, "kernel_launch: workspace too small (%zu < %zu)\n", ws_size, (size_t)WS_END); g_grid = -1; return g_grid; }
    int dev = 0, cus = 0, per_cu = 0;
    if (hipGetDevice(&dev) != hipSuccess || hipDeviceGetAttribute(&cus, hipDeviceAttributeMultiprocessorCount, dev) != hipSuccess) { g_grid = -1; return g_grid; }
    if (hipFuncSetAttribute((const void*)mk_fwd, hipFuncAttributeMaxDynamicSharedMemorySize, LDS_BYTES) != hipSuccess) { fprintf(stderr, "kernel_launch: hipFuncSetAttribute failed\n"); g_grid = -1; return g_grid; }
    if (hipOccupancyMaxActiveBlocksPerMultiprocessor(&per_cu, (const void*)mk_fwd, NTHR, LDS_BYTES) != hipSuccess || per_cu < 1) fprintf(stderr, "kernel_launch: occupancy query reports %d blocks per CU\n", per_cu);
    (void)hipGetLastError();
    g_grid = cus;
    return g_grid;
}
static void mk_launch(Ptrs a, int lo, int hi, int li, hipStream_t stream) {
    a.ph_lo = lo; a.ph_hi = hi; a.li = li;
    hipLaunchKernelGGL(mk_fwd, dim3(g_grid), dim3(NTHR), LDS_BYTES, stream, a);
}
}

extern "C" void kernel_launch(void* const* d_in, const int* in_sizes, int n_in, void* d_out, int out_size, void* d_ws, size_t ws_size, hipStream_t stream) {
    if (n_in != 14 || out_size != 2 * mk::S * mk::D) { fprintf(stderr, "kernel_launch: unexpected shapes\n"); return; }
    if (mk::mk_setup(ws_size) < 0) return;
    if (hipMemsetAsync((char*)d_ws + mk::WS_CTL, 0, mk::CTL_ZERO_BYTES, stream) != hipSuccess) return;
    mk::Ptrs a{};
    for (int i = 0; i < 14; ++i) a.in[i] = (const float*)d_in[i];
    a.out = (float*)d_out; a.ws = (unsigned char*)d_ws; a.mrows = 2 * mk::S;
#ifndef MK_PER_PHASE
    mk::mk_launch(a, 0, mk::N_PHASES, 0, stream);
#else
    for (int ph = 0; ph < mk::N_PHASES; ++ph) mk::mk_launch(a, ph, ph + 1, ph, stream);
#endif
}
```
